# Optimizing an MI355X kernel written in HIP

```python
import math
import jax, jax.numpy as jnp
from jax import lax
import numpy as np

D_MODEL = 1024
BATCH = 2
SEQ = 16384
DEPTH = 2

GRID_W = 64
CTX_LEN = 256
Q_BLOCK = 128
ROPE_BASE = 10000.0
EPS = 1e-6

DIFF_HEADS = 4
DIFF_HEAD_DIM = 64
DIFF_V_DIM = 2 * DIFF_HEAD_DIM
HYENA_WIDTH = 256
HYENA_ORDER = 2
HYENA_SHORT = 3
FILT_EMB = 33
FILT_HIDDEN = 64
DECAY_TARGET = 1e-2
FAST_DECAY = 0.3
SLOW_DECAY = 1.5
CONF_WIDTH = 256
CONF_KERNEL = 31
MLA_HEADS = 4
MLA_Q_RANK = 256
MLA_KV_RANK = 128
MLA_NOPE = 64
MLA_ROPE = 32
MLA_V = 64
MLA_SCALE = (MLA_NOPE + MLA_ROPE) ** -0.5
N_BRANCH = 4
N_EXPERTS = 16
EC_CAPACITY = 2
EXPERT_HIDDEN = 1024

DIFF_QK_W = DIFF_HEADS * 2 * DIFF_HEAD_DIM
DIFF_V_W = DIFF_HEADS * DIFF_V_DIM
HYENA_PROJ = (HYENA_ORDER + 1) * HYENA_WIDTH
CONF_PROJ = 2 * CONF_WIDTH
GATE_PROJ = N_BRANCH * D_MODEL
IN_SPLITS = (DIFF_QK_W, DIFF_QK_W, DIFF_V_W, HYENA_PROJ, CONF_PROJ, MLA_Q_RANK, MLA_KV_RANK, MLA_ROPE, GATE_PROJ)
IN_WIDTH = DIFF_QK_W * 2 + DIFF_V_W + HYENA_PROJ + CONF_PROJ + MLA_Q_RANK + MLA_KV_RANK + MLA_ROPE + GATE_PROJ
BRANCH_WIDTHS = (DIFF_V_W, HYENA_WIDTH, CONF_WIDTH, MLA_HEADS * MLA_V)
MIX_WIDTH = DIFF_V_W + HYENA_WIDTH + CONF_WIDTH + MLA_HEADS * MLA_V

kernel_name = 'hybrid_diffusion_parallel_mixers_ec_moe'


def _split(z, sizes):
    out, start = [], 0
    for s in sizes:
        out.append(z[..., start:start + s])
        start += s
    return out


def rms_norm(x, g):
    xf = x.astype(jnp.float32)
    y = xf * lax.rsqrt(jnp.mean(xf * xf, axis=-1, keepdims=True) + EPS)
    return y.astype(x.dtype) * g


def layer_norm(x, g, b):
    xf = x.astype(jnp.float32)
    mu = jnp.mean(xf, axis=-1, keepdims=True)
    var = jnp.mean(jnp.square(xf - mu), axis=-1, keepdims=True)
    return ((xf - mu) * lax.rsqrt(var + EPS)).astype(x.dtype) * g + b


def modulate(x, shift, scale):
    return x * (1.0 + scale) + shift


def axial_rope_tables(n_tok, rot_dim):
    rows = n_tok // GRID_W
    row = jnp.repeat(jnp.arange(rows), GRID_W).astype(jnp.float32)
    col = jnp.tile(jnp.arange(GRID_W), rows).astype(jnp.float32)
    nf = rot_dim // 4
    inv = ROPE_BASE ** (-jnp.arange(nf, dtype=jnp.float32) / nf)
    ang = jnp.concatenate([row[:, None] * inv, col[:, None] * inv], axis=-1)
    return jnp.cos(ang), jnp.sin(ang)


def apply_rope(x, cos, sin):
    half = x.shape[-1] // 2
    x1, x2 = x[..., :half], x[..., half:]
    return jnp.concatenate([x1 * cos - x2 * sin, x1 * sin + x2 * cos], axis=-1).astype(x.dtype)


def depthwise_conv(u, w):
    k, c = w.shape
    return lax.conv_general_dilated(u, w[:, None, :].astype(u.dtype), window_strides=(1,),
                                    padding=[(k // 2, k // 2)], dimension_numbers=('NWC', 'WIO', 'NWC'),
                                    feature_group_count=c)


def attn_probs(q, k, scale):
    s = jnp.einsum('...qd,...kd->...qk', q, k).astype(jnp.float32) * scale
    return jax.nn.softmax(s, axis=-1)


def softmax_attend(q, k, v, scale):
    p = attn_probs(q, k, scale)
    return jnp.einsum('bhqk,bhkv->bhqv', p.astype(v.dtype), v)


def diff_attend(q, k, v, lam):
    p = attn_probs(q, k, DIFF_HEAD_DIM ** -0.5)
    a = p[:, :, 0] - lam * p[:, :, 1]
    return jnp.einsum('bhqk,bhkv->bhqv', a.astype(v.dtype), v)


def sweep_query_blocks(fn, q):
    *lead, s, d = q.shape
    nb = s // Q_BLOCK
    qb = jnp.moveaxis(q.reshape(*lead, nb, Q_BLOCK, d), -3, 0)
    out = jnp.moveaxis(lax.map(fn, qb), 0, -3)
    return out.reshape(*out.shape[:-3], s, out.shape[-1])


def diff_heads(z):
    b, n, _ = z.shape
    return z.reshape(b, n, DIFF_HEADS, 2, DIFF_HEAD_DIM).transpose(0, 2, 3, 1, 4)


def value_heads(z, n_heads):
    b, n, _ = z.shape
    return z.reshape(b, n, n_heads, -1).transpose(0, 2, 1, 3)


def merge_heads(o):
    b, h, n, dv = o.shape
    return o.transpose(0, 2, 1, 3).reshape(b, n, h * dv)


def diff_finish(o, g, lam_init):
    return merge_heads(rms_norm(o, g) * (1.0 - lam_init))


def mla_queries(cq, p, rope):
    q = value_heads(rms_norm(cq, p['mla_q_norm_g']) @ p['mla_w_uq'], MLA_HEADS)
    q_nope, q_rope = q[..., :MLA_NOPE], q[..., MLA_NOPE:]
    if rope is not None:
        q_rope = apply_rope(q_rope, *rope)
    return jnp.concatenate([q_nope, q_rope], axis=-1)


def mla_keys_values(ckv, kr, p, rope):
    kv = value_heads(rms_norm(ckv, p['mla_kv_norm_g']) @ p['mla_w_ukv'], MLA_HEADS)
    k_nope, v = kv[..., :MLA_NOPE], kv[..., MLA_NOPE:]
    kr = kr[:, None]
    if rope is not None:
        kr = apply_rope(kr, *rope)
    k = jnp.concatenate([k_nope, jnp.broadcast_to(kr, k_nope.shape[:-1] + (MLA_ROPE,))], axis=-1)
    return k, v


def hyena_filters(n, p):
    t = jnp.linspace(0.0, 1.0, n, dtype=jnp.float32)[:, None]
    bands = (FILT_EMB - 1) // 2
    w = (2.0 * math.pi / n) * jnp.arange(n, dtype=jnp.float32)[:, None]
    f = jnp.linspace(1e-4, bands - 1, bands, dtype=jnp.float32)[None, :]
    z = jnp.concatenate([t, jnp.cos(f * w), -jnp.sin(f * w)], axis=-1)
    hid = jnp.sin(p['filt_freq'][0] * (z @ p['filt_w1'] + p['filt_b1']))
    hid = jnp.sin(p['filt_freq'][1] * (hid @ p['filt_w2'] + p['filt_b2']))
    h = (hid @ p['filt_w3']).astype(jnp.float32).reshape(n, HYENA_ORDER, 2, HYENA_WIDTH)
    deltas = jnp.abs(jnp.linspace(math.log(DECAY_TARGET) / SLOW_DECAY, math.log(DECAY_TARGET) / FAST_DECAY,
                                  HYENA_WIDTH, dtype=jnp.float32))
    h = h * jnp.exp(-t * deltas)[:, None, None, :]
    return h / jnp.sum(jnp.abs(h), axis=0, keepdims=True)


def centred_long_conv(u, h_fwd, h_bwd):
    n = u.shape[1]
    k = jnp.concatenate([h_fwd, jnp.zeros_like(h_fwd[:1]), h_bwd[:-1][::-1]], axis=0)
    u_f = jnp.fft.rfft(u.astype(jnp.float32), n=2 * n, axis=1)
    k_f = jnp.fft.rfft(k, axis=0)
    y = jnp.fft.irfft(u_f * k_f[None], n=2 * n, axis=1)[:, :n]
    return y.astype(u.dtype)


def hyena_branch(z, p):
    n = z.shape[1]
    z = depthwise_conv(z, p['hyena_short_w']) + p['hyena_short_b']
    x1, x2, v = _split(z, (HYENA_WIDTH, HYENA_WIDTH, HYENA_WIDTH))
    h = hyena_filters(n, p)
    for o, gate in enumerate((x1, x2)):
        v = gate * (centred_long_conv(v, h[:, o, 0], h[:, o, 1]) + p['hyena_skip'][o] * v)
    return v


def conformer_branch(z, p):
    a, b = _split(z, (CONF_WIDTH, CONF_WIDTH))
    u = depthwise_conv(a * jax.nn.sigmoid(b), p['conf_dw_w'])
    return jax.nn.silu(layer_norm(u, p['conf_ln_g'], p['conf_ln_b']))


def merge_branches(ys, g, p):
    gates = jax.nn.sigmoid(g.reshape(*g.shape[:-1], N_BRANCH, D_MODEL))
    acc, start = 0.0, 0
    for i, (y, w) in enumerate(zip(ys, BRANCH_WIDTHS)):
        acc = acc + gates[..., i, :] * (y @ p['w_branch'][start:start + w])
        start += w
    return acc @ p['w_out']


def token_mixer(u_lat, u_ctx, p, lam, lam_init, rope_diff, rope_mla, with_ctx_out):
    dq_l, dk_l, dv_l, hy_l, cf_l, cq_l, ckv_l, kr_l, g_l = _split(u_lat @ p['w_in'], IN_SPLITS)
    dq_c, dk_c, dv_c, hy_c, cf_c, cq_c, ckv_c, kr_c, g_c = _split(u_ctx @ p['w_in'], IN_SPLITS)
    dk_c, dv_c = diff_heads(dk_c), value_heads(dv_c, DIFF_HEADS)
    mk_c, mv_c = mla_keys_values(ckv_c, kr_c, p, None)
    dk_all = jnp.concatenate([dk_c, apply_rope(diff_heads(dk_l), *rope_diff)], axis=-2)
    dv_all = jnp.concatenate([dv_c, value_heads(dv_l, DIFF_HEADS)], axis=-2)
    mk_l, mv_l = mla_keys_values(ckv_l, kr_l, p, rope_mla)
    mk_all = jnp.concatenate([mk_c, mk_l], axis=-2)
    mv_all = jnp.concatenate([mv_c, mv_l], axis=-2)
    dq = apply_rope(diff_heads(dq_l), *rope_diff)
    a_lat = sweep_query_blocks(lambda qb: diff_attend(qb, dk_all, dv_all, lam), dq)
    m_lat = sweep_query_blocks(lambda qb: softmax_attend(qb, mk_all, mv_all, MLA_SCALE), mla_queries(cq_l, p, rope_mla))
    y_lat = merge_branches((diff_finish(a_lat, p['diff_subln_g'], lam_init), hyena_branch(hy_l, p),
                            conformer_branch(cf_l, p), merge_heads(m_lat)), g_l, p)
    if not with_ctx_out:
        return y_lat, None
    a_ctx = diff_attend(diff_heads(dq_c), dk_c, dv_c, lam)
    m_ctx = softmax_attend(mla_queries(cq_c, p, None), mk_c, mv_c, MLA_SCALE)
    y_ctx = merge_branches((diff_finish(a_ctx, p['diff_subln_g'], lam_init), hyena_branch(hy_c, p),
                            conformer_branch(cf_c, p), merge_heads(m_ctx)), g_c, p)
    return y_lat, y_ctx


def expert_choice_ffn(u, p):
    b, n, d = u.shape
    cap = max(1, EC_CAPACITY * n // N_EXPERTS)
    aff = jax.nn.softmax((u @ p['w_router']).astype(jnp.float32), axis=-1)
    gate, idx = lax.top_k(jnp.swapaxes(aff, 1, 2), cap)
    xe = jax.vmap(lambda ub, ib: ub[ib])(u, idx)
    hg, hu = jnp.split(jnp.einsum('becd,edf->becf', xe, p['w_exp_in']), 2, axis=-1)
    ye = jnp.einsum('becf,efd->becd', jax.nn.silu(hg) * hu, p['w_exp_out']) * gate[..., None].astype(u.dtype)
    return jax.vmap(lambda yb, ib: jnp.zeros((n, d), yb.dtype).at[ib.reshape(-1)].add(yb.reshape(-1, d)))(ye, idx)


def setup_inputs(seed: int = 0) -> dict:
    key = jax.random.key(seed)
    ks = iter(jax.random.split(key, 40))

    def nrm(shape, scale):
        return scale * jax.random.normal(next(ks), shape, jnp.float32)

    def gain(shape):
        return 1.0 + nrm(shape, 0.02)

    L, D = DEPTH, D_MODEL
    return {
        'x': nrm((BATCH, SEQ, D), 1.0),
        'c': nrm((BATCH, D), 1.0),
        'ctx': nrm((BATCH, CTX_LEN, D), 1.0),
        'c_ctx': nrm((D,), 1.0),
        'ada_w': nrm((L, D, 6 * D), 0.5 * D ** -0.5),
        'ada_b': nrm((L, 6 * D), 0.02),
        'norm_mix_g': gain((L, D)),
        'norm_ffn_g': gain((L, D)),
        'w_in': nrm((L, D, IN_WIDTH), D ** -0.5),
        'diff_lambda': nrm((L, 4, DIFF_HEAD_DIM), 0.1),
        'diff_subln_g': gain((L, DIFF_V_DIM)),
        'hyena_short_w': nrm((L, HYENA_SHORT, HYENA_PROJ), HYENA_SHORT ** -0.5),
        'hyena_short_b': nrm((L, HYENA_PROJ), 0.02),
        'filt_w1': nrm((L, FILT_EMB, FILT_HIDDEN), FILT_EMB ** -0.5),
        'filt_b1': nrm((L, FILT_HIDDEN), 0.02),
        'filt_freq': gain((L, 2, FILT_HIDDEN)),
        'filt_w2': nrm((L, FILT_HIDDEN, FILT_HIDDEN), FILT_HIDDEN ** -0.5),
        'filt_b2': nrm((L, FILT_HIDDEN), 0.02),
        'filt_w3': nrm((L, FILT_HIDDEN, HYENA_ORDER * 2 * HYENA_WIDTH), FILT_HIDDEN ** -0.5),
        'hyena_skip': nrm((L, HYENA_ORDER, HYENA_WIDTH), 0.5),
        'conf_dw_w': nrm((L, CONF_KERNEL, CONF_WIDTH), CONF_KERNEL ** -0.5),
        'conf_ln_g': gain((L, CONF_WIDTH)),
        'conf_ln_b': nrm((L, CONF_WIDTH), 0.02),
        'mla_q_norm_g': gain((L, MLA_Q_RANK)),
        'mla_kv_norm_g': gain((L, MLA_KV_RANK)),
        'mla_w_uq': nrm((L, MLA_Q_RANK, MLA_HEADS * (MLA_NOPE + MLA_ROPE)), MLA_Q_RANK ** -0.5),
        'mla_w_ukv': nrm((L, MLA_KV_RANK, MLA_HEADS * (MLA_NOPE + MLA_V)), MLA_KV_RANK ** -0.5),
        'w_branch': nrm((L, MIX_WIDTH, D), 512 ** -0.5),
        'w_out': nrm((L, D, D), D ** -0.5),
        'w_router': nrm((L, D, N_EXPERTS), D ** -0.5),
        'w_exp_in': nrm((L, N_EXPERTS, D, 2 * EXPERT_HIDDEN), D ** -0.5),
        'w_exp_out': nrm((L, N_EXPERTS, EXPERT_HIDDEN, D), EXPERT_HIDDEN ** -0.5),
        'final_norm_g': gain((D,)),
    }


def reference(x, c, ctx, c_ctx, ada_w, ada_b, norm_mix_g, norm_ffn_g, w_in, diff_lambda, diff_subln_g,
              hyena_short_w, hyena_short_b, filt_w1, filt_b1, filt_freq, filt_w2, filt_b2, filt_w3, hyena_skip,
              conf_dw_w, conf_ln_g, conf_ln_b, mla_q_norm_g, mla_kv_norm_g, mla_w_uq, mla_w_ukv,
              w_branch, w_out, w_router, w_exp_in, w_exp_out, final_norm_g):
    n_lat = x.shape[1]
    rope_diff = axial_rope_tables(n_lat, DIFF_HEAD_DIM)
    rope_mla = axial_rope_tables(n_lat, MLA_ROPE)
    s_lat = jax.nn.silu(c)
    s_ctx = jax.nn.silu(c_ctx)[None]
    h_lat, h_ctx = x, ctx
    for l in range(DEPTH):
        last = l == DEPTH - 1
        p = dict(w_in=w_in[l], diff_subln_g=diff_subln_g[l], hyena_short_w=hyena_short_w[l],
                 hyena_short_b=hyena_short_b[l], filt_w1=filt_w1[l], filt_b1=filt_b1[l], filt_freq=filt_freq[l],
                 filt_w2=filt_w2[l], filt_b2=filt_b2[l], filt_w3=filt_w3[l], hyena_skip=hyena_skip[l],
                 conf_dw_w=conf_dw_w[l], conf_ln_g=conf_ln_g[l], conf_ln_b=conf_ln_b[l],
                 mla_q_norm_g=mla_q_norm_g[l], mla_kv_norm_g=mla_kv_norm_g[l], mla_w_uq=mla_w_uq[l],
                 mla_w_ukv=mla_w_ukv[l], w_branch=w_branch[l], w_out=w_out[l], w_router=w_router[l],
                 w_exp_in=w_exp_in[l], w_exp_out=w_exp_out[l])
        mod_lat = jnp.split((s_lat @ ada_w[l] + ada_b[l])[:, None, :], 6, axis=-1)
        mod_ctx = jnp.split((s_ctx @ ada_w[l] + ada_b[l])[:, None, :], 6, axis=-1)
        lam_init = 0.8 - 0.6 * math.exp(-0.3 * l)
        lq1, lk1, lq2, lk2 = diff_lambda[l].astype(jnp.float32)
        lam = jnp.exp(jnp.sum(lq1 * lk1)) - jnp.exp(jnp.sum(lq2 * lk2)) + lam_init
        u_lat = modulate(rms_norm(h_lat, norm_mix_g[l]), mod_lat[0], mod_lat[1])
        u_ctx = modulate(rms_norm(h_ctx, norm_mix_g[l]), mod_ctx[0], mod_ctx[1])
        y_lat, y_ctx = token_mixer(u_lat, u_ctx, p, lam, lam_init, rope_diff, rope_mla, not last)
        h_lat = h_lat + mod_lat[2] * y_lat
        u_lat = modulate(rms_norm(h_lat, norm_ffn_g[l]), mod_lat[3], mod_lat[4])
        h_lat = h_lat + mod_lat[5] * expert_choice_ffn(u_lat, p)
        if not last:
            h_ctx = h_ctx + mod_ctx[2] * y_ctx
            u_ctx = modulate(rms_norm(h_ctx, norm_ffn_g[l]), mod_ctx[3], mod_ctx[4])
            h_ctx = h_ctx + mod_ctx[5] * expert_choice_ffn(u_ctx, p)
    return rms_norm(h_lat, final_norm_g)
```

```cpp
#define MK_ONE_LAUNCH 1
#include <hip/hip_runtime.h>
#include <cstdio>
#include <cstdint>
#include <cstddef>

#define LAS __attribute__((address_space(3)))
typedef unsigned short bf16_t;
typedef short bf16x8 __attribute__((ext_vector_type(8)));
typedef short s16x4 __attribute__((ext_vector_type(4)));
typedef float f32x4 __attribute__((ext_vector_type(4)));
typedef float f32x2 __attribute__((ext_vector_type(2)));
typedef float f32x16 __attribute__((ext_vector_type(16)));
typedef unsigned u32x4 __attribute__((ext_vector_type(4)));
typedef unsigned u32x2 __attribute__((ext_vector_type(2)));

constexpr int D = 1024, NB = 2, SEQ = 16384, NCTX = 256, KVLEN = SEQ + NCTX, DEPTH = 2, GRIDW = 64;
constexpr int RL = NB * SEQ, RC = NB * NCTX, ROWS = RL + RC;
constexpr int NIN = 7328, NPRE = 3232, NPREP = 3328;
constexpr int NE = 16, CAPL = 2048, CAPC = 32, EH = 1024;
constexpr int XROWS = NE * 4096 + NE * 256;
constexpr float EPS = 1e-6f;
constexpr int NT = 512;

enum { I_X = 0, I_C, I_CTX, I_CCTX, I_ADAW, I_ADAB, I_GMIX, I_GFFN, I_WIN, I_DLAM, I_SUBLN, I_HSW, I_HSB, I_FW1, I_FB1, I_FFREQ, I_FW2, I_FB2, I_FW3, I_HSKIP,
       I_CDW, I_CLNG, I_CLNB, I_MQG, I_MKVG, I_WUQ, I_WUKV, I_WBR, I_WOUT, I_WROUTER, I_WEIN, I_WEOUT, I_FNORM, N_INPUTS };

constexpr size_t al256(size_t x) { return (x + 255) / 256 * 256; }
constexpr size_t WS_CTL = 0;
constexpr size_t CTL_BYTES = 65536;
constexpr size_t WS_MOD = WS_CTL + CTL_BYTES;
constexpr size_t WS_LAM = WS_MOD + al256((size_t)2 * 3 * 6144 * 4);
constexpr size_t WS_HID2 = WS_LAM + 256;
constexpr size_t WS_HID2C = WS_HID2 + (size_t)2 * SEQ * 64 * 4;
constexpr size_t WS_RS = WS_HID2C + (size_t)2 * NCTX * 64 * 4;
constexpr size_t WS_AFFT = WS_RS + al256((size_t)2 * ROWS * 4);
constexpr size_t WS_IDX = WS_AFFT + (size_t)(2 * 16 * SEQ + 2 * 16 * NCTX) * 4;
constexpr size_t WS_GATEV = WS_IDX + (size_t)(2 * 16 * CAPL + 2 * 16 * CAPC) * 4;
constexpr size_t WS_INV = WS_GATEV + (size_t)(2 * 16 * CAPL + 2 * 16 * CAPC) * 4;
constexpr size_t WS_HCTX = WS_INV + (size_t)ROWS * 16 * 4;
constexpr size_t WS_HC = WS_HCTX + (size_t)RC * D * 4;
constexpr size_t WS_GROW = WS_HC + (size_t)1024 * NCTX * 4;
constexpr size_t WS_WIN = WS_GROW + al256((size_t)XROWS * 4);
constexpr size_t WS_WG = WS_WIN + (size_t)2 * NPREP * D * 2;
constexpr size_t WS_WB = WS_WG + (size_t)2 * 4096 * D * 2;
constexpr size_t WS_WO = WS_WB + (size_t)2 * 4 * 1024 * 512 * 2;
constexpr size_t WS_WMLA = WS_WO + (size_t)2 * D * D * 2;
constexpr size_t WS_WEIN = WS_WMLA + (size_t)2 * 1024 * 384 * 2;
constexpr size_t WS_WEOUT = WS_WEIN + (size_t)NE * 2048 * D * 2;
constexpr size_t WS_U = WS_WEOUT + (size_t)NE * D * EH * 2;
constexpr size_t WS_Y = WS_U + (size_t)ROWS * D * 2;
constexpr size_t WS_R1 = WS_Y + (size_t)ROWS * 1280 * 2;
constexpr size_t WS_ZD = WS_R1;
constexpr size_t WS_ZH = WS_ZD + (size_t)ROWS * 1536 * 2;
constexpr size_t WS_ZC = WS_ZH + (size_t)ROWS * 768 * 2;
constexpr size_t WS_ZM = WS_ZC + (size_t)ROWS * 512 * 2;
constexpr size_t WS_SCRX = WS_ZM + (size_t)ROWS * 512 * 2;
constexpr size_t SCR_PER_BLOCK = 196608;
constexpr size_t WS_HYT = WS_ZM + (size_t)256 * SCR_PER_BLOCK;
constexpr size_t WS_HF = WS_HYT + (size_t)(2 * 768 * SEQ + 2 * 768 * NCTX) * 2;
constexpr size_t WS_KR = WS_HF + (size_t)1024 * SEQ * 2;
constexpr size_t WS_R1END_MIX = WS_KR + (size_t)ROWS * 32 * 2;
constexpr size_t WS_QM = WS_ZH;
constexpr size_t WS_HYO = WS_QM + (size_t)ROWS * 1024 * 2;
static_assert(WS_HYO + (size_t)(2 * 256 * SEQ + 2 * 256 * NCTX) * 2 <= WS_ZM, "QM/KVM/HYO must fit in ZH+ZC");
static_assert(WS_ZM + (size_t)256 * SCR_PER_BLOCK >= WS_SCRX, "scratch covers ZM");
constexpr size_t WS_P = WS_R1;
constexpr size_t WS_ACC = WS_Y;
constexpr size_t WS_XE = WS_R1;
constexpr size_t WS_HID = WS_XE + (size_t)XROWS * D * 2;
constexpr size_t WS_R1END_MOE = WS_HID + (size_t)XROWS * EH * 2;
constexpr size_t WS_R1END_P = WS_P + (size_t)ROWS * 4096 * 2;
constexpr size_t cmax(size_t a, size_t b) { return a > b ? a : b; }
constexpr size_t WS_END = cmax(WS_R1END_MIX, cmax(WS_R1END_MOE, WS_R1END_P));
static_assert(WS_END <= (size_t)660 * 1000 * 1000, "workspace budget");

__device__ __forceinline__ unsigned cvt_pk_bf16(float lo, float hi) { unsigned r; asm("v_cvt_pk_bf16_f32 %0, %1, %2" : "=v"(r) : "v"(lo), "v"(hi)); return r; }
__device__ __forceinline__ float bf2f(bf16_t b) { return __uint_as_float(((unsigned)b) << 16); }
__device__ __forceinline__ float bflo(unsigned w) { return __uint_as_float(w << 16); }
__device__ __forceinline__ float bfhi(unsigned w) { return __uint_as_float(w & 0xffff0000u); }
__device__ __forceinline__ bf16_t f2bf(float f) { return (bf16_t)(cvt_pk_bf16(f, 0.f) & 0xffffu); }
__device__ __forceinline__ float wave_sum(float v) {
#pragma unroll
    for (int o = 1; o < 64; o <<= 1) v += __shfl_xor(v, o);
    return v;
}
__device__ __forceinline__ float sigmoidf_(float x) { return __builtin_amdgcn_rcpf(1.0f + __expf(-x)); }
__device__ __forceinline__ float siluf_(float x) { return x * sigmoidf_(x); }
__device__ __forceinline__ int row_vec(int row) { return row < SEQ ? 0 : (row < RL ? 1 : 2); }

__device__ __forceinline__ int ltid() { int t = threadIdx.x; asm volatile("" : "+v"(t)); return t; }
struct Args { const float* in[N_INPUTS]; float* out; unsigned char* ws; int ph_lo, ph_hi; };

namespace pg8 {
constexpr int BM = 256, BK = 64, HALF = 128, HTB = HALF * BK * 2, STAGE_BYTES = 8 * HTB, NXCD = 8, WGM = 8;
__host__ __device__ __forceinline__ int lds_byte(int r, int c) { const int st = (r >> 4) * 2 + (c >> 5), rr = r & 15, cc = c & 31, ob = rr * 64 + cc * 2; return st * 1024 + (ob ^ (((ob >> 9) & 1) << 5)); }
__host__ __device__ __forceinline__ void stage_rc(int b, int& R, int& C) { const int st = b / 1024, sb = b % 1024, swz = sb ^ (((sb >> 9) & 1) << 5); R = (st >> 1) * 16 + swz / 64; C = (st & 1) * 32 + (swz % 64) / 2; }
__host__ __device__ __forceinline__ int perm32(int rho) { const int n = rho >> 4, i = rho & 15; return 8 * (i >> 2) + 4 * n + (i & 3); }
struct Unit { int pm, pn, nt, tag; const char* a; const char* b; };
struct Gemm { const bf16_t* A; const bf16_t* Bt; int M, N, K, lda, ldb; int gshift, gsplit; size_t bgs; };
struct StaticOrder {
    int nM, nN, nwg, G, c; Gemm g;
    __device__ void init(const Gemm& g_, int G_, int c_) { g = g_; nM = g.M / BM; nN = g.N / BM; nwg = nM * nN; G = G_; c = c_; }
    __device__ bool map(int i, int& pm, int& pn) const {
        const long L = (long)i * G + c; if (L >= nwg) return false;
        int wgid = (int)L; { const int q = nwg / NXCD, r = nwg % NXCD, xcd = wgid % NXCD, off = wgid / NXCD; wgid = (xcd < r ? xcd * (q + 1) : r * (q + 1) + (xcd - r) * q) + off; }
        const int nig = WGM * nN, gid = wgid / nig, fm = gid * WGM, gsz = (nM - fm) < WGM ? (nM - fm) : WGM;
        pm = fm + ((wgid % nig) % gsz); pn = (wgid % nig) / gsz; return true;
    }
    __device__ bool next(int i, Unit& u) const {
        if (!map(i, u.pm, u.pn)) return false;
        u.nt = g.K / BK; u.tag = 0; u.a = (const char*)g.A + (size_t)u.pm * BM * g.lda * 2;
        u.b = (const char*)g.Bt + (g.gshift >= 0 ? (size_t)(u.pm < g.gsplit ? (u.pm >> g.gshift) : (u.pm - g.gsplit)) * g.bgs * 2 : (size_t)0) + (size_t)u.pn * BM * g.ldb * 2;
        return true;
    }
};
struct BranchOrder : StaticOrder {
    __device__ bool next(int i, Unit& u) const {
        int q; if (!map(i, u.pm, q)) return false;
        const int br = q >> 2; u.pn = q & 3; u.tag = br; u.nt = br == 0 ? 8 : 4;
        const int start = br == 0 ? 0 : 512 + 256 * (br - 1);
        u.a = (const char*)g.A + ((size_t)u.pm * BM * g.lda + start) * 2; u.b = (const char*)g.Bt + ((size_t)br * 1024 * 512 + (size_t)u.pn * BM * 512) * 2;
        return true;
    }
};
template <class Epi, class Sched, bool GATHER = false>
__device__ __forceinline__ void gemm_phase(LAS unsigned char* lds, const Gemm g, const Sched& S, const Epi& E, const int* gidx = nullptr) {
    const int tid = ltid(), wid = __builtin_amdgcn_readfirstlane(tid >> 6), lane = tid & 63, wr = wid >> 2, wc = wid & 3, fr = lane & 15, fq = lane >> 4;
    unsigned voffA[2], voffB[2];
#pragma unroll
    for (int i = 0; i < 2; ++i) { int R, C; stage_rc(tid * 16 + i * 8192, R, C); const int Rb = Epi::PERM ? ((R & ~31) + perm32(R & 31)) : R;
        voffA[i] = (unsigned)(R * g.lda + C) * 2u; voffB[i] = (unsigned)(Rb * g.ldb + C) * 2u; }
    const size_t kstep = (size_t)(BK * 2);
    unsigned gvc[2][2] = {{0u, 0u}, {0u, 0u}}, gvn[2][2] = {{0u, 0u}, {0u, 0u}}; unsigned gR[2] = {0u, 0u}, gC[2] = {0u, 0u};
    const char* gA = (const char*)g.A;
    if constexpr (GATHER) {
#pragma unroll
        for (int i = 0; i < 2; ++i) { int R, C; stage_rc(tid * 16 + i * 8192, R, C); gR[i] = (unsigned)R; gC[i] = (unsigned)C * 2u; }
        LAS unsigned short* li = (LAS unsigned short*)(lds + STAGE_BYTES);
        for (int q = tid; q < 16 * 256; q += 512) { int pm, pn; if (S.map(q >> 8, pm, pn)) li[q] = (unsigned short)gidx[pm * 256 + (q & 255)]; }
        __syncthreads();
    }
#define PG8_GV(dst, u) do { const LAS unsigned short* _li = (const LAS unsigned short*)(lds + STAGE_BYTES) + (u) * 256; _Pragma("unroll") for (int _h = 0; _h < 2; ++_h) _Pragma("unroll") for (int _i = 0; _i < 2; ++_i) \
        dst[_h][_i] = (unsigned)_li[_h * HALF + gR[_i]] * (unsigned)(g.lda * 2) + gC[_i]; } while (0)
#define PG8_STAGE_G(bufoff, gbase, v0, v1) do { __builtin_amdgcn_global_load_lds((const unsigned*)((gbase) + (v0)), (LAS unsigned*)(lds + (bufoff) + ldsw), 16, 0, 0); \
        __builtin_amdgcn_global_load_lds((const unsigned*)((gbase) + (v1)), (LAS unsigned*)(lds + (bufoff) + ldsw + 8192), 16, 0, 0); } while (0)
    const size_t hstepA = (size_t)HALF * g.lda * 2, hstepB = (size_t)HALF * g.ldb * 2;
    const unsigned ldsw = (unsigned)wid * 1024u;
    const int aoff = lds_byte(wr * 64 + fr, fq * 8), boff = lds_byte(wc * 32 + fr, fq * 8);
#define PG8_SA(b, h) (((b) * 2 + (h)) * HTB)
#define PG8_SB(b, h) ((4 + (b) * 2 + (h)) * HTB)
#define PG8_STAGE(bufoff, gbase, voff) do { _Pragma("unroll") for (int _i = 0; _i < 2; ++_i) \
        __builtin_amdgcn_global_load_lds((const unsigned*)((const char*)(gbase) + (voff)[_i]), (LAS unsigned*)(lds + (bufoff) + ldsw + _i * 8192), 16, 0, 0); } while (0)
#define PG8_LDA(dst, b, h) do { _Pragma("unroll") for (int m = 0; m < 4; ++m) _Pragma("unroll") for (int k = 0; k < 2; ++k) dst[m][k] = *(const LAS bf16x8*)(lds + PG8_SA(b, h) + aoff + m * 2048 + k * 1024); } while (0)
#define PG8_LDB(dst, b, h) do { _Pragma("unroll") for (int n = 0; n < 2; ++n) _Pragma("unroll") for (int k = 0; k < 2; ++k) dst[n][k] = *(const LAS bf16x8*)(lds + PG8_SB(b, h) + boff + n * 2048 + k * 1024); } while (0)
#define PG8_MMA(ai, bj, At, Bt) do { __builtin_amdgcn_s_setprio(1); _Pragma("unroll") for (int m = 0; m < 4; ++m) _Pragma("unroll") for (int n = 0; n < 2; ++n) _Pragma("unroll") for (int k = 0; k < 2; ++k) \
        acc[ai][bj][m][n] = __builtin_amdgcn_mfma_f32_16x16x32_bf16(Bt[n][k], At[m][k], acc[ai][bj][m][n], 0, 0, 0); __builtin_amdgcn_s_setprio(0); } while (0)
#define PG8_WAIT_V(n) asm volatile("s_waitcnt vmcnt(" #n ")" ::: "memory")
#define PG8_WAIT_L(n) asm volatile("s_waitcnt lgkmcnt(" #n ")" ::: "memory")
#define PG8_BAR __builtin_amdgcn_s_barrier()
#define PG8_SCHED __builtin_amdgcn_sched_barrier(0)
    Unit cur, nxt; int ui = 0;
    if (!S.next(0, cur)) return;
    f32x4 acc[2][2][4][2];
#pragma unroll
    for (int a = 0; a < 2; ++a)
#pragma unroll
        for (int b = 0; b < 2; ++b)
#pragma unroll
            for (int m = 0; m < 4; ++m)
#pragma unroll
                for (int n = 0; n < 2; ++n) acc[a][b][m][n] = (f32x4){0.f, 0.f, 0.f, 0.f};
    bf16x8 At[4][2], B0[2][2], B1[2][2];
    const char* cA = cur.a; const char* cB = cur.b;
    if constexpr (GATHER) { PG8_GV(gvc, 0);
        PG8_STAGE(PG8_SB(0, 0), cB, voffB); PG8_STAGE_G(PG8_SA(0, 0), gA, gvc[0][0], gvc[0][1]); PG8_STAGE(PG8_SB(0, 1), cB + hstepB, voffB); PG8_STAGE_G(PG8_SA(0, 1), gA, gvc[1][0], gvc[1][1]); }
    else {
    PG8_STAGE(PG8_SB(0, 0), cB, voffB); PG8_STAGE(PG8_SA(0, 0), cA, voffA); PG8_STAGE(PG8_SB(0, 1), cB + hstepB, voffB); PG8_STAGE(PG8_SA(0, 1), cA + hstepA, voffA); }
    if (wr == 1) PG8_BAR;
    PG8_WAIT_V(4); PG8_BAR;
    PG8_STAGE(PG8_SB(1, 0), cB + kstep, voffB); if constexpr (GATHER) PG8_STAGE_G(PG8_SA(1, 0), gA + kstep, gvc[0][0], gvc[0][1]); else PG8_STAGE(PG8_SA(1, 0), cA + kstep, voffA); PG8_STAGE(PG8_SB(1, 1), cB + hstepB + kstep, voffB);
    PG8_WAIT_V(6); PG8_BAR;
    for (;;) {
        const bool has_next = S.next(ui + 1, nxt);
        const char* nA = has_next ? nxt.a : cA; const char* nB = has_next ? nxt.b : cB;
        if constexpr (GATHER) { if (has_next) PG8_GV(gvn, ui + 1); }
        const int nt = cur.nt;
        for (int t = 0; t < nt; t += 2) {
            const bool last = (t == nt - 2);
            const char* a1 = cA + (size_t)(t + 1) * kstep;
            const char* a2 = last ? nA : cA + (size_t)(t + 2) * kstep; const char* b2 = last ? nB : cB + (size_t)(t + 2) * kstep;
            const char* a3 = a2 + kstep; const char* b3 = b2 + kstep;
            const char* ga1 = gA + (size_t)(t + 1) * kstep; const char* ga2 = last ? gA : gA + (size_t)(t + 2) * kstep;
            const unsigned g00 = last ? gvn[0][0] : gvc[0][0], g01 = last ? gvn[0][1] : gvc[0][1], g10 = last ? gvn[1][0] : gvc[1][0], g11 = last ? gvn[1][1] : gvc[1][1];
            PG8_LDB(B0, 0, 0); PG8_SCHED; PG8_LDA(At, 0, 0); if constexpr (GATHER) PG8_STAGE_G(PG8_SA(1, 1), ga1, gvc[1][0], gvc[1][1]); else PG8_STAGE(PG8_SA(1, 1), a1 + hstepA, voffA);
            PG8_WAIT_L(8); PG8_BAR; PG8_WAIT_L(0); PG8_MMA(0, 0, At, B0); PG8_BAR; PG8_SCHED;
            PG8_LDB(B1, 0, 1); PG8_STAGE(PG8_SB(0, 0), b2, voffB);
            PG8_BAR; PG8_WAIT_L(0); PG8_MMA(0, 1, At, B1); PG8_BAR;
            PG8_LDA(At, 0, 1); if constexpr (GATHER) PG8_STAGE_G(PG8_SA(0, 0), ga2, g00, g01); else PG8_STAGE(PG8_SA(0, 0), a2, voffA);
            PG8_BAR; PG8_WAIT_L(0); PG8_MMA(1, 0, At, B0); PG8_BAR; PG8_SCHED;
            PG8_STAGE(PG8_SB(0, 1), b2 + hstepB, voffB);
            PG8_WAIT_V(6); PG8_BAR; PG8_MMA(1, 1, At, B1); PG8_BAR;
            PG8_LDB(B0, 1, 0); PG8_SCHED; PG8_LDA(At, 1, 0); if constexpr (GATHER) PG8_STAGE_G(PG8_SA(0, 1), ga2, g10, g11); else PG8_STAGE(PG8_SA(0, 1), a2 + hstepA, voffA);
            PG8_WAIT_L(8); PG8_BAR; PG8_WAIT_L(0); PG8_MMA(0, 0, At, B0); PG8_BAR; PG8_SCHED;
            PG8_LDB(B1, 1, 1); PG8_STAGE(PG8_SB(1, 0), b3, voffB);
            PG8_BAR; PG8_WAIT_L(0); PG8_MMA(0, 1, At, B1); PG8_BAR;
            PG8_LDA(At, 1, 1); if constexpr (GATHER) PG8_STAGE_G(PG8_SA(1, 0), ga2 + kstep, g00, g01); else PG8_STAGE(PG8_SA(1, 0), a3, voffA);
            PG8_BAR; PG8_WAIT_L(0); PG8_MMA(1, 0, At, B0); PG8_BAR; PG8_SCHED;
            PG8_STAGE(PG8_SB(1, 1), b3 + hstepB, voffB);
            PG8_WAIT_V(6); PG8_BAR; PG8_MMA(1, 1, At, B1); PG8_BAR;
        }
        { int frl = fr, fql = fq; asm volatile("" : "+v"(frl), "+v"(fql)); E(acc, cur, wr, wc, frl, fql); }
        if (!has_next) break;
#pragma unroll
        for (int a = 0; a < 2; ++a)
#pragma unroll
            for (int b = 0; b < 2; ++b)
#pragma unroll
                for (int m = 0; m < 4; ++m)
#pragma unroll
                    for (int n = 0; n < 2; ++n) acc[a][b][m][n] = (f32x4){0.f, 0.f, 0.f, 0.f};
        cur = nxt; cA = nA; cB = nB; ++ui;
        if constexpr (GATHER) { gvc[0][0] = gvn[0][0]; gvc[0][1] = gvn[0][1]; gvc[1][0] = gvn[1][0]; gvc[1][1] = gvn[1][1]; }
    }
    PG8_WAIT_V(0);
    if (wr == 0) PG8_BAR;
    PG8_BAR;
#undef PG8_SA
#undef PG8_SB
#undef PG8_STAGE
#undef PG8_STAGE_G
#undef PG8_GV
#undef PG8_LDA
#undef PG8_LDB
#undef PG8_MMA
#undef PG8_WAIT_V
#undef PG8_WAIT_L
#undef PG8_BAR
#undef PG8_SCHED
}
}

namespace att {
constexpr int KVBLK = 64;
constexpr int SHM_K = KVBLK * 256, SHM_V = KVBLK * 256;
constexpr int SHM_ATTN = 4 * SHM_K + 4 * SHM_V + 8 * 64 * 4;
#define KSWZ(row, colB) ((row) * 256 + ((colB) ^ (((row) & 7) << 4)))
#define SBAR() __builtin_amdgcn_sched_barrier(0)
__device__ __forceinline__ int crow(int r, int hi) { return (r & 3) + 8 * (r >> 2) + 4 * hi; }

template <int NQB>
__device__ __forceinline__ void k_load(bf16x8 (&k0)[NQB], bf16x8 (&k1)[NQB], const char* Ks, int r32, int hi, int koff) {
#pragma unroll
    for (int d0 = 0; d0 < NQB; ++d0) { const int cb = (koff + d0 * 16 + hi * 8) * 2;
        k0[d0] = *reinterpret_cast<const bf16x8*>(Ks + KSWZ(r32, cb)); k1[d0] = *reinterpret_cast<const bf16x8*>(Ks + KSWZ(32 + r32, cb)); }
}
__device__ __forceinline__ bf16x8 mk8(unsigned a, unsigned b, unsigned c, unsigned d) { u32x4 w = {a, b, c, d}; return *reinterpret_cast<bf16x8*>(&w); }
template <int NCB> __device__ __forceinline__ int v_st(int k, int c) { const int kk = (k & ~0xC) | ((k & 4) << 1) | ((k & 8) >> 1); return ((kk >> 3) * NCB + (c >> 5)) * 512 + ((kk & 7) * 32 + (c & 31)) * 2; }
__device__ __forceinline__ int v_rd_base(int lane) { return ((lane & 3) << 3) | (((lane >> 2) & 3) << 6) | (((lane >> 4) & 1) << 5) | (((lane >> 5) & 1) << 8); }
template <int NCB> constexpr int v_rd_off(int d0, int ks, int half) { return d0 * 512 + ks * (1024 * NCB) + half * (512 * NCB); }
template <int OFF> __device__ __forceinline__ s16x4 tr_read(int vb) {
    s16x4 r; asm volatile("ds_read_b64_tr_b16 %0, %1 offset:%2" : "=&v"(r) : "v"(vb), "i"(OFF) : "memory"); return r;
}
template <int NCB, int D0> __device__ __forceinline__ void tr8(int vb, s16x4 (&f)[8]) {
    f[0] = tr_read<v_rd_off<NCB>(D0, 0, 0)>(vb); f[1] = tr_read<v_rd_off<NCB>(D0, 0, 1)>(vb); f[2] = tr_read<v_rd_off<NCB>(D0, 1, 0)>(vb); f[3] = tr_read<v_rd_off<NCB>(D0, 1, 1)>(vb);
    f[4] = tr_read<v_rd_off<NCB>(D0, 2, 0)>(vb); f[5] = tr_read<v_rd_off<NCB>(D0, 2, 1)>(vb); f[6] = tr_read<v_rd_off<NCB>(D0, 3, 0)>(vb); f[7] = tr_read<v_rd_off<NCB>(D0, 3, 1)>(vb);
}
#define PK(L, H) (bf16x8){L[0], L[1], L[2], L[3], H[0], H[1], H[2], H[3]}
template <int NQB, int NCB, bool RELOAD, int SH>
__device__ __forceinline__ void seg_qk(f32x16& n0, f32x16& n1, f32x16& c0, f32x16& c1, float& l_reg, bf16x8& pa0, bf16x8& pa1, bf16x8& pa2, bf16x8& pa3,
                                       bf16x8 (&k0)[NQB], bf16x8 (&k1)[NQB], const bf16x8* qr, const char* Kn, int r32, int hi, int koff, int vbn, s16x4 (&f)[8]) {
    constexpr int NM = 2 * NQB;
    unsigned w0[8], w1[8];
    n0 = f32x16{}; n1 = f32x16{};
#pragma unroll
    for (int i = 0; i < NM; ++i) {
        const int d0 = i >> 1;
        if (i & 1) n1 = __builtin_amdgcn_mfma_f32_32x32x16_bf16(k1[d0], qr[d0], n1, 0, 0, 0);
        else       n0 = __builtin_amdgcn_mfma_f32_32x32x16_bf16(k0[d0], qr[d0], n0, 0, 0, 0);
        if (RELOAD && (i & 1)) { const int cb = (koff + d0 * 16 + hi * 8) * 2;
            k0[d0] = *reinterpret_cast<const bf16x8*>(Kn + KSWZ(r32, cb)); k1[d0] = *reinterpret_cast<const bf16x8*>(Kn + KSWZ(32 + r32, cb)); }
        const int k = (NM == 8) ? i : ((i % 3 == 2) ? -1 : (i / 3) * 2 + (i % 3));
        if (k >= 0) {
            if (SH != 3) { c1[2 * k] = __builtin_amdgcn_exp2f(c1[2 * k]); c1[2 * k + 1] = __builtin_amdgcn_exp2f(c1[2 * k + 1]); }
            w0[k] = cvt_pk_bf16(c0[2 * k], c0[2 * k + 1]);
            if (k > 0) { l_reg += c1[2 * k - 2]; l_reg += c1[2 * k - 1]; asm volatile("" : "+v"(l_reg)); w1[k - 1] = cvt_pk_bf16(c1[2 * k - 2], c1[2 * k - 1]); }
        }
        if (i == NM - 1) { l_reg += c1[14]; l_reg += c1[15]; asm volatile("" : "+v"(l_reg)); w1[7] = cvt_pk_bf16(c1[14], c1[15]); }
        if (i == NM / 2 && SH != 4) tr8<NCB, 0>(vbn, f);
        SBAR();
    }
    pa0 = mk8(w0[0], w0[1], w0[2], w0[3]); pa1 = mk8(w0[4], w0[5], w0[6], w0[7]); pa2 = mk8(w1[0], w1[1], w1[2], w1[3]); pa3 = mk8(w1[4], w1[5], w1[6], w1[7]);
    asm volatile("s_nop 7" : "+v"(pa0), "+v"(pa1), "+v"(pa2), "+v"(pa3));
}
__device__ __forceinline__ void sm2_only(f32x16& c0, f32x16& c1, float& l_reg, bf16x8& pa0, bf16x8& pa1, bf16x8& pa2, bf16x8& pa3) {
    unsigned w0[8], w1[8];
#pragma unroll
    for (int k = 0; k < 8; ++k) { c1[2 * k] = __builtin_amdgcn_exp2f(c1[2 * k]); c1[2 * k + 1] = __builtin_amdgcn_exp2f(c1[2 * k + 1]); }
#pragma unroll
    for (int k = 0; k < 8; ++k) { l_reg += c1[2 * k]; l_reg += c1[2 * k + 1]; w0[k] = cvt_pk_bf16(c0[2 * k], c0[2 * k + 1]); w1[k] = cvt_pk_bf16(c1[2 * k], c1[2 * k + 1]); }
    pa0 = mk8(w0[0], w0[1], w0[2], w0[3]); pa1 = mk8(w0[4], w0[5], w0[6], w0[7]); pa2 = mk8(w1[0], w1[1], w1[2], w1[3]); pa3 = mk8(w1[4], w1[5], w1[6], w1[7]);
    asm volatile("s_nop 7" : "+v"(pa0), "+v"(pa1), "+v"(pa2), "+v"(pa3));
}
template <int NCB, bool SM1, int W0, int SH>
__device__ __forceinline__ void seg_pv(f32x16* o, int vb, bf16x8 pa0, bf16x8 pa1, bf16x8 pa2, bf16x8 pa3, s16x4 (&f)[8], f32x16& n0, float& l_reg) {
    s16x4 g[8];
    if (SH == 4) {
#pragma unroll
        for (int q = 0; q < 8; ++q) g[q] = f[q]; }
    constexpr int STEP = NCB == 4 ? 2 : 1;
#define SEG_PV_FILL(J) do { if (SM1) { constexpr int _j = (J); \
        if (_j % STEP == 0 && SH != 3) { constexpr int _k = _j / STEP; n0[2 * _k] = __builtin_amdgcn_exp2f(n0[2 * _k]); n0[2 * _k + 1] = __builtin_amdgcn_exp2f(n0[2 * _k + 1]); } \
        if (STEP == 2 ? (_j % 2 == 1) : (_j > 0)) { constexpr int _k = STEP == 2 ? _j / 2 : (_j > 0 ? _j - 1 : 0); l_reg += n0[2 * _k]; l_reg += n0[2 * _k + 1]; asm volatile("" : "+v"(l_reg)); } } } while (0)
#define SEG_PV_GROUP(D0, CUR, NXT, HASNEXT, WAITN) do { constexpr int _da = (D0), _db = SH == 2 ? ((D0) + 1) % NCB : (D0); \
        asm volatile("s_waitcnt lgkmcnt(%0)" :: "n"(WAITN) : "memory"); SBAR(); \
        if (SH != 5) o[_da] = __builtin_amdgcn_mfma_f32_32x32x16_bf16(pa0, PK(CUR[0], CUR[1]), o[_da], 0, 0, 0); else asm volatile("" :: "v"(CUR[0]), "v"(CUR[1]), "v"(pa0)); \
        if constexpr (HASNEXT && SH != 4) tr8<NCB, (D0) + 1 < NCB ? (D0) + 1 : 0>(vb, NXT); SEG_PV_FILL(4 * (D0) + 0); SBAR(); \
        if (SH != 5) o[_db] = __builtin_amdgcn_mfma_f32_32x32x16_bf16(pa1, PK(CUR[2], CUR[3]), o[_db], 0, 0, 0); else asm volatile("" :: "v"(CUR[2]), "v"(CUR[3]), "v"(pa1)); SEG_PV_FILL(4 * (D0) + 1); SBAR(); \
        if (SH != 5) o[_da] = __builtin_amdgcn_mfma_f32_32x32x16_bf16(pa2, PK(CUR[4], CUR[5]), o[_da], 0, 0, 0); else asm volatile("" :: "v"(CUR[4]), "v"(CUR[5]), "v"(pa2)); SEG_PV_FILL(4 * (D0) + 2); SBAR(); \
        if (SH != 5) o[_db] = __builtin_amdgcn_mfma_f32_32x32x16_bf16(pa3, PK(CUR[6], CUR[7]), o[_db], 0, 0, 0); else asm volatile("" :: "v"(CUR[6]), "v"(CUR[7]), "v"(pa3)); SEG_PV_FILL(4 * (D0) + 3); SBAR(); } while (0)
    if constexpr (NCB == 4) { SEG_PV_GROUP(0, f, g, true, W0); SEG_PV_GROUP(1, g, f, true, 0); SEG_PV_GROUP(2, f, g, true, 0); SEG_PV_GROUP(3, g, f, false, 0); }
    else { SEG_PV_GROUP(0, f, g, true, W0); SEG_PV_GROUP(1, g, f, false, 0); if (SM1) { l_reg += n0[14]; l_reg += n0[15]; asm volatile("" : "+v"(l_reg)); } }
#undef SEG_PV_GROUP
#undef SEG_PV_FILL
}
#undef PK

struct Tensors { const char* base;   const bf16_t* ZD; const bf16_t* QM;   const bf16_t* KR; bf16_t* Y; const float* subln_g; float lam, one_minus_lam_init; };
template <bool DIFF, int SH = 0>
__device__ __forceinline__ void attn_unit(const Tensors& T, int b, int h, int q0, bool ctxq, char* lds) {
    constexpr int NQB = DIFF ? 4 : 6, NCB = DIFF ? 4 : 2, NLD = DIFF ? 4 : 3;
    const int tid = ltid(), wid = tid >> 6, lane = tid & 63, r32 = lane & 31, hi = lane >> 5;
    float* li_l = (float*)(lds + 4 * SHM_V + 4 * SHM_K) + wid * 64;
    const int map = DIFF ? (wid >> 2) : 0, wq = DIFF ? (wid & 3) : wid;
    const int koff = DIFF ? map * 64 : 0;
    const int NTILES = ctxq ? NCTX / KVBLK : KVLEN / KVBLK;
    const int qrow = (ctxq ? RL + b * NCTX : b * SEQ) + q0 + wq * 32 + r32;
    constexpr bool HALF = SH != 0;
    const bool act = SH != 9 || wid < 4;
    float l_reg = 0; f32x16 o[NCB]; bf16x8 qr[NQB];
#pragma unroll
    for (int d = 0; d < NCB; ++d) o[d] = f32x16{};
    {
        const bf16_t* Qw = DIFF ? T.ZD + (size_t)qrow * 1536 + h * 128 + map * 64 + hi * 8 : T.QM + (size_t)qrow * 1024 + h * 96 + hi * 8;
#pragma unroll
        for (int d0 = 0; d0 < NQB; ++d0) qr[d0] = *reinterpret_cast<const bf16x8*>(Qw + d0 * 16);
    }
#define KROW(kt) ((int)((ctxq || (kt) < NCTX / KVBLK) ? RL + b * NCTX + (kt) * KVBLK : b * SEQ + (kt) * KVBLK - NCTX))
    const int krow_t = tid >> 4, kc = (tid & 15) ^ (krow_t & 7);
    const int vkk = DIFF ? (tid >> 7) * 8 + ((tid & 31) >> 2) : (tid >> 6) * 8 + ((tid & 31) >> 2);
    const int vkey = vkk;
    const int vcol = (DIFF ? ((tid >> 5) & 3) : ((tid >> 5) & 1)) * 32 + (tid & 3) * 8;
    const char* gb = T.base; unsigned kofs, kstrB, vofs; bool k_ok = true;
    const unsigned zd_o = (unsigned)((const char*)T.ZD - T.base), qm_o = (unsigned)((const char*)T.QM - T.base), kr_o = (unsigned)((const char*)T.KR - T.base);
    constexpr unsigned vstrB = DIFF ? 3072u : 2048u;
    if constexpr (DIFF) { kofs = zd_o + (unsigned)(512 + h * 128 + krow_t * 1536 + kc * 8) * 2u; kstrB = 3072u; vofs = zd_o + (unsigned)(1024 + h * 128 + vkey * 1536 + vcol) * 2u; }
    else { k_ok = kc < 12;
        if (kc < 8) { kofs = qm_o + (unsigned)(384 + h * 128 + krow_t * 1024 + kc * 8) * 2u; kstrB = 2048u; } else { kofs = kr_o + (unsigned)(krow_t * 32 + (kc - 8) * 8) * 2u; kstrB = 64u; }
        vofs = qm_o + (unsigned)(384 + h * 128 + 64 + vkey * 1024 + vcol) * 2u; }
    LAS unsigned char* ldsl = (LAS unsigned char*)lds; const unsigned ldsw = (unsigned)__builtin_amdgcn_readfirstlane(wid) * 1024u;
#define KOFF(bb, ss) (((bb) * 2 + (ss)) * SHM_K)
#define VOFF(bb, ss) (4 * SHM_K + ((bb) * 2 + (ss)) * SHM_V)
#define DMA16(gp, loff) if (SH != 6) __builtin_amdgcn_global_load_lds((const unsigned*)(gp), (LAS unsigned*)(ldsl + (loff) + ldsw), 16, 0, 0)
#define DMA_K(bb, ss, kt) do { const unsigned _kr = (unsigned)KROW(kt); if (k_ok) { const unsigned _o = DIFF ? kofs + _kr * 3072u : kofs + _kr * kstrB; DMA16(gb + _o, KOFF(bb, ss)); DMA16(gb + (_o + 32u * (DIFF ? 3072u : kstrB)), KOFF(bb, ss) + 8192); } } while (0)
#define DMA_V(bb, ss, kt) do { const unsigned _o = vofs + (unsigned)KROW(kt) * vstrB; DMA16(gb + _o, VOFF(bb, ss)); if constexpr (DIFF) DMA16(gb + (_o + 32u * vstrB), VOFF(bb, ss) + 8192); } while (0)
    f32x16 sE0, sE1, sO0, sO1; bf16x8 pa0, pa1, pa2, pa3; bf16x8 kf0[NQB], kf1[NQB]; s16x4 vf[8];
    const int NR = NTILES / 2;
    const int vbase = (int)(uintptr_t)lds + v_rd_base(lane);
#define ROUND(cb, more, t0) do { \
    k_load<NQB>(kf0, kf1, lds + KOFF(cb, 0), r32, hi, koff); \
    if (more) { DMA_K(1 - (cb), 0, (t0) + 2); DMA_K(1 - (cb), 1, (t0) + 3); } \
    DMA_V(cb, 1, (t0) + 1); if (more) DMA_V(1 - (cb), 0, (t0) + 2); \
    SBAR(); if (act) { \
    seg_qk<NQB, NCB, true, SH>(sE0, sE1, sO0, sO1, l_reg, pa0, pa1, pa2, pa3, kf0, kf1, qr, lds + KOFF(cb, 1), r32, hi, koff, vbase + VOFF(1 - (cb), 1), vf); \
    seg_pv<NCB, true, NQB, SH>(o, vbase + VOFF(1 - (cb), 1), pa0, pa1, pa2, pa3, vf, sE0, l_reg); \
    seg_qk<NQB, NCB, false, SH>(sO0, sO1, sE0, sE1, l_reg, pa0, pa1, pa2, pa3, kf0, kf1, qr, lds, r32, hi, koff, vbase + VOFF(cb, 0), vf); \
    seg_pv<NCB, true, 0, SH>(o, vbase + VOFF(cb, 0), pa0, pa1, pa2, pa3, vf, sO0, l_reg); } \
    if (SH == 7) asm volatile("s_waitcnt vmcnt(8)" ::: "memory"); else asm volatile("s_waitcnt vmcnt(0)" ::: "memory"); __syncthreads(); } while (0)
    DMA_K(0, 0, 0); DMA_K(0, 1, 1); DMA_V(0, 0, 0);
    { u32x4 z = {0u, 0u, 0u, 0u}; *reinterpret_cast<u32x4*>(lds + VOFF(1, 1) + tid * 16) = z; *reinterpret_cast<u32x4*>(lds + VOFF(1, 1) + 8192 + tid * 16) = z; }
#pragma unroll
    for (int r = 0; r < 16; ++r) { sO0[r] = 0.f; sO1[r] = -1.0e30f; }
    if (SH == 4) {
#pragma unroll
        for (int q = 0; q < 8; ++q) vf[q] = *reinterpret_cast<const s16x4*>(&qr[q % NQB]); }
    asm volatile("s_waitcnt vmcnt(0)" ::: "memory"); __syncthreads();
    if (wid >= 4) __builtin_amdgcn_s_setprio(1);
    for (int r = 0; r < NR; r += 2) {
        ROUND(0, true, 2 * r);
        { const bool more = r + 2 < NR; ROUND(1, more, 2 * r + 2); }
    }
    __builtin_amdgcn_s_setprio(0);
    sm2_only(sO0, sO1, l_reg, pa0, pa1, pa2, pa3);
    tr8<NCB, 0>(vbase + VOFF(1, 1), vf);
    seg_pv<NCB, false, 0, SH>(o, vbase + VOFF(1, 1), pa0, pa1, pa2, pa3, vf, sO0, l_reg);
#undef ROUND
#undef DMA_K
#undef DMA_V
#undef DMA16
#undef KOFF
#undef VOFF
    asm volatile("s_waitcnt vmcnt(0)" ::: "memory");
    int zz = 0; asm volatile("" : "+v"(zz));
    const int r32e = r32 + zz, hie = hi + zz;
    { auto rr = __builtin_amdgcn_permlane32_swap(__float_as_uint(l_reg), __float_as_uint(l_reg), false, false); l_reg = __uint_as_float(rr[0]) + __uint_as_float(rr[1]); }
    if (hie == 0) li_l[r32e] = l_reg; asm volatile("s_waitcnt lgkmcnt(0)" ::: "memory");
    float rli[16];
#pragma unroll
    for (int r = 0; r < 16; ++r) rli[r] = __builtin_amdgcn_rcpf(li_l[crow(r, hie)]);
    const int orow0 = (ctxq ? RL + b * NCTX : b * SEQ) + q0 + wq * 32;
    if constexpr (HALF) {
        float chk = l_reg;
#pragma unroll
        for (int d0 = 0; d0 < NCB; ++d0)
#pragma unroll
            for (int r = 0; r < 16; ++r) chk += o[d0][r];
        if (chk == 123456.789f) T.Y[(size_t)orow0 * 1280] = f2bf(chk);
        __syncthreads();
    } else if constexpr (!DIFF) {
        bf16_t* Ow = T.Y + (size_t)orow0 * 1280 + 1024 + h * 64;
#pragma unroll
        for (int r = 0; r < 16; ++r) { const int orow = crow(r, hie);
#pragma unroll
            for (int d0 = 0; d0 < NCB; ++d0) Ow[(size_t)orow * 1280 + d0 * 32 + r32e] = f2bf(o[d0][r] * rli[r]); }
        __syncthreads();
    } else {
        __syncthreads();
        float* XB = (float*)lds + wq * (32 * 128);
        if (map == 1) {
#pragma unroll
            for (int r = 0; r < 16; ++r) { const int orow = crow(r, hie); const float s = rli[r] * T.lam;
#pragma unroll
                for (int d0 = 0; d0 < 4; ++d0) XB[orow * 128 + d0 * 32 + r32e] = o[d0][r] * s; }
        }
        __syncthreads();
        if (map == 0) {
            float gcol[4];
#pragma unroll
            for (int d0 = 0; d0 < 4; ++d0) gcol[d0] = T.subln_g[d0 * 32 + r32e + zz] * T.one_minus_lam_init;
            bf16_t* Ow = T.Y + (size_t)orow0 * 1280 + h * 128;
#pragma unroll
            for (int r = 0; r < 16; ++r) { const int orow = crow(r, hie); float a[4]; float ss = 0.f;
#pragma unroll
                for (int d0 = 0; d0 < 4; ++d0) { a[d0] = o[d0][r] * rli[r] - XB[orow * 128 + d0 * 32 + r32e]; ss += a[d0] * a[d0]; }
#pragma unroll
                for (int m = 1; m < 32; m <<= 1) ss += __shfl_xor(ss, m);
                const float rs = __builtin_amdgcn_rsqf(ss * (1.0f / 128.0f) + EPS);
#pragma unroll
                for (int d0 = 0; d0 < 4; ++d0) Ow[(size_t)orow * 1280 + d0 * 32 + r32e] = f2bf(a[d0] * rs * gcol[d0]); }
        }
        __syncthreads();
    }
#undef KROW
}
#undef KSWZ
#undef SBAR
}

#ifndef FFT_HOST
#define FFT_HD __device__ __forceinline__
#define FFT_BUF LAS hcx*
#define FFT_CBUF const LAS hcx*
#define FFT_COS(r) __builtin_amdgcn_cosf(r)
#define FFT_SIN(r) __builtin_amdgcn_sinf(r)
#endif
typedef _Float16 hcx __attribute__((ext_vector_type(2)));
typedef float cpx __attribute__((ext_vector_type(2)));
constexpr int FFT_N = 16384;
constexpr int FFT_BUF_ELEMS = FFT_N + FFT_N / 32;
constexpr int FFT_TA = 15 * 1024, FFT_TB = 15 * 64, FFT_TC = 15 * 4;
constexpr int FFT_TW_ELEMS = FFT_TA + FFT_TB + FFT_TC;
constexpr int FFT_LDS_BYTES = (FFT_BUF_ELEMS + FFT_TW_ELEMS) * 4;
FFT_HD int fpad(int i) { return i + (i >> 5); }
FFT_HD hcx hmk(float re, float im) { hcx r; r.x = (_Float16)re; r.y = (_Float16)im; return r; }
FFT_HD hcx hmul(hcx a, hcx w) { const hcx ax = {a.x, a.x}, ay = {a.y, a.y}, wr = {(_Float16)(-w.y), w.x}; return ax * w + ay * wr; }
FFT_HD hcx hconj(hcx a) { hcx r; r.x = a.x; r.y = (_Float16)(-a.y); return r; }
FFT_HD cpx cmul(cpx a, cpx b) { cpx r; r.x = a.x * b.x - a.y * b.y; r.y = a.x * b.y + a.y * b.x; return r; }
template <bool INV> FFT_HD cpx twid(float r) { cpx w; w.x = FFT_COS(r); const float s = FFT_SIN(r); w.y = INV ? s : -s; return w; }
template <bool INV> FFT_HD void dft4(hcx& a0, hcx& a1, hcx& a2, hcx& a3) {
    const hcx t0 = a0 + a2, t1 = a0 - a2, t2 = a1 + a3, d = a1 - a3;
    hcx t3; if (INV) { t3.x = (_Float16)(-d.y); t3.y = d.x; } else { t3.x = d.y; t3.y = (_Float16)(-d.x); }
    a0 = t0 + t2; a1 = t1 + t3; a2 = t0 - t2; a3 = t1 - t3;
}
template <bool INV> FFT_HD void dft16(hcx (&x)[16]) {
#pragma unroll
    for (int n1 = 0; n1 < 4; ++n1) dft4<INV>(x[n1], x[n1 + 4], x[n1 + 8], x[n1 + 12]);
    const float C1 = 0.92387953251128674f, S1 = 0.38268343236508977f, C2 = 0.70710678118654752f;
#define FFT_TW(idx, cr, ci) do { const hcx w = hmk((cr), INV ? -(ci) : (ci)); x[idx] = hmul(x[idx], w); } while (0)
    FFT_TW(1 + 4 * 1, C1, -S1);  FFT_TW(2 + 4 * 1, C2, -C2);  FFT_TW(3 + 4 * 1, S1, -C1);
    FFT_TW(1 + 4 * 2, C2, -C2);  FFT_TW(2 + 4 * 2, 0.f, -1.f); FFT_TW(3 + 4 * 2, -C2, -C2);
    FFT_TW(1 + 4 * 3, S1, -C1);  FFT_TW(2 + 4 * 3, -C2, -C2); FFT_TW(3 + 4 * 3, -C1, S1);
#undef FFT_TW
#pragma unroll
    for (int k2 = 0; k2 < 4; ++k2) dft4<INV>(x[4 * k2], x[4 * k2 + 1], x[4 * k2 + 2], x[4 * k2 + 3]);
#define FFT_SW(a, b) do { const hcx t = x[a]; x[a] = x[b]; x[b] = t; } while (0)
    FFT_SW(1, 4); FFT_SW(2, 8); FFT_SW(3, 12); FFT_SW(6, 9); FFT_SW(7, 13); FFT_SW(11, 14);
#undef FFT_SW
}
FFT_HD void fft_fill_tables(FFT_BUF tw, int tid) {
    for (int i = tid; i < FFT_TW_ELEMS; i += NT) {
        int idx = i, M, L;
        if (idx < FFT_TA) { M = 1024; L = 16384; } else if (idx < FFT_TA + FFT_TB) { idx -= FFT_TA; M = 64; L = 1024; } else { idx -= FFT_TA + FFT_TB; M = 4; L = 64; }
        const int p = idx / M + 1, j = idx - (p - 1) * M; const cpx w = twid<false>((float)(j * p) / (float)L);
        tw[i] = hmk(w.x, w.y);
    }
}
template <bool INV> FFT_HD void fft_pass16(FFT_BUF buf, FFT_CBUF tbl, int M, int tid) {
#pragma unroll 1
    for (int i = 0; i < 2; ++i) {
        const int bf = tid + NT * i, blk = bf / M, j = bf - blk * M, base = blk * 16 * M + j;
        hcx x[16];
#pragma unroll
        for (int q = 0; q < 16; ++q) x[q] = buf[fpad(base + M * q)];
        if (INV) {
#pragma unroll
            for (int p = 1; p < 16; ++p) x[p] = hmul(x[p], hconj(tbl[(p - 1) * M + j]));
        }
        dft16<INV>(x);
        if (!INV) {
#pragma unroll
            for (int p = 1; p < 16; ++p) x[p] = hmul(x[p], tbl[(p - 1) * M + j]);
        }
#pragma unroll
        for (int q = 0; q < 16; ++q) buf[fpad(base + M * q)] = x[q];
    }
}
#ifndef FFT_HOST
#define FFT_SYNC() __syncthreads()
FFT_HD void fft_fwd3(FFT_BUF buf, FFT_CBUF tw, int tid) { fft_pass16<false>(buf, tw, 1024, tid); FFT_SYNC(); fft_pass16<false>(buf, tw + FFT_TA, 64, tid); FFT_SYNC(); fft_pass16<false>(buf, tw + FFT_TA + FFT_TB, 4, tid); FFT_SYNC(); }
FFT_HD void fft_inv3(FFT_BUF buf, FFT_CBUF tw, int tid) { fft_pass16<true>(buf, tw + FFT_TA + FFT_TB, 4, tid); FFT_SYNC(); fft_pass16<true>(buf, tw + FFT_TA, 64, tid); FFT_SYNC(); fft_pass16<true>(buf, tw, 1024, tid); FFT_SYNC(); }
#endif
FFT_HD void fft_mid_load(FFT_BUF buf, int tid, int i, hcx (&e)[4]) {
    const int b0 = 4 * (tid + NT * i);
#pragma unroll
    for (int q = 0; q < 4; ++q) e[q] = buf[fpad(b0 + q)];
    dft4<false>(e[0], e[1], e[2], e[3]);
}
FFT_HD void fft_mid_mulstore(FFT_BUF buf, int tid, int i, hcx (&e)[4], const hcx (&k)[4]) {
    const int b0 = 4 * (tid + NT * i);
#pragma unroll
    for (int q = 0; q < 4; ++q) e[q] = hmul(e[q], k[q]);
    dft4<true>(e[0], e[1], e[2], e[3]);
#pragma unroll
    for (int q = 0; q < 4; ++q) buf[fpad(b0 + q)] = e[q];
}

#define WSP(T, off) ((T*)(A.ws + (off)))
__device__ __forceinline__ int gwave() { return blockIdx.x * 8 + (ltid() >> 6); }
__device__ __forceinline__ int ngwaves() { return gridDim.x * 8; }

template <class F>
__device__ __forceinline__ void tr_item(const float* W, int ldw, F colmap, const float* kscale, bf16_t* WT, int ldd, int ksrc0, int kdst0, int n0, float* scr, int lane, float nscale = 1.0f, int nscale_lim = 0) {
    const int n = n0 + (lane & 31); const int col = colmap(n); const float ns = n < nscale_lim ? nscale : 1.0f;
    float vv[32];
#pragma unroll
    for (int i = 0; i < 32; ++i) { const int kk = 2 * i + (lane >> 5); vv[i] = col >= 0 ? W[(size_t)(ksrc0 + kk) * ldw + col] : 0.f; }
#pragma unroll
    for (int i = 0; i < 32; ++i) { const int kk = 2 * i + (lane >> 5); float v = vv[i]; if (kscale) v *= kscale[ksrc0 + kk]; scr[kk * 33 + (lane & 31)] = v * ns; }
    asm volatile("s_waitcnt lgkmcnt(0)" ::: "memory");
    const int c = lane & 7;
#pragma unroll
    for (int j = 0; j < 4; ++j) { const int nn = (lane >> 3) + 8 * j; const float* s = scr + (8 * c) * 33 + nn;
        u32x4 o; o.x = cvt_pk_bf16(s[0 * 33], s[1 * 33]); o.y = cvt_pk_bf16(s[2 * 33], s[3 * 33]); o.z = cvt_pk_bf16(s[4 * 33], s[5 * 33]); o.w = cvt_pk_bf16(s[6 * 33], s[7 * 33]);
        *(u32x4*)(WT + (size_t)(n0 + nn) * ldd + kdst0 + 8 * c) = o; }
    asm volatile("s_waitcnt lgkmcnt(0)" ::: "memory");
}
__device__ __forceinline__ void conv_small_weights(const Args& A, int l, char* lds) {
    float* scr = (float*)lds + (ltid() >> 6) * (64 * 33); const int lane = ltid() & 63;
    constexpr int C_WIN = 16 * (NPREP / 32), C_WG = 16 * 128, C_WB = (8 + 4 + 4 + 4) * 32, C_WO = 16 * 32, C_WM = 6 * 32, C_ALL = C_WIN + C_WG + C_WB + C_WO + C_WM;
    for (int it = gwave(); it < C_ALL; it += ngwaves()) {
        int r = it;
        if (r < C_WIN) { const int kb = r / (NPREP / 32), nb = r % (NPREP / 32);
            tr_item(A.in[I_WIN] + (size_t)l * D * NIN, NIN, [](int n) { return n < NPRE ? n : -1; }, nullptr, WSP(bf16_t, WS_WIN) + (size_t)l * NPREP * D, D, kb * 64, kb * 64, nb * 32, scr, lane, 0.125f * 1.4426950408889634f, 512); continue; }
        r -= C_WIN;
        if (r < C_WG) { const int kb = r / 128, nb = r % 128;
            tr_item(A.in[I_WIN] + (size_t)l * D * NIN, NIN, [](int n) { const int pn = n >> 8, cl = n & 255, bj = cl >> 7, rr = cl & 127, wc = rr >> 5, r2 = rr & 31, nn = r2 >> 4, r3 = r2 & 15;
                                                                     return NPRE + (2 * bj + nn) * 1024 + pn * 64 + wc * 16 + r3; }, nullptr, WSP(bf16_t, WS_WG) + (size_t)l * 4096 * D, D, kb * 64, kb * 64, nb * 32, scr, lane); continue; }
        r -= C_WG;
        if (r < C_WB) { int br, kb; const int q = r / 32, nb = r % 32;
            if (q < 8) { br = 0; kb = q; } else if (q < 12) { br = 1; kb = q - 8; } else if (q < 16) { br = 2; kb = q - 12; } else { br = 3; kb = q - 16; }
            const int start = br == 0 ? 0 : 512 + 256 * (br - 1), Ki = br == 0 ? 512 : 256;
            tr_item(A.in[I_WBR] + (size_t)l * 1280 * D + (size_t)start * D, D, [](int n) { return n; }, nullptr, WSP(bf16_t, WS_WB) + ((size_t)l * 4 + br) * 1024 * 512, 512, kb * 64, kb * 64, nb * 32, scr, lane); continue; }
        r -= C_WB;
        if (r < C_WO) { const int kb = r / 32, nb = r % 32;
            tr_item(A.in[I_WOUT] + (size_t)l * D * D, D, [](int n) { return n; }, nullptr, WSP(bf16_t, WS_WO) + (size_t)l * D * D, D, kb * 64, kb * 64, nb * 32, scr, lane); continue; }
        r -= C_WO;
        { const int kb = r / 32, nb = r % 32; bf16_t* dst = WSP(bf16_t, WS_WMLA) + (size_t)l * 1024 * 384;
            if (kb < 4) tr_item(A.in[I_WUQ] + (size_t)l * 256 * 384, 384, [](int n) { return n < 384 ? n : -1; }, A.in[I_MQG] + l * 256, dst, 384, kb * 64, kb * 64, nb * 32, scr, lane, 0.10206207261596575f * 1.4426950408889634f, 384);
            else tr_item(A.in[I_WUKV] + (size_t)l * 128 * 512, 512, [](int n) { return (n >= 384 && n < 896) ? n - 384 : -1; }, A.in[I_MKVG] + l * 128, dst, 384, (kb - 4) * 64, kb * 64, nb * 32, scr, lane); }
    }
}
__device__ __forceinline__ void conv_expert_weights(const Args& A, int l, char* lds, int first_block = 0) {
    float* scr = (float*)lds + (ltid() >> 6) * (64 * 33); const int lane = ltid() & 63;
    constexpr int C_IN = NE * 16 * 64, C_OUT = NE * 16 * 32;
    if ((int)blockIdx.x < first_block) return;
    for (int it = ((int)blockIdx.x - first_block) * 8 + (ltid() >> 6); it < C_IN + C_OUT; it += ((int)gridDim.x - first_block) * 8) {
        if (it < C_IN) { const int e = it / (16 * 64), r = it % (16 * 64), kb = r / 64, nb = r % 64;
            tr_item(A.in[I_WEIN] + ((size_t)l * NE + e) * D * 2048, 2048, [](int n) { const int f = (n >> 8) * 128 + (n & 127); return ((n >> 7) & 1) ? 1024 + f : f; }, nullptr,
                    WSP(bf16_t, WS_WEIN) + (size_t)e * 2048 * D, D, kb * 64, kb * 64, nb * 32, scr, lane); }
        else { const int r0 = it - C_IN, e = r0 / (16 * 32), r = r0 % (16 * 32), kb = r / 32, nb = r % 32;
            tr_item(A.in[I_WEOUT] + ((size_t)l * NE + e) * EH * D, D, [](int n) { return n; }, nullptr, WSP(bf16_t, WS_WEOUT) + (size_t)e * D * EH, EH, kb * 64, kb * 64, nb * 32, scr, lane); }
    }
}
__device__ __forceinline__ void compute_mod(const Args& A, char* lds) {
    float* red = (float*)lds; float* sc = red + 8 * 3 * 64;
    const int tid = ltid(), w = tid >> 6, lane = tid & 63;
    if ((int)blockIdx.x < 2 * 96) { for (int i = tid; i < 3 * 1024; i += NT) sc[i] = siluf_(i < 2048 ? A.in[I_C][i] : A.in[I_CCTX][i - 2048]); __syncthreads(); }
    for (int it = blockIdx.x; it < 2 * 96; it += gridDim.x) {
        const int l = it / 96, col = (it % 96) * 64 + lane;
        const float* W = A.in[I_ADAW] + (size_t)l * D * 6144;
        float a0 = 0.f, a1 = 0.f, a2 = 0.f;
#pragma unroll 1
        for (int k0 = w * 128; k0 < w * 128 + 128; k0 += 32) { float wv[32];
#pragma unroll
            for (int q = 0; q < 32; ++q) wv[q] = W[(size_t)(k0 + q) * 6144 + col];
#pragma unroll
            for (int q = 0; q < 32; ++q) { a0 += sc[k0 + q] * wv[q]; a1 += sc[1024 + k0 + q] * wv[q]; a2 += sc[2048 + k0 + q] * wv[q]; } }
        red[(w * 3 + 0) * 64 + lane] = a0; red[(w * 3 + 1) * 64 + lane] = a1; red[(w * 3 + 2) * 64 + lane] = a2;
        __syncthreads();
        if (tid < 192) { const int v = tid >> 6; float s = 0.f;
#pragma unroll
            for (int q = 0; q < 8; ++q) s += red[(q * 3 + v) * 64 + lane];
            WSP(float, WS_MOD)[((size_t)l * 3 + v) * 6144 + col] = s + A.in[I_ADAB][l * 6144 + col]; }
        __syncthreads();
    }
    if (blockIdx.x == gridDim.x - 1 && tid < 128) {
        const int l = tid >> 6; const float* dl = A.in[I_DLAM] + l * 256;
        const float s1 = wave_sum(dl[lane] * dl[64 + lane]), s2 = wave_sum(dl[128 + lane] * dl[192 + lane]);
        const float lam_init = l == 0 ? 0.2f : 0.35550907f;
        if (lane == 0) WSP(float, WS_LAM)[l] = __expf(s1) - __expf(s2) + lam_init;
    }
}
__device__ __forceinline__ void compute_hid2(const Args& A, char* lds) {
    float* zs = (float*)lds; float* hs = zs + 128 * 34;
    const int tid = ltid(), tl = tid & 127, og = tid >> 7;
    constexpr int IT_L = SEQ / 128, IT_C = NCTX / 128, IT = 2 * (IT_L + IT_C);
    for (int it = (blockIdx.x + gridDim.x - 192u % gridDim.x) % gridDim.x; it < IT; it += gridDim.x) {
        const int l = it / (IT_L + IT_C), r = it % (IT_L + IT_C); const bool isc = r >= IT_L; const int n = isc ? NCTX : SEQ, t = (isc ? r - IT_L : r) * 128 + tl;
        if (og == 0) {
            const float tn = (float)t / (float)(n - 1), tr = (float)t / (float)n;
            zs[tl * 34] = tn;
            for (int k = 0; k < 16; ++k) { const float f = 1e-4f + (float)k * ((15.0f - 1e-4f) / 15.0f); const float rv = f * tr;
                zs[tl * 34 + 1 + k] = __builtin_amdgcn_cosf(rv); zs[tl * 34 + 17 + k] = -__builtin_amdgcn_sinf(rv); }
        }
        __syncthreads();
        float acc[16];
        { const float* w1 = A.in[I_FW1] + l * 33 * 64; const float* b1 = A.in[I_FB1] + l * 64;
#pragma unroll
          for (int j = 0; j < 16; ++j) acc[j] = b1[og * 16 + j];
          for (int k = 0; k < 33; ++k) { const float z = zs[tl * 34 + k];
#pragma unroll
              for (int j = 0; j < 16; ++j) acc[j] += z * w1[k * 64 + og * 16 + j]; }
          const float* fq = A.in[I_FFREQ] + l * 128;
#pragma unroll
          for (int j = 0; j < 16; ++j) hs[tl * 65 + og * 16 + j] = __builtin_amdgcn_sinf(fq[og * 16 + j] * acc[j] * 0.15915494309189535f); }
        __syncthreads();
        { const float* w2 = A.in[I_FW2] + l * 64 * 64; const float* b2 = A.in[I_FB2] + l * 64;
#pragma unroll
          for (int j = 0; j < 16; ++j) acc[j] = b2[og * 16 + j];
          for (int k = 0; k < 64; ++k) { const float z = hs[tl * 65 + k];
#pragma unroll
              for (int j = 0; j < 16; ++j) acc[j] += z * w2[k * 64 + og * 16 + j]; }
          const float* fq = A.in[I_FFREQ] + l * 128 + 64;
          float* dst = isc ? WSP(float, WS_HID2C) + ((size_t)l * NCTX + t) * 64 : WSP(float, WS_HID2) + ((size_t)l * SEQ + t) * 64;
#pragma unroll
          for (int j = 0; j < 16; ++j) dst[og * 16 + j] = __builtin_amdgcn_sinf(fq[og * 16 + j] * acc[j] * 0.15915494309189535f); }
        __syncthreads();
    }
}
__device__ __forceinline__ void norm_mod_store(const f32x4 (&v)[4], const float* g, const float* shift, const float* scale, bf16_t* urow, int lane) {
    float ss = 0.f;
#pragma unroll
    for (int j = 0; j < 4; ++j) ss += (v[j].x * v[j].x + v[j].y * v[j].y) + (v[j].z * v[j].z + v[j].w * v[j].w);
    const float rs = 1.0f / sqrtf(wave_sum(ss) * (1.0f / D) + EPS);
#pragma unroll
    for (int j = 0; j < 4; ++j) { const int c = 4 * lane + 256 * j; const f32x4 gg = *(const f32x4*)(g + c), sh = *(const f32x4*)(shift + c), sc = *(const f32x4*)(scale + c);
        const f32x4 u = v[j] * rs * gg * (sc + 1.0f) + sh;
        u32x2 w; w.x = cvt_pk_bf16(u.x, u.y); w.y = cvt_pk_bf16(u.z, u.w); *(u32x2*)(urow + c) = w; }
}
__device__ __forceinline__ void rows_to_u_layer0(const Args& A) {
    const int lane = ltid() & 63;
    for (int row = gwave(); row < ROWS; row += ngwaves()) {
        const float* src = row < RL ? A.in[I_X] + (size_t)row * D : A.in[I_CTX] + (size_t)(row - RL) * D;
        f32x4 v[4];
#pragma unroll
        for (int j = 0; j < 4; ++j) v[j] = *(const f32x4*)(src + 4 * lane + 256 * j);
        const float* mod = WSP(float, WS_MOD) + (size_t)(0 * 3 + row_vec(row)) * 6144;
        norm_mod_store(v, A.in[I_GMIX], mod, mod + 1024, WSP(bf16_t, WS_U) + (size_t)row * D, lane);
    }
}
__device__ __forceinline__ void post_rows(const Args& A) {
    const int lane = ltid() & 63;
    bf16_t* ZD = WSP(bf16_t, WS_ZD); bf16_t* ZM = WSP(bf16_t, WS_ZM); bf16_t* KR = WSP(bf16_t, WS_KR);
    for (int row = gwave(); row < ROWS; row += ngwaves()) {
        const bool lat = row < RL; const int tok = row & (SEQ - 1); const float prow = (float)(tok >> 6), pcol = (float)(tok & 63);
        if (lat) {
            const int blk = lane >> 2, j0 = (lane & 3) * 8; bf16_t* p = ZD + (size_t)row * 1536 + blk * 64 + j0;
            const u32x4 a = *(const u32x4*)p, bq = *(const u32x4*)(p + 32);
            const float pos = j0 < 16 ? prow : pcol; const int jb = j0 & 15;
            float x1[8], x2[8]; const unsigned aw[4] = {a.x, a.y, a.z, a.w}, bw[4] = {bq.x, bq.y, bq.z, bq.w};
#pragma unroll
            for (int e = 0; e < 4; ++e) { x1[2 * e] = bflo(aw[e]); x1[2 * e + 1] = bfhi(aw[e]); x2[2 * e] = bflo(bw[e]); x2[2 * e + 1] = bfhi(bw[e]); }
            float y1[8], y2[8];
#pragma unroll
            for (int e = 0; e < 8; ++e) { const float inv = exp2f(-(float)(jb + e) * (13.287712379549449f / 16.0f)); const float rev = pos * inv * 0.15915494309189535f;
                const float c = __builtin_amdgcn_cosf(rev), s = __builtin_amdgcn_sinf(rev); y1[e] = x1[e] * c - x2[e] * s; y2[e] = x1[e] * s + x2[e] * c; }
            u32x4 oa, ob; oa.x = cvt_pk_bf16(y1[0], y1[1]); oa.y = cvt_pk_bf16(y1[2], y1[3]); oa.z = cvt_pk_bf16(y1[4], y1[5]); oa.w = cvt_pk_bf16(y1[6], y1[7]);
            ob.x = cvt_pk_bf16(y2[0], y2[1]); ob.y = cvt_pk_bf16(y2[2], y2[3]); ob.z = cvt_pk_bf16(y2[4], y2[5]); ob.w = cvt_pk_bf16(y2[6], y2[7]);
            *(u32x4*)p = oa; *(u32x4*)(p + 32) = ob;
        }
        bf16_t* zm = ZM + (size_t)row * 512;
        { const u32x2 q = *(const u32x2*)(zm + 4 * lane); const float a0 = bflo(q.x), a1 = bfhi(q.x), a2 = bflo(q.y), a3 = bfhi(q.y);
          const float rs = 1.0f / sqrtf(wave_sum((a0 * a0 + a1 * a1) + (a2 * a2 + a3 * a3)) * (1.0f / 256.0f) + EPS);
          u32x2 o; o.x = cvt_pk_bf16(a0 * rs, a1 * rs); o.y = cvt_pk_bf16(a2 * rs, a3 * rs); *(u32x2*)(zm + 4 * lane) = o; }
        { float a0 = 0.f, a1 = 0.f, a2 = 0.f, a3 = 0.f; if (lane < 32) { const u32x2 q = *(const u32x2*)(zm + 256 + 4 * lane); a0 = bflo(q.x); a1 = bfhi(q.x); a2 = bflo(q.y); a3 = bfhi(q.y); }
          const float rs = 1.0f / sqrtf(wave_sum((a0 * a0 + a1 * a1) + (a2 * a2 + a3 * a3)) * (1.0f / 128.0f) + EPS);
          if (lane < 32) { u32x2 o; o.x = cvt_pk_bf16(a0 * rs, a1 * rs); o.y = cvt_pk_bf16(a2 * rs, a3 * rs); *(u32x2*)(zm + 256 + 4 * lane) = o; } }
        if (lane < 16) { const float x1 = bf2f(zm[384 + lane]), x2 = bf2f(zm[384 + 16 + lane]); float y1 = x1, y2 = x2;
            if (lat) { const float pos = lane < 8 ? prow : pcol; const float inv = exp2f(-(float)(lane & 7) * (13.287712379549449f / 8.0f)); const float rev = pos * inv * 0.15915494309189535f;
                const float c = __builtin_amdgcn_cosf(rev), s = __builtin_amdgcn_sinf(rev); y1 = x1 * c - x2 * s; y2 = x1 * s + x2 * c; }
            KR[(size_t)row * 32 + lane] = f2bf(y1); KR[(size_t)row * 32 + 16 + lane] = f2bf(y2); }
    }
}
__device__ __forceinline__ void mla_q_rope(const Args& A) {
    const int lane = ltid() & 63; bf16_t* QM = WSP(bf16_t, WS_QM);
    for (int row = gwave(); row < RL; row += ngwaves()) {
        const int tok = row & (SEQ - 1); const int h = lane >> 4, j = lane & 15; bf16_t* p = QM + (size_t)row * 1024 + h * 96 + 64 + j;
        const float x1 = bf2f(p[0]), x2 = bf2f(p[16]); const float pos = j < 8 ? (float)(tok >> 6) : (float)(tok & 63);
        const float inv = exp2f(-(float)(j & 7) * (13.287712379549449f / 8.0f)); const float rev = pos * inv * 0.15915494309189535f;
        const float c = __builtin_amdgcn_cosf(rev), s = __builtin_amdgcn_sinf(rev);
        p[0] = f2bf(x1 * c - x2 * s); p[16] = f2bf(x1 * s + x2 * c);
    }
}

__device__ __forceinline__ void seq_bounds(int row, int& lo, int& hi) { if (row < RL) { lo = row & ~(SEQ - 1); hi = lo + SEQ; } else { lo = RL + ((row - RL) & ~(NCTX - 1)); hi = lo + NCTX; } }

__device__ __forceinline__ void conformer_tiles(const Args& A, int l, char* lds, int nrows) {
    float* glu = (float*)lds; float* ub = glu + 62 * 256;
    const int tid = ltid(), lane = tid & 63, w = tid >> 6, c = tid & 255, half = tid >> 8;
    const bf16_t* ZC = WSP(bf16_t, WS_ZC); bf16_t* Y = WSP(bf16_t, WS_Y);
    float wk[31];
#pragma unroll
    for (int k = 0; k < 31; ++k) wk[k] = A.in[I_CDW][(size_t)l * 31 * 256 + k * 256 + c];
    const f32x4 lg = *(const f32x4*)(A.in[I_CLNG] + l * 256 + 4 * lane), lb = *(const f32x4*)(A.in[I_CLNB] + l * 256 + 4 * lane);
    for (int it = blockIdx.x; it < nrows / 32; it += gridDim.x) {
        const int row0 = it * 32; int lo, hi; seq_bounds(row0, lo, hi);
        for (int idx = tid; idx < 62 * 64; idx += NT) { const int r = idx >> 6, c4 = (idx & 63) * 4, grow = row0 - 15 + r; f32x4 g = {0.f, 0.f, 0.f, 0.f};
            if (grow >= lo && grow < hi) { const u32x2 a = *(const u32x2*)(ZC + (size_t)grow * 512 + c4), b = *(const u32x2*)(ZC + (size_t)grow * 512 + 256 + c4);
                g.x = bflo(a.x) * sigmoidf_(bflo(b.x)); g.y = bfhi(a.x) * sigmoidf_(bfhi(b.x)); g.z = bflo(a.y) * sigmoidf_(bflo(b.y)); g.w = bfhi(a.y) * sigmoidf_(bfhi(b.y)); }
            *(f32x4*)(glu + r * 256 + c4) = g; }
        __syncthreads();
        { float win[46];
#pragma unroll
            for (int k = 0; k < 46; ++k) win[k] = glu[(half * 16 + k) * 256 + c];
#pragma unroll
            for (int q = 0; q < 16; ++q) { float s = 0.f;
#pragma unroll
                for (int k = 0; k < 31; ++k) s += wk[k] * win[q + k];
                ub[(half * 16 + q) * 256 + c] = s; } }
        __syncthreads();
#pragma unroll
        for (int q = 0; q < 4; ++q) { const int tt = w * 4 + q; const f32x4 x = *(const f32x4*)(ub + tt * 256 + 4 * lane);
            const float mu = wave_sum((x.x + x.y) + (x.z + x.w)) * (1.0f / 256.0f); const f32x4 d = x - mu;
            const float var = wave_sum((d.x * d.x + d.y * d.y) + (d.z * d.z + d.w * d.w)) * (1.0f / 256.0f); const float rstd = 1.0f / sqrtf(var + EPS);
            const f32x4 y = d * rstd * lg + lb;
            u32x2 o; o.x = cvt_pk_bf16(siluf_(y.x), siluf_(y.y)); o.y = cvt_pk_bf16(siluf_(y.z), siluf_(y.w));
            *(u32x2*)(Y + (size_t)(row0 + tt) * 1280 + 768 + 4 * lane) = o; }
        __syncthreads();
    }
}
__device__ __forceinline__ void hyena_pre_tiles(const Args& A, int l, char* lds, int nrows) {
    bf16_t* zt = (bf16_t*)lds;
    const int tid = ltid(), lane = tid & 63, w = tid >> 6;
    const bf16_t* ZH = WSP(bf16_t, WS_ZH); bf16_t* HYT = WSP(bf16_t, WS_HYT);
    for (int it = (blockIdx.x + gridDim.x - 16u % gridDim.x) % gridDim.x; it < (nrows / 128) * 3; it += gridDim.x) {
        const int tile = it / 3, cg = it % 3, row0 = tile * 128; int lo, hi; seq_bounds(row0, lo, hi);
        for (int idx = tid; idx < 130 * 32; idx += NT) { const int r = idx >> 5, c8 = (idx & 31) * 8, grow = row0 - 1 + r; u32x4 v = {0u, 0u, 0u, 0u};
            if (grow >= lo && grow < hi) v = *(const u32x4*)(ZH + (size_t)grow * 768 + cg * 256 + c8);
            unsigned* d = (unsigned*)(zt + r * 258 + c8); d[0] = v.x; d[1] = v.y; d[2] = v.z; d[3] = v.w; }
        __syncthreads();
        const bool lat = row0 < RL; const int b = lat ? row0 / SEQ : (row0 - RL) / NCTX, t0 = lat ? row0 % SEQ : (row0 - RL) % NCTX;
        const int gchl = cg * 256 + w * 32 + (lane & 31);
        const float w0l = A.in[I_HSW][(size_t)l * 3 * 768 + gchl], w1l = A.in[I_HSW][(size_t)l * 3 * 768 + 768 + gchl], w2l = A.in[I_HSW][(size_t)l * 3 * 768 + 1536 + gchl], bbl = A.in[I_HSB][l * 768 + gchl];
        for (int q = 0; q < 32; ++q) { const int ch = w * 32 + q, gch = cg * 256 + ch;
            const float w0 = __uint_as_float(__builtin_amdgcn_readlane(__float_as_uint(w0l), q)), w1 = __uint_as_float(__builtin_amdgcn_readlane(__float_as_uint(w1l), q)),
                        w2 = __uint_as_float(__builtin_amdgcn_readlane(__float_as_uint(w2l), q)), bb = __uint_as_float(__builtin_amdgcn_readlane(__float_as_uint(bbl), q));
            const float z0 = bf2f(zt[(2 * lane) * 258 + ch]), z1 = bf2f(zt[(2 * lane + 1) * 258 + ch]), z2 = bf2f(zt[(2 * lane + 2) * 258 + ch]), z3 = bf2f(zt[(2 * lane + 3) * 258 + ch]);
            const float o0 = w0 * z0 + w1 * z1 + w2 * z2 + bb, o1 = w0 * z1 + w1 * z2 + w2 * z3 + bb;
            bf16_t* dst = lat ? HYT + ((size_t)(b * 768 + gch)) * SEQ + t0 : HYT + (size_t)2 * 768 * SEQ + ((size_t)(b * 768 + gch)) * NCTX + t0;
            *(unsigned*)(dst + 2 * lane) = cvt_pk_bf16(o0, o1); }
        __syncthreads();
    }
}
typedef _Float16 f16x8 __attribute__((ext_vector_type(8)));
__device__ __forceinline__ void hyena_filters(const Args& A, int l, char* lds, bool with_ctx) {
    float* h2 = (float*)lds; float* w3s = h2 + 256 * 68;
    const int tid = ltid(), lane = tid & 63, w = tid >> 6, l16 = lane & 15, lg = lane >> 4;
    const int nit = 64 * 8 + (with_ctx ? 8 : 0);
    for (int it = (blockIdx.x + gridDim.x - 32u % gridDim.x) % gridDim.x; it < nit; it += gridDim.x) {
        const bool isc = it >= 512; const int r = isc ? it - 512 : it, tt = r >> 3, ct = r & 7, n = isc ? NCTX : SEQ, t0 = tt * 256, col0 = ct * 128;
        const float* hsrc = isc ? WSP(float, WS_HID2C) + (size_t)l * NCTX * 64 : WSP(float, WS_HID2) + (size_t)l * SEQ * 64;
        for (int idx = tid; idx < 256 * 16; idx += NT) { const int rr = idx >> 4, c4 = (idx & 15) * 4; *(f32x4*)(h2 + rr * 68 + c4) = *(const f32x4*)(hsrc + (size_t)(t0 + rr) * 64 + c4); }
        for (int idx = tid; idx < 64 * 32; idx += NT) { const int j = idx >> 5, c4 = (idx & 31) * 4; *(f32x4*)(w3s + j * 132 + c4) = *(const f32x4*)(A.in[I_FW3] + (size_t)l * 64 * 1024 + j * 1024 + col0 + c4); }
        __syncthreads();
        f16x8 bt[2][2];
#pragma unroll
        for (int tb = 0; tb < 2; ++tb)
#pragma unroll
            for (int ks = 0; ks < 2; ++ks) { const float* hp = h2 + (w * 32 + tb * 16 + l16) * 68 + ks * 32 + lg * 8; const f32x4 x0 = *(const f32x4*)hp, x1 = *(const f32x4*)(hp + 4);
                bt[tb][ks] = (f16x8){(_Float16)x0.x, (_Float16)x0.y, (_Float16)x0.z, (_Float16)x0.w, (_Float16)x1.x, (_Float16)x1.y, (_Float16)x1.z, (_Float16)x1.w}; }
        const int t_l = t0 + w * 32 + l16;
#pragma unroll
        for (int cb = 0; cb < 8; ++cb) {
            f16x8 at[2];
#pragma unroll
            for (int ks = 0; ks < 2; ++ks) { const float* wp = w3s + (ks * 32 + lg * 8) * 132 + cb * 16 + l16;
                at[ks] = (f16x8){(_Float16)wp[0], (_Float16)wp[132], (_Float16)wp[2 * 132], (_Float16)wp[3 * 132], (_Float16)wp[4 * 132], (_Float16)wp[5 * 132], (_Float16)wp[6 * 132], (_Float16)wp[7 * 132]}; }
#pragma unroll
            for (int tb = 0; tb < 2; ++tb) { f32x4 d = {0.f, 0.f, 0.f, 0.f};
                d = __builtin_amdgcn_mfma_f32_16x16x32_f16(at[0], bt[tb][0], d, 0, 0, 0); d = __builtin_amdgcn_mfma_f32_16x16x32_f16(at[1], bt[tb][1], d, 0, 0, 0);
                const int t = t_l + tb * 16; const float tn = (float)t / (float)(n - 1);
#pragma unroll
                for (int i = 0; i < 4; ++i) { const int col = col0 + cb * 16 + lg * 4 + i, ch = col & 255; const float delta = 3.0701134573253945f + (float)ch * (12.280453829301578f / 255.0f);
                    const float v = d[i] * __expf(-tn * delta);
                    if (isc) WSP(float, WS_HC)[(size_t)col * NCTX + t] = v; else WSP(bf16_t, WS_HF)[(size_t)col * SEQ + t] = f2bf(v); } }
        }
        __syncthreads();
    }
}

__device__ __forceinline__ unsigned hcx_bits(hcx h) { return __builtin_bit_cast(unsigned, h); }
__device__ __forceinline__ hcx bits_hcx(unsigned u) { return __builtin_bit_cast(hcx, u); }
__device__ __forceinline__ float block_sum(float v, float* red) {
    v = wave_sum(v); if ((ltid() & 63) == 0) red[ltid() >> 6] = v; __syncthreads();
    float s = 0.f;
#pragma unroll
    for (int q = 0; q < 8; ++q) s += red[q];
    __syncthreads(); return s;
}
__device__ __forceinline__ void ld8bf(const bf16_t* p, float (&v)[8]) { const u32x4 q = *(const u32x4*)p; v[0] = bflo(q.x); v[1] = bfhi(q.x); v[2] = bflo(q.y); v[3] = bfhi(q.y); v[4] = bflo(q.z); v[5] = bfhi(q.z); v[6] = bflo(q.w); v[7] = bfhi(q.w); }
__device__ __forceinline__ void hyena_item(const Args& A, int l, int c, char* lds, unsigned char* scr) {
    LAS hcx* buf = (LAS hcx*)(LAS char*)lds; LAS hcx* tw = buf + FFT_BUF_ELEMS; float* red = (float*)(lds + FFT_LDS_BYTES);
    const int tid = ltid(); constexpr int n = SEQ; constexpr float inv2n = 1.0f / (2.0f * n);
    constexpr float FS = 16384.0f, DS = 1.0f / 128.0f, OS = 128.0f / (2.0f * n); const _Float16 KS = (_Float16)(1.0f / 16384.0f);
    const bf16_t* HYT = WSP(bf16_t, WS_HYT); const bf16_t* HF = WSP(bf16_t, WS_HF); bf16_t* HYO = WSP(bf16_t, WS_HYO);
    cpx* yev = (cpx*)scr; unsigned* v1s = (unsigned*)(scr + 131072);
    int tl;
#define LAUNDER() do { tl = tid; asm volatile("" : "+v"(tl)); } while (0)
    fft_fill_tables(tw, tid);
    __syncthreads();
#pragma unroll 1
    for (int o = 0; o < 2; ++o) {
        const bf16_t* hf = HF + (size_t)(o * 512 + c) * SEQ; const bf16_t* hb = HF + (size_t)(o * 512 + 256 + c) * SEQ;
        float sf = 0.f, sb = 0.f;
        LAUNDER();
#pragma unroll
        for (int cc = 0; cc < 4; ++cc) { const int t0 = 8 * (tl + NT * cc); float a[8], b[8]; ld8bf(hf + t0, a); ld8bf(hb + t0, b);
#pragma unroll
            for (int e = 0; e < 8; ++e) { sf += fabsf(a[e]); sb += fabsf(b[e]); } }
        sf = block_sum(sf, red); sb = block_sum(sb, red);
        const float inf = FS / sf, inb = FS / sb;
        unsigned Ke[8][4], Ko[8][4];
        LAUNDER();
#pragma unroll 2
        for (int cc = 0; cc < 4; ++cc) { const int t0 = 8 * (tl + NT * cc); float a[8], b[8]; ld8bf(hf + t0, a); ld8bf(hb + (n - 8 - t0), b);
#pragma unroll
            for (int e = 0; e < 8; ++e) { const float hbp = (t0 + e) >= 1 ? b[7 - e] * inb : 0.f; buf[fpad(t0 + e)] = hmk(a[e] * inf + hbp, 0.f); } }
        __syncthreads(); fft_fwd3(buf, tw, tid);
LAUNDER();
#pragma unroll
        for (int i = 0; i < 8; ++i) { hcx e[4]; fft_mid_load(buf, tl, i, e);
#pragma unroll
            for (int q = 0; q < 4; ++q) Ke[i][q] = hcx_bits(e[q] * KS);
            asm volatile("" : "+v"(Ke[i][0]), "+v"(Ke[i][1]), "+v"(Ke[i][2]), "+v"(Ke[i][3]) :: "memory"); }
        __syncthreads();
        LAUNDER();
#pragma unroll 2
        for (int cc = 0; cc < 4; ++cc) { const int t0 = 8 * (tl + NT * cc); float a[8], b[8]; ld8bf(hf + t0, a); ld8bf(hb + (n - 8 - t0), b);
#pragma unroll
            for (int e = 0; e < 8; ++e) { const float hbp = (t0 + e) >= 1 ? b[7 - e] * inb : 0.f; const float r = a[e] * inf - hbp; const cpx w = twid<false>((float)(t0 + e) * inv2n);
                buf[fpad(t0 + e)] = hmk(r * w.x, r * w.y); } }
        __syncthreads(); fft_fwd3(buf, tw, tid);
LAUNDER();
#pragma unroll
        for (int i = 0; i < 8; ++i) { hcx e[4]; fft_mid_load(buf, tl, i, e);
#pragma unroll
            for (int q = 0; q < 4; ++q) Ko[i][q] = hcx_bits(e[q] * KS);
            asm volatile("" : "+v"(Ko[i][0]), "+v"(Ko[i][1]), "+v"(Ko[i][2]), "+v"(Ko[i][3]) :: "memory"); }
        __syncthreads();
        const bf16_t* vin0 = HYT + (size_t)(0 * 768 + 512 + c) * SEQ; const bf16_t* vin1 = HYT + (size_t)(1 * 768 + 512 + c) * SEQ;
#define LOAD_Z(t0, z0, z1) do { if (o == 0) { ld8bf(vin0 + (t0), z0); ld8bf(vin1 + (t0), z1); } else { const u32x4 qa = *(const u32x4*)(v1s + (t0)), qb = *(const u32x4*)(v1s + (t0) + 4); \
            z0[0] = bflo(qa.x); z1[0] = bfhi(qa.x); z0[1] = bflo(qa.y); z1[1] = bfhi(qa.y); z0[2] = bflo(qa.z); z1[2] = bfhi(qa.z); z0[3] = bflo(qa.w); z1[3] = bfhi(qa.w); \
            z0[4] = bflo(qb.x); z1[4] = bfhi(qb.x); z0[5] = bflo(qb.y); z1[5] = bfhi(qb.y); z0[6] = bflo(qb.z); z1[6] = bfhi(qb.z); z0[7] = bflo(qb.w); z1[7] = bfhi(qb.w); } } while (0)
        LAUNDER();
#pragma unroll 2
        for (int cc = 0; cc < 4; ++cc) { const int t0 = 8 * (tl + NT * cc); float z0[8], z1[8]; LOAD_Z(t0, z0, z1);
#pragma unroll
            for (int e = 0; e < 8; ++e) buf[fpad(t0 + e)] = hmk(z0[e] * DS, z1[e] * DS); }
        __syncthreads(); fft_fwd3(buf, tw, tid);
LAUNDER();
#pragma unroll
        for (int i = 0; i < 8; ++i) { hcx e[4], k[4]; fft_mid_load(buf, tl, i, e);
#pragma unroll
            for (int q = 0; q < 4; ++q) k[q] = bits_hcx(Ke[i][q]);
            fft_mid_mulstore(buf, tl, i, e, k); asm volatile("" ::: "memory"); }
        __syncthreads(); fft_inv3(buf, tw, tid);
        LAUNDER();
#pragma unroll 2
        for (int cc = 0; cc < 4; ++cc) { const int t0 = 8 * (tl + NT * cc);
#pragma unroll
            for (int e = 0; e < 8; e += 2) { const hcx y0 = buf[fpad(t0 + e)], y1 = buf[fpad(t0 + e + 1)]; *(f32x4*)(yev + t0 + e) = (f32x4){(float)y0.x, (float)y0.y, (float)y1.x, (float)y1.y}; } }
        __syncthreads();
        LAUNDER();
#pragma unroll 2
        for (int cc = 0; cc < 4; ++cc) { const int t0 = 8 * (tl + NT * cc); float z0[8], z1[8]; LOAD_Z(t0, z0, z1);
#pragma unroll
            for (int e = 0; e < 8; ++e) { cpx z; z.x = z0[e] * DS; z.y = z1[e] * DS; z = cmul(z, twid<false>((float)(t0 + e) * inv2n)); buf[fpad(t0 + e)] = hmk(z.x, z.y); } }
        __syncthreads(); fft_fwd3(buf, tw, tid);
LAUNDER();
#pragma unroll
        for (int i = 0; i < 8; ++i) { hcx e[4], k[4]; fft_mid_load(buf, tl, i, e);
#pragma unroll
            for (int q = 0; q < 4; ++q) k[q] = bits_hcx(Ko[i][q]);
            fft_mid_mulstore(buf, tl, i, e, k); asm volatile("" ::: "memory"); }
        __syncthreads(); fft_inv3(buf, tw, tid);
        const float skip = A.in[I_HSKIP][l * 512 + o * 256 + c];
        const bf16_t* g0 = HYT + (size_t)(0 * 768 + o * 256 + c) * SEQ; const bf16_t* g1 = HYT + (size_t)(1 * 768 + o * 256 + c) * SEQ;
        LAUNDER();
#pragma unroll 1
        for (int cc = 0; cc < 4; ++cc) { const int t0 = 8 * (tl + NT * cc); float z0[8], z1[8], ga[8], gb[8]; LOAD_Z(t0, z0, z1); ld8bf(g0 + t0, ga); ld8bf(g1 + t0, gb);
            float r0[8], r1[8];
#pragma unroll
            for (int e = 0; e < 8; e += 2) { const f32x4 ye = *(const f32x4*)(yev + t0 + e); const hcx h0 = buf[fpad(t0 + e)], h1 = buf[fpad(t0 + e + 1)];
                cpx b0; b0.x = (float)h0.x; b0.y = (float)h0.y; cpx b1; b1.x = (float)h1.x; b1.y = (float)h1.y;
                const cpx yo0 = cmul(b0, twid<true>((float)(t0 + e) * inv2n)), yo1 = cmul(b1, twid<true>((float)(t0 + e + 1) * inv2n));
                r0[e] = ga[e] * ((ye[0] + yo0.x) * OS + skip * z0[e]); r1[e] = gb[e] * ((ye[1] + yo0.y) * OS + skip * z1[e]);
                r0[e + 1] = ga[e + 1] * ((ye[2] + yo1.x) * OS + skip * z0[e + 1]); r1[e + 1] = gb[e + 1] * ((ye[3] + yo1.y) * OS + skip * z1[e + 1]); }
            if (o == 0) { u32x4 qa, qb; qa.x = cvt_pk_bf16(r0[0], r1[0]); qa.y = cvt_pk_bf16(r0[1], r1[1]); qa.z = cvt_pk_bf16(r0[2], r1[2]); qa.w = cvt_pk_bf16(r0[3], r1[3]);
                qb.x = cvt_pk_bf16(r0[4], r1[4]); qb.y = cvt_pk_bf16(r0[5], r1[5]); qb.z = cvt_pk_bf16(r0[6], r1[6]); qb.w = cvt_pk_bf16(r0[7], r1[7]);
                *(u32x4*)(v1s + t0) = qa; *(u32x4*)(v1s + t0 + 4) = qb; }
            else { u32x4 qa, qb; qa.x = cvt_pk_bf16(r0[0], r0[1]); qa.y = cvt_pk_bf16(r0[2], r0[3]); qa.z = cvt_pk_bf16(r0[4], r0[5]); qa.w = cvt_pk_bf16(r0[6], r0[7]);
                qb.x = cvt_pk_bf16(r1[0], r1[1]); qb.y = cvt_pk_bf16(r1[2], r1[3]); qb.z = cvt_pk_bf16(r1[4], r1[5]); qb.w = cvt_pk_bf16(r1[6], r1[7]);
                *(u32x4*)(HYO + (size_t)(0 * 256 + c) * SEQ + t0) = qa; *(u32x4*)(HYO + (size_t)(1 * 256 + c) * SEQ + t0) = qb; } }
        __syncthreads();
    }
#undef LOAD_Z
#undef LAUNDER
}
__device__ __forceinline__ void hyena_ctx_item(const Args& A, int l, int c, char* lds) {
    float* hfl = (float*)lds; float* hbl = hfl + 512; float* vv = hbl + 512; float* nrm = vv + 512;
    const int tid = ltid(), t = tid & 255, b = tid >> 8, lane = tid & 63, w = tid >> 6;
    const float* HC = WSP(float, WS_HC); const bf16_t* HYTC = WSP(bf16_t, WS_HYT) + (size_t)2 * 768 * SEQ; bf16_t* HYOC = WSP(bf16_t, WS_HYO) + (size_t)2 * 256 * SEQ;
    if (w < 4) { const int col = (w >> 1) * 512 + (w & 1) * 256 + c; float s = 0.f;
#pragma unroll
        for (int q = 0; q < 4; ++q) s += fabsf(HC[(size_t)col * NCTX + lane + 64 * q]);
        s = wave_sum(s); if (lane == 0) nrm[w] = s; }
    vv[b * 256 + t] = bf2f(HYTC[(size_t)(b * 768 + 512 + c) * NCTX + t]);
    __syncthreads();
    hfl[b * 256 + t] = HC[(size_t)(b * 512 + c) * NCTX + t] / nrm[b * 2];
    hbl[b * 256 + t] = HC[(size_t)(b * 512 + 256 + c) * NCTX + t] / nrm[b * 2 + 1];
    __syncthreads();
    for (int o = 0; o < 2; ++o) {
        float y = 0.f;
        for (int s = 0; s < NCTX; ++s) { const float k = s <= t ? hfl[o * 256 + t - s] : hbl[o * 256 + s - t - 1]; y += k * vv[b * 256 + s]; }
        const float gate = bf2f(HYTC[(size_t)(b * 768 + o * 256 + c) * NCTX + t]); const float r = gate * (y + A.in[I_HSKIP][l * 512 + o * 256 + c] * vv[b * 256 + t]);
        __syncthreads();
        vv[b * 256 + t] = r;
        __syncthreads();
    }
    HYOC[(size_t)(b * 256 + c) * NCTX + t] = f2bf(vv[b * 256 + t]);
    __syncthreads();
}
__device__ __forceinline__ void hyena_post_tiles(const Args& A, char* lds, int nrows) {
    bf16_t* tl = (bf16_t*)lds;
    const int tid = ltid(); const bf16_t* HYO = WSP(bf16_t, WS_HYO); bf16_t* Y = WSP(bf16_t, WS_Y);
    for (int it = blockIdx.x; it < nrows / 64; it += gridDim.x) {
        const int row0 = it * 64; const bool lat = row0 < RL; const int b = lat ? row0 / SEQ : (row0 - RL) / NCTX, t0 = lat ? row0 % SEQ : (row0 - RL) % NCTX;
        for (int idx = tid; idx < 256 * 8; idx += NT) { const int ch = idx >> 3, c8 = (idx & 7) * 8;
            const bf16_t* src = lat ? HYO + (size_t)(b * 256 + ch) * SEQ + t0 + c8 : HYO + (size_t)2 * 256 * SEQ + (size_t)(b * 256 + ch) * NCTX + t0 + c8;
            const u32x4 v = *(const u32x4*)src; unsigned* d = (unsigned*)(tl + ch * 66 + c8); d[0] = v.x; d[1] = v.y; d[2] = v.z; d[3] = v.w; }
        __syncthreads();
        for (int idx = tid; idx < 64 * 32; idx += NT) { const int tok = idx >> 5, c8 = (idx & 31) * 8; unsigned short e[8];
#pragma unroll
            for (int q = 0; q < 8; ++q) e[q] = tl[(c8 + q) * 66 + tok];
            u32x4 o; o.x = e[0] | ((unsigned)e[1] << 16); o.y = e[2] | ((unsigned)e[3] << 16); o.z = e[4] | ((unsigned)e[5] << 16); o.w = e[6] | ((unsigned)e[7] << 16);
            *(u32x4*)(Y + (size_t)(row0 + tok) * 1280 + 512 + c8) = o; }
        __syncthreads();
    }
}

namespace epi {
using pg8::Unit; using pg8::BM; using pg8::HALF;
__device__ __forceinline__ u32x4 pack8(const f32x4& a, const f32x4& b) { u32x4 w; w.x = cvt_pk_bf16(a[0], a[1]); w.y = cvt_pk_bf16(a[2], a[3]); w.z = cvt_pk_bf16(b[0], b[1]); w.w = cvt_pk_bf16(b[2], b[3]); return w; }
struct Win { static constexpr bool PERM = true; bf16_t *zd, *zh, *zc, *zm;
    __device__ __forceinline__ void operator()(const f32x4 (&acc)[2][2][4][2], const Unit& u, int wr, int wc, int fr, int fq) const {
        bf16_t* base; int ldc, colt; const int pn = u.pn;
        if (pn < 6) { base = zd; ldc = 1536; colt = pn * 256; } else if (pn < 9) { base = zh; ldc = 768; colt = (pn - 6) * 256; } else if (pn < 11) { base = zc; ldc = 512; colt = (pn - 9) * 256; } else { base = zm; ldc = 512; colt = (pn - 11) * 256; }
        const int row0 = u.pm * BM + wr * 64 + fr, col0 = colt + wc * 32 + 8 * fq;
#pragma unroll
        for (int ai = 0; ai < 2; ++ai)
#pragma unroll
            for (int m = 0; m < 4; ++m) { bf16_t* rowp = base + (size_t)(row0 + ai * HALF + m * 16) * ldc + col0;
#pragma unroll
                for (int bj = 0; bj < 2; ++bj) *(u32x4*)(rowp + bj * HALF) = pack8(acc[ai][bj][m][0], acc[ai][bj][m][1]); }
    } };
struct Mla { static constexpr bool PERM = true; bf16_t* qkv;
    __device__ __forceinline__ void operator()(const f32x4 (&acc)[2][2][4][2], const Unit& u, int wr, int wc, int fr, int fq) const {
        const int row0 = u.pm * BM + wr * 64 + fr, col0 = u.pn * BM + wc * 32 + 8 * fq;
#pragma unroll
        for (int ai = 0; ai < 2; ++ai)
#pragma unroll
            for (int m = 0; m < 4; ++m) { bf16_t* rowp = qkv + (size_t)(row0 + ai * HALF + m * 16) * 1024 + col0;
#pragma unroll
                for (int bj = 0; bj < 2; ++bj) *(u32x4*)(rowp + bj * HALF) = pack8(acc[ai][bj][m][0], acc[ai][bj][m][1]); }
    } };
struct PBranch { static constexpr bool PERM = true; bf16_t* P;
    __device__ __forceinline__ void operator()(const f32x4 (&acc)[2][2][4][2], const Unit& u, int wr, int wc, int fr, int fq) const {
        const int row0 = u.pm * BM + wr * 64 + fr, col0 = u.tag * 1024 + u.pn * BM + wc * 32 + 8 * fq;
#pragma unroll
        for (int ai = 0; ai < 2; ++ai)
#pragma unroll
            for (int m = 0; m < 4; ++m) { bf16_t* rowp = P + (size_t)(row0 + ai * HALF + m * 16) * 4096 + col0;
#pragma unroll
                for (int bj = 0; bj < 2; ++bj) *(u32x4*)(rowp + bj * HALF) = pack8(acc[ai][bj][m][0], acc[ai][bj][m][1]); }
    } };
struct Gate { static constexpr bool PERM = false; const bf16_t* P; bf16_t* ACC;
    __device__ __forceinline__ void operator()(const f32x4 (&acc)[2][2][4][2], const Unit& u, int wr, int wc, int fr, int fq) const {
        const int row0 = u.pm * BM + wr * 64 + fr, chan = u.pn * 64 + wc * 16 + 4 * fq;
#pragma unroll
        for (int ai = 0; ai < 2; ++ai) {
            u32x2 pw[4][4];
#pragma unroll
            for (int m = 0; m < 4; ++m) { const bf16_t* pp = P + (size_t)(row0 + ai * HALF + m * 16) * 4096 + chan;
#pragma unroll
                for (int i = 0; i < 4; ++i) pw[m][i] = *(const u32x2*)(pp + i * 1024); }
            asm volatile("" ::: "memory");
#pragma unroll
            for (int m = 0; m < 4; ++m) { const int row = row0 + ai * HALF + m * 16; f32x4 s = {0.f, 0.f, 0.f, 0.f};
#pragma unroll
                for (int i = 0; i < 4; ++i) { const f32x4 g = acc[ai][i >> 1][m][i & 1];
                    s[0] += sigmoidf_(g[0]) * bflo(pw[m][i].x); s[1] += sigmoidf_(g[1]) * bfhi(pw[m][i].x); s[2] += sigmoidf_(g[2]) * bflo(pw[m][i].y); s[3] += sigmoidf_(g[3]) * bfhi(pw[m][i].y); }
                u32x2 w; w.x = cvt_pk_bf16(s[0], s[1]); w.y = cvt_pk_bf16(s[2], s[3]); *(u32x2*)(ACC + (size_t)row * 1024 + chan) = w; }
        }
    } };
struct Out { static constexpr bool PERM = false; const float* hsrc_lat; float* hdst_lat; const float* hsrc_ctx; float* hdst_ctx; const float* mod2;
    __device__ __forceinline__ void operator()(const f32x4 (&acc)[2][2][4][2], const Unit& u, int wr, int wc, int fr, int fq) const {
        const int v = u.pm < 64 ? 0 : (u.pm < 128 ? 1 : 2); const bool lat = u.pm < 128;
        const float* src = lat ? hsrc_lat : hsrc_ctx - (size_t)RL * D; float* dst = lat ? hdst_lat : hdst_ctx - (size_t)RL * D;
        const int row0 = u.pm * BM + wr * 64 + fr, col0 = u.pn * BM + wc * 32 + 4 * fq; const float* mg = mod2 + (size_t)v * 6144 + col0;
        f32x4 gv[2][2];
#pragma unroll
        for (int bj = 0; bj < 2; ++bj)
#pragma unroll
            for (int n = 0; n < 2; ++n) gv[bj][n] = *(const f32x4*)(mg + bj * HALF + n * 16);
#pragma unroll
        for (int ai = 0; ai < 2; ++ai)
#pragma unroll
            for (int m = 0; m < 4; ++m) { const size_t off = (size_t)(row0 + ai * HALF + m * 16) * D + col0;
#pragma unroll
                for (int bj = 0; bj < 2; ++bj)
#pragma unroll
                    for (int n = 0; n < 2; ++n) { const f32x4 hs = *(const f32x4*)(src + off + bj * HALF + n * 16); *(f32x4*)(dst + off + bj * HALF + n * 16) = hs + gv[bj][n] * acc[ai][bj][m][n]; } }
    } };
struct Ex1 { static constexpr bool PERM = true; bf16_t* HID;
    __device__ __forceinline__ void operator()(const f32x4 (&acc)[2][2][4][2], const Unit& u, int wr, int wc, int fr, int fq) const {
        const int row0 = u.pm * BM + wr * 64 + fr, f0 = u.pn * 128 + wc * 32 + 8 * fq;
#pragma unroll
        for (int ai = 0; ai < 2; ++ai)
#pragma unroll
            for (int m = 0; m < 4; ++m) { f32x4 a, b; const f32x4 g0 = acc[ai][0][m][0], g1 = acc[ai][0][m][1], u0 = acc[ai][1][m][0], u1 = acc[ai][1][m][1];
#pragma unroll
                for (int j = 0; j < 4; ++j) { a[j] = siluf_(g0[j]) * u0[j]; b[j] = siluf_(g1[j]) * u1[j]; }
                *(u32x4*)(HID + (size_t)(row0 + ai * HALF + m * 16) * EH + f0) = pack8(a, b); }
    } };
struct Ex2 { static constexpr bool PERM = true; bf16_t* YE; const float* grow;
    __device__ __forceinline__ void operator()(const f32x4 (&acc)[2][2][4][2], const Unit& u, int wr, int wc, int fr, int fq) const {
        const int row0 = u.pm * BM + wr * 64 + fr, col0 = u.pn * BM + wc * 32 + 8 * fq;
#pragma unroll
        for (int ai = 0; ai < 2; ++ai)
#pragma unroll
            for (int m = 0; m < 4; ++m) { const int row = row0 + ai * HALF + m * 16; const float g = grow[row];
#pragma unroll
                for (int bj = 0; bj < 2; ++bj) *(u32x4*)(YE + (size_t)row * D + col0 + bj * HALF) = pack8(acc[ai][bj][m][0] * g, acc[ai][bj][m][1] * g); }
    } };
}

__device__ __forceinline__ void router_rows(const Args& A, int l, char* lds, int nrows) {
    float* wrT = (float*)lds; const int tid = ltid(), lane = tid & 63;
    constexpr int WRS = 1028;
    { f32x4 lw[8];
#pragma unroll
      for (int q = 0; q < 8; ++q) lw[q] = *(const f32x4*)(A.in[I_WROUTER] + (size_t)l * D * NE + 4 * (tid + NT * q));
#pragma unroll
      for (int q = 0; q < 8; ++q) { const int i4 = 4 * (tid + NT * q), k = i4 >> 4, e0 = i4 & 15; wrT[(e0 + 0) * WRS + k] = lw[q].x; wrT[(e0 + 1) * WRS + k] = lw[q].y; wrT[(e0 + 2) * WRS + k] = lw[q].z; wrT[(e0 + 3) * WRS + k] = lw[q].w; } }
    __syncthreads();
    float* AFFT = WSP(float, WS_AFFT); int* INV = WSP(int, WS_INV);
    const int stride = ngwaves(); int row = gwave(); f32x4 vn[4];
#define RROW_PTR(r) ((r) < RL ? A.out + (size_t)(r) * D : WSP(float, WS_HCTX) + (size_t)((r) - RL) * D)
    if (row < nrows) { const float* src = RROW_PTR(row);
#pragma unroll
        for (int j = 0; j < 4; ++j) vn[j] = *(const f32x4*)(src + 4 * lane + 256 * j); }
    for (; row < nrows; row += stride) {
        f32x4 v[4]; float ss = 0.f;
#pragma unroll
        for (int j = 0; j < 4; ++j) { v[j] = vn[j]; ss += (v[j].x * v[j].x + v[j].y * v[j].y) + (v[j].z * v[j].z + v[j].w * v[j].w); }
        if (row + stride < nrows) { const float* src = RROW_PTR(row + stride);
#pragma unroll
            for (int j = 0; j < 4; ++j) vn[j] = *(const f32x4*)(src + 4 * lane + 256 * j); }
        const float rs = 1.0f / sqrtf(wave_sum(ss) * (1.0f / D) + EPS);
        const float* mod = WSP(float, WS_MOD) + (size_t)(l * 3 + row_vec(row)) * 6144; const float* g = A.in[I_GFFN] + l * D;
        bf16_t* urow = WSP(bf16_t, WS_U) + (size_t)row * D;
#pragma unroll
        for (int j = 0; j < 4; ++j) { const int c = 4 * lane + 256 * j; const f32x4 gg = *(const f32x4*)(g + c), sh = *(const f32x4*)(mod + 3 * 1024 + c), sc = *(const f32x4*)(mod + 4 * 1024 + c);
            v[j] = v[j] * rs * gg * (sc + 1.0f) + sh;
            u32x2 w; w.x = cvt_pk_bf16(v[j].x, v[j].y); w.y = cvt_pk_bf16(v[j].z, v[j].w); *(u32x2*)(urow + c) = w; }
        float lg[16];
#pragma unroll
        for (int e = 0; e < 16; ++e) { float s = 0.f;
#pragma unroll
            for (int j = 0; j < 4; ++j) { const f32x4 w = *(const f32x4*)(wrT + e * WRS + 4 * lane + 256 * j); s += (v[j].x * w.x + v[j].y * w.y) + (v[j].z * w.z + v[j].w * w.w); }
            lg[e] = s; }
#pragma unroll
        for (int i = 0; i < 8; ++i) { const bool up = (lane & 32) != 0; const float send = up ? lg[i] : lg[i + 8], keep = up ? lg[i + 8] : lg[i]; lg[i] = keep + __shfl_xor(send, 32); }
#pragma unroll
        for (int i = 0; i < 4; ++i) { const bool up = (lane & 16) != 0; const float send = up ? lg[i] : lg[i + 4], keep = up ? lg[i + 4] : lg[i]; lg[i] = keep + __shfl_xor(send, 16); }
#pragma unroll
        for (int i = 0; i < 2; ++i) { const bool up = (lane & 8) != 0; const float send = up ? lg[i] : lg[i + 2], keep = up ? lg[i + 2] : lg[i]; lg[i] = keep + __shfl_xor(send, 8); }
        { const bool up = (lane & 4) != 0; const float send = up ? lg[0] : lg[1], keep = up ? lg[1] : lg[0]; lg[0] = keep + __shfl_xor(send, 4); }
        float logit = lg[0]; logit += __shfl_xor(logit, 2); logit += __shfl_xor(logit, 1);
        const int e = ((lane >> 5) & 1) * 8 + ((lane >> 4) & 1) * 4 + ((lane >> 3) & 1) * 2 + ((lane >> 2) & 1);
        float mx = logit;
#pragma unroll
        for (int o = 4; o < 64; o <<= 1) mx = fmaxf(mx, __shfl_xor(mx, o));
        const float ex = __expf(logit - mx); float den = ex;
#pragma unroll
        for (int o = 4; o < 64; o <<= 1) den += __shfl_xor(den, o);
        const float mine = ex / den;
        if ((lane & 3) == 0) { const bool lat = row < RL;
            if (lat) AFFT[((size_t)(row / SEQ) * 16 + e) * SEQ + (row % SEQ)] = mine;
            else AFFT[(size_t)2 * 16 * SEQ + ((size_t)((row - RL) / NCTX) * 16 + e) * NCTX + ((row - RL) % NCTX)] = mine;
            INV[(size_t)row * 16 + e] = -1; }
    }
#undef RROW_PTR
}
__device__ __forceinline__ int block_sum_i(int v, int* red) {
#pragma unroll
    for (int o = 1; o < 64; o <<= 1) v += __shfl_xor(v, o);
    if ((ltid() & 63) == 0) red[ltid() >> 6] = v; __syncthreads();
    int s = 0;
#pragma unroll
    for (int q = 0; q < 8; ++q) s += red[q];
    __syncthreads(); return s;
}
__device__ __forceinline__ int block_excl_scan(int v, int* red) {
    const int lane = ltid() & 63, w = ltid() >> 6; int inc = v;
#pragma unroll
    for (int o = 1; o < 64; o <<= 1) { const int t = __shfl_up(inc, o); if (lane >= o) inc += t; }
    if (lane == 63) red[w] = inc; __syncthreads();
    int base = 0;
#pragma unroll
    for (int q = 0; q < 8; ++q) base += (q < w) ? red[q] : 0;
    __syncthreads(); return base + inc - v;
}
__device__ __forceinline__ void topk_select(const Args& A, char* lds, bool with_ctx) {
    int* red = (int*)lds; const int tid = ltid();
    const float* AFFT = WSP(float, WS_AFFT); int* SROW = WSP(int, WS_IDX); float* GROW = WSP(float, WS_GROW); int* INV = WSP(int, WS_INV);
    for (int it = blockIdx.x; it < (with_ctx ? 64 : 32); it += gridDim.x) {
        const bool isc = it >= 32; const int r = it & 31, b = r >> 4, e = r & 15; const int n = isc ? NCTX : SEQ, cap = isc ? CAPC : CAPL;
        const float* src = isc ? AFFT + (size_t)2 * 16 * SEQ + (size_t)(b * 16 + e) * NCTX : AFFT + (size_t)(b * 16 + e) * SEQ;
        unsigned key[32];
#pragma unroll
        for (int i = 0; i < 32; ++i) { const int t = tid + NT * i; key[i] = t < n ? __float_as_uint(src[t]) : 0u; }
        unsigned prefix = 0u; int krem = cap;
        for (int bit = 30; bit >= 0; --bit) { const unsigned cand = prefix | (1u << bit); int cnt = 0;
#pragma unroll
            for (int i = 0; i < 32; ++i) cnt += ((key[i] >> bit) == (cand >> bit)) ? 1 : 0;
            cnt = block_sum_i(cnt, red);
            if (cnt >= krem) prefix = cand; else krem -= cnt; }
        int cg = 0, ce = 0;
#pragma unroll
        for (int i = 0; i < 32; ++i) { cg += key[i] > prefix ? 1 : 0; ce += key[i] == prefix ? 1 : 0; }
        int sg = block_excl_scan(cg, red), se = block_excl_scan(ce, red);
        const int ngreater = cap - krem;
        const int xbase = isc ? NE * 4096 + e * 256 + b * CAPC : e * 4096 + b * CAPL;
        const int rowbase = isc ? RL + b * NCTX : b * SEQ;
#pragma unroll
        for (int i = 0; i < 32; ++i) { const int t = tid + NT * i; int slot = -1;
            if (key[i] > prefix) slot = sg++; else if (key[i] == prefix && prefix != 0u) { if (se < krem) slot = ngreater + se; ++se; }
            if (slot >= 0) { SROW[xbase + slot] = rowbase + t; GROW[xbase + slot] = __uint_as_float(key[i]); INV[(size_t)(rowbase + t) * 16 + e] = slot; } }
        if (isc && b == 0 && tid < 256 - 2 * CAPC) { SROW[NE * 4096 + e * 256 + 2 * CAPC + tid] = 0; GROW[NE * 4096 + e * 256 + 2 * CAPC + tid] = 0.f; }
        __syncthreads();
    }
}
__device__ __forceinline__ void moe_gather(const Args& A, bool with_ctx, float* GROW) {
    const int lane = ltid() & 63; const int* IDX = WSP(int, WS_IDX); const float* GV = WSP(float, WS_GATEV); const bf16_t* U = WSP(bf16_t, WS_U); bf16_t* XE = WSP(bf16_t, WS_XE);
    const int nx = with_ctx ? XROWS : NE * 4096;
    for (int xr = gwave(); xr < nx; xr += ngwaves()) {
        int srow = 0; float g = 0.f;
        if (xr < NE * 4096) { const int e = xr >> 12, s = xr & 4095, b = s >> 11, i = s & 2047; srow = b * SEQ + IDX[(b * 16 + e) * CAPL + i]; g = GV[(b * 16 + e) * CAPL + i]; }
        else { const int q = xr - NE * 4096, e = q >> 8, s = q & 255; if (s < 2 * CAPC) { const int b = s >> 5, i = s & 31; srow = RL + b * NCTX + IDX[2 * 16 * CAPL + (b * 16 + e) * CAPC + i]; g = GV[2 * 16 * CAPL + (b * 16 + e) * CAPC + i]; } }
        const u32x4* s4 = (const u32x4*)(U + (size_t)srow * D); u32x4* d4 = (u32x4*)(XE + (size_t)xr * D);
        d4[lane] = s4[lane]; d4[64 + lane] = s4[64 + lane];
        if (lane == 0) GROW[xr] = g;
    }
}
__device__ __forceinline__ void moe_combine(const Args& A, int l) {
    const int lane = ltid() & 63; const int* INV = WSP(int, WS_INV); const bf16_t* YE = WSP(bf16_t, WS_XE);
    const int nrows = l == 0 ? ROWS : RL;
    const int stride = ngwaves(); int row = gwave(); f32x4 vn[4]; int invn = -1;
#define CROW_PTR(r) ((r) < RL ? A.out + (size_t)(r) * D : WSP(float, WS_HCTX) + (size_t)((r) - RL) * D)
    if (row < nrows) { const float* src = CROW_PTR(row);
#pragma unroll
        for (int j = 0; j < 4; ++j) vn[j] = *(const f32x4*)(src + 4 * lane + 256 * j);
        invn = lane < 16 ? INV[(size_t)row * 16 + lane] : -1; }
    for (; row < nrows; row += stride) {
        const bool lat = row < RL; float* hp = CROW_PTR(row);
        f32x4 v[4], s[4];
#pragma unroll
        for (int j = 0; j < 4; ++j) { v[j] = vn[j]; s[j] = (f32x4){0.f, 0.f, 0.f, 0.f}; }
        const int myinv = invn;
        if (row + stride < nrows) { const float* src = CROW_PTR(row + stride);
#pragma unroll
            for (int j = 0; j < 4; ++j) vn[j] = *(const f32x4*)(src + 4 * lane + 256 * j);
            invn = lane < 16 ? INV[(size_t)(row + stride) * 16 + lane] : -1; }
        const int b = lat ? row / SEQ : (row - RL) / NCTX;
        unsigned m = (unsigned)(__ballot(myinv >= 0) & 0xFFFFull);
        while (m) {
            const bf16_t* yr[4]; float wq[4];
#pragma unroll
            for (int q = 0; q < 4; ++q) { const bool ok = m != 0u; const int e = ok ? __builtin_ctz(m) : 0; if (ok) m &= m - 1u;
                const int slot = ok ? __builtin_amdgcn_readlane(myinv, e) : 0;
                const size_t xr = lat ? (size_t)e * 4096 + b * 2048 + slot : (size_t)NE * 4096 + e * 256 + b * 32 + slot;
                yr[q] = (ok || q == 0) ? YE + xr * D : yr[0]; wq[q] = ok ? 1.f : 0.f; }
            u32x2 qv[4][4];
#pragma unroll
            for (int q = 0; q < 4; ++q)
#pragma unroll
                for (int j = 0; j < 4; ++j) qv[q][j] = *(const u32x2*)(yr[q] + 4 * lane + 256 * j);
#pragma unroll
            for (int q = 0; q < 4; ++q)
#pragma unroll
                for (int j = 0; j < 4; ++j) { s[j].x += wq[q] * bflo(qv[q][j].x); s[j].y += wq[q] * bfhi(qv[q][j].x); s[j].z += wq[q] * bflo(qv[q][j].y); s[j].w += wq[q] * bfhi(qv[q][j].y); }
        }
        const int vv = row_vec(row); const float* mod = WSP(float, WS_MOD) + (size_t)(l * 3 + vv) * 6144;
#pragma unroll
        for (int j = 0; j < 4; ++j) { const f32x4 g5 = *(const f32x4*)(mod + 5 * 1024 + 4 * lane + 256 * j); v[j] = v[j] + g5 * s[j]; }
        if (l == 0) {
#pragma unroll
            for (int j = 0; j < 4; ++j) *(f32x4*)(hp + 4 * lane + 256 * j) = v[j];
            const float* mod1 = WSP(float, WS_MOD) + (size_t)(1 * 3 + vv) * 6144;
            norm_mod_store(v, A.in[I_GMIX] + D, mod1, mod1 + 1024, WSP(bf16_t, WS_U) + (size_t)row * D, lane);
        } else {
            float ss = 0.f;
#pragma unroll
            for (int j = 0; j < 4; ++j) ss += (v[j].x * v[j].x + v[j].y * v[j].y) + (v[j].z * v[j].z + v[j].w * v[j].w);
            const float rs = 1.0f / sqrtf(wave_sum(ss) * (1.0f / D) + EPS);
#pragma unroll
            for (int j = 0; j < 4; ++j) { const f32x4 g = *(const f32x4*)(A.in[I_FNORM] + 4 * lane + 256 * j); *(f32x4*)(hp + 4 * lane + 256 * j) = v[j] * rs * g; }
        }
    }
#undef CROW_PTR
}

#define XB_TMO      128
#define XB_XCNT(j)  (256  + 64 * (j))
#define XB_XSUB(j)  (1280 + 64 * (j))
#define XB_XGEN(j)  (2304 + 64 * (j))
#define XB_TOP      3328
#define XB_TOPGEN   3392
#define XCD_BAR_WORDS 3456
#define XB_SPIN_CAP (1u << 22)
__device__ __forceinline__ unsigned xb_ld(unsigned* p)              { return __hip_atomic_load(p, __ATOMIC_RELAXED, __HIP_MEMORY_SCOPE_AGENT); }
__device__ __forceinline__ unsigned xb_add(unsigned* p, unsigned v) { return __hip_atomic_fetch_add(p, v, __ATOMIC_RELAXED, __HIP_MEMORY_SCOPE_AGENT); }
__device__ __forceinline__ unsigned xb_xcc_id() { return (unsigned)__builtin_amdgcn_s_getreg((3 << 11) | 20) & 0xFu; }
#define XB_SPIN(cond, bar) do { unsigned _sp = 0; while (cond) { __builtin_amdgcn_s_sleep(1); \
    if ((++_sp & 255u) == 0u) { if (xb_ld(&(bar)[XB_TMO])) break; if (_sp > XB_SPIN_CAP) { atomicAdd(&(bar)[XB_TMO], 1u); break; } } } } while (0)
struct XcdBarrier { unsigned* bar; unsigned x; volatile LAS unsigned* st; };
__device__ __forceinline__ XcdBarrier xcd_barrier_post(unsigned* bar, volatile LAS unsigned* st) {
    XcdBarrier b; b.bar = bar; b.x = xb_xcc_id(); b.st = st;
    if (threadIdx.x == 0) (void)xb_add(&bar[XB_XCNT(b.x)], 1u);
    return b;
}
__device__ __forceinline__ void xcd_barrier_complete(unsigned* bar, unsigned x, unsigned& nloc, unsigned& nx) {
    const unsigned G = gridDim.x * gridDim.y * gridDim.z;
    unsigned sum, cnt, mine, sp = 0u;
    for (;;) {
        sum = 0u; cnt = 0u; mine = 0u;
#pragma unroll
        for (unsigned j = 0; j < 16; ++j) { const unsigned c = xb_ld(&bar[XB_XCNT(j)]); sum += c; cnt += (c > 0u) ? 1u : 0u; mine = (j == x) ? c : mine; }
        if (sum == G) break;
        __builtin_amdgcn_s_sleep(1);
        if ((++sp & 255u) == 0u) { if (xb_ld(&bar[XB_TMO])) break; if (sp > XB_SPIN_CAP) { atomicAdd(&bar[XB_TMO], 1u); break; } }
    }
    nloc = mine > 0u ? mine : 1u; nx = cnt > 0u ? cnt : 1u;
}
__device__ __forceinline__ void xcd_barrier(const XcdBarrier& b) {
    asm volatile("s_waitcnt vmcnt(0)" ::: "memory");
    __syncthreads();
    if (threadIdx.x == 0) {
        unsigned* bar = b.bar;
        __builtin_amdgcn_s_waitcnt(0);
        unsigned nloc = b.st[0], nx = b.st[1];
        if (nloc == 0u) { xcd_barrier_complete(bar, b.x, nloc, nx); b.st[0] = nloc; b.st[1] = nx; }
        const unsigned old = xb_add(&bar[XB_XSUB(b.x)], 1u);
        const unsigned gen = old / nloc;
        if (old + 1u == (gen + 1u) * nloc) {
            __builtin_amdgcn_fence(__ATOMIC_RELEASE, "agent");
            asm volatile("s_waitcnt vmcnt(0)" ::: "memory");
            const unsigned og = xb_add(&bar[XB_TOP], 1u);
            const unsigned tg = og / nx;
            if (og + 1u == (tg + 1u) * nx) xb_add(&bar[XB_TOPGEN], 1u);
            else XB_SPIN(xb_ld(&bar[XB_TOPGEN]) == tg, bar);
            __builtin_amdgcn_fence(__ATOMIC_ACQUIRE, "agent");
            xb_add(&bar[XB_XGEN(b.x)], 1u);
            asm volatile("s_waitcnt vmcnt(0)" ::: "memory");
        } else {
            XB_SPIN(xb_ld(&bar[XB_XGEN(b.x)]) == gen, bar);
            __builtin_amdgcn_fence(__ATOMIC_ACQUIRE, "agent");
            asm volatile("s_waitcnt vmcnt(0)" ::: "memory");
        }
    }
    __syncthreads();
}

constexpr int LDS_MAIN = 136 * 1024;
constexpr int LDS_BYTES = LDS_MAIN + 16;
constexpr int PH_PER_LAYER = 15, N_PHASES = 2 + 2 * PH_PER_LAYER;

__global__ void __launch_bounds__(NT, 2) hybrid_fwd(Args A0) {
    extern __shared__ __attribute__((aligned(16))) unsigned char lds_raw[];
    char* lds = (char*)lds_raw;
    const int tid = threadIdx.x;
    if (tid < 4) ((volatile LAS unsigned*)(LAS unsigned char*)(lds_raw + LDS_MAIN))[tid] = 0u;
    __syncthreads();
    const bool multi = (A0.ph_hi - A0.ph_lo) > 1;
    XcdBarrier bar; bar.bar = (unsigned*)(A0.ws + WS_CTL); bar.x = 0; bar.st = nullptr;
    if (multi) bar = xcd_barrier_post((unsigned*)(A0.ws + WS_CTL), (volatile LAS unsigned*)(LAS unsigned char*)(lds_raw + LDS_MAIN));
    const int lo = A0.ph_lo, hi = A0.ph_hi;
#ifndef PROBE_PHASE
#define PROBE_PHASE -1
#endif
#ifndef PROBE_B
#define PROBE_B -1
#endif
#ifndef PROBE_C
#define PROBE_C -1
#endif
#ifndef PROBE_D
#define PROBE_D -1
#endif
#define REPEAT(j) _Pragma("unroll 1") for (int _rep = 0; _rep < ((PROBE_PHASE == (j) || PROBE_B == (j) || PROBE_C == (j) || PROBE_D == (j)) ? 2 : 1); ++_rep)
#define LA Args A = A0; asm volatile("" : "+s"(A.ws))
#ifdef DIAG_PHASE
#define DIAGOK(k) ((k) < 2 ? (k) == DIAG_PHASE : (((k) - 2) % PH_PER_LAYER) + 2 == DIAG_PHASE)
#else
#define DIAGOK(k) true
#endif
#define IN(k) (DIAGOK(k) && lo <= (k) && (k) < hi)
#define INR(k) (lo <= (k) && (k) < hi)
#define SEAM(k) do { if (INR(k) && INR((k) + 1)) xcd_barrier(bar); } while (0)
    const int G = gridDim.x, bx = blockIdx.x;
    LAS unsigned char* ldsl = (LAS unsigned char*)lds_raw;

    if (IN(0)) { LA; REPEAT(200) { conv_small_weights(A, 0, lds); conv_small_weights(A, 1, lds); __syncthreads(); } REPEAT(201) compute_mod(A, lds); REPEAT(202) compute_hid2(A, lds); }
    SEAM(0);
    if (IN(1)) { LA; REPEAT(203) rows_to_u_layer0(A); }
    SEAM(1);

#pragma unroll 1
    for (int l = 0; l < DEPTH; ++l) {
        const int pb = 2 + l * PH_PER_LAYER; const bool first = (l == 0);
        const int Mtok = first ? ROWS : RL;
        if (IN(pb + 0)) { LA;
            pg8::Gemm g{WSP(bf16_t, WS_U), WSP(bf16_t, WS_WIN) + (size_t)l * NPREP * D, ROWS, NPREP, D, D, D, -1, 0, 0};
            pg8::StaticOrder S; S.init(g, G, bx);
            epi::Win E{WSP(bf16_t, WS_ZD), WSP(bf16_t, WS_ZH), WSP(bf16_t, WS_ZC), WSP(bf16_t, WS_ZM)};
            REPEAT(0) pg8::gemm_phase(ldsl, g, S, E);
        }
        SEAM(pb + 0);
        if (IN(pb + 1)) { LA;
            post_rows(A);
            REPEAT(10) conformer_tiles(A, l, lds, Mtok);
            REPEAT(11) hyena_pre_tiles(A, l, lds, Mtok);
            REPEAT(12) hyena_filters(A, l, lds, first);
        }
        SEAM(pb + 1);
        if (IN(pb + 2)) { LA;
            pg8::Gemm g{WSP(bf16_t, WS_ZM), WSP(bf16_t, WS_WMLA) + (size_t)l * 1024 * 384, ROWS, 1024, 384, 512, 384, -1, 0, 0};
            pg8::StaticOrder S; S.init(g, G, bx);
            epi::Mla E{WSP(bf16_t, WS_QM)};
            REPEAT(2) pg8::gemm_phase(ldsl, g, S, E);
        }
        SEAM(pb + 2);
        if (IN(pb + 3)) { LA; mla_q_rope(A); }
        SEAM(pb + 3);
        if (IN(pb + 4)) { LA;
            att::Tensors T{(const char*)A.ws, WSP(bf16_t, WS_ZD), WSP(bf16_t, WS_QM), WSP(bf16_t, WS_KR), WSP(bf16_t, WS_Y), A.in[I_SUBLN] + l * 128, WSP(float, WS_LAM)[l], first ? 0.8f : 0.64449093f};
            constexpr int N_DL = 1024, N_ML = 512, N_HL = 256, N_DC = 16, N_MC = 8, N_HC = 256;
#if !defined(DIAG_SUB) || DIAG_SUB == 0
            REPEAT(40) for (int r = bx; r < N_DL; r += G) att::attn_unit<true>(T, r >> 9, (r >> 7) & 3, (r & 127) * 128, false, lds);
#endif
#if !defined(DIAG_SUB) || DIAG_SUB == 1
            REPEAT(41) for (int r = bx; r < N_ML; r += G) att::attn_unit<false>(T, r >> 8, (r >> 6) & 3, (r & 63) * 256, false, lds);
#endif
#if defined(PROBE_HALF) && PROBE_HALF == 1
            for (int r = bx; r < N_ML; r += G) att::attn_unit<false, PROBE_SH>(T, r >> 8, (r >> 6) & 3, (r & 63) * 256, false, lds);
#endif
#if defined(PROBE_HALF) && PROBE_HALF == 2
            for (int r = bx; r < N_DL; r += G) att::attn_unit<true, PROBE_SH>(T, r >> 9, (r >> 7) & 3, (r & 127) * 128, false, lds);
#endif
#if !defined(DIAG_SUB) || DIAG_SUB == 2
            REPEAT(42) for (int r = bx; r < N_HL; r += G) hyena_item(A, l, r, lds, A.ws + WS_ZM + (size_t)bx * SCR_PER_BLOCK);
#endif
#if !defined(DIAG_SUB) || DIAG_SUB == 3
            if (first) {
                for (int r = bx; r < N_DC; r += G) att::attn_unit<true>(T, r >> 3, (r >> 1) & 3, (r & 1) * 128, true, lds);
                for (int r = G >= 32 ? bx - 16 : bx; r >= 0 && r < N_MC; r += G) att::attn_unit<false>(T, r >> 2, r & 3, 0, true, lds);
                for (int r = bx; r < N_HC; r += G) hyena_ctx_item(A, l, r, lds);
            }
#endif
        }
        SEAM(pb + 4);
        if (IN(pb + 5)) { LA; REPEAT(5) hyena_post_tiles(A, lds, Mtok); }
        SEAM(pb + 5);
#if defined(SENS) && SENS == 3
        if (multi) { for (int q = 0; q < 10; ++q) xcd_barrier(bar); }
#endif
        if (IN(pb + 6)) { LA;
            pg8::Gemm g{WSP(bf16_t, WS_Y), WSP(bf16_t, WS_WB) + (size_t)l * 4 * 1024 * 512, Mtok, 4096, 512, 1280, 512, -1, 0, 0};
            pg8::BranchOrder S; S.init(g, G, bx);
            epi::PBranch E{WSP(bf16_t, WS_P)};
            REPEAT(6) pg8::gemm_phase(ldsl, g, S, E);
        }
        SEAM(pb + 6);
        if (IN(pb + 7)) { LA;
            pg8::Gemm g{WSP(bf16_t, WS_U), WSP(bf16_t, WS_WG) + (size_t)l * 4096 * D, Mtok, 4096, D, D, D, -1, 0, 0};
            pg8::StaticOrder S; S.init(g, G, bx);
            epi::Gate E{WSP(bf16_t, WS_P), WSP(bf16_t, WS_ACC)};
            REPEAT(7) pg8::gemm_phase(ldsl, g, S, E);
        }
        SEAM(pb + 7);
        if (IN(pb + 8)) { LA;
            pg8::Gemm g{WSP(bf16_t, WS_ACC), WSP(bf16_t, WS_WO) + (size_t)l * D * D, Mtok, D, D, D, D, -1, 0, 0};
            pg8::StaticOrder S; S.init(g, G, bx);
            epi::Out E{first ? A.in[I_X] : A.out, A.out, A.in[I_CTX], WSP(float, WS_HCTX), WSP(float, WS_MOD) + (size_t)l * 3 * 6144 + 2 * 1024};
            pg8::gemm_phase(ldsl, g, S, E);
        }
        SEAM(pb + 8);
        if (IN(pb + 9)) { LA; REPEAT(90) { router_rows(A, l, lds, Mtok); __syncthreads(); } }
        SEAM(pb + 9);
        if (IN(pb + 10)) { LA; REPEAT(100) topk_select(A, lds, first); __syncthreads(); conv_expert_weights(A, l, lds, G >= 128 ? (first ? 64 : 32) : 0); }
        SEAM(pb + 10);
        if (IN(pb + 12)) { LA;
            pg8::Gemm g{WSP(bf16_t, WS_U), WSP(bf16_t, WS_WEIN), first ? XROWS : NE * 4096, 2048, D, D, D, 4, 256, (size_t)2048 * D};
            pg8::StaticOrder S; S.init(g, G, bx);
            epi::Ex1 E{WSP(bf16_t, WS_HID)};
            REPEAT(120) pg8::gemm_phase<epi::Ex1, pg8::StaticOrder, true>(ldsl, g, S, E, WSP(int, WS_IDX));
        }
        SEAM(pb + 12);
        if (IN(pb + 13)) { LA;
            pg8::Gemm g{WSP(bf16_t, WS_HID), WSP(bf16_t, WS_WEOUT), first ? XROWS : NE * 4096, D, EH, EH, EH, 4, 256, (size_t)D * EH};
            pg8::StaticOrder S; S.init(g, G, bx);
            epi::Ex2 E{WSP(bf16_t, WS_XE), WSP(float, WS_GROW)};
            REPEAT(130) pg8::gemm_phase(ldsl, g, S, E);
        }
        SEAM(pb + 13);
        if (IN(pb + 14)) { LA; moe_combine(A, l); }
        if (l + 1 < DEPTH) SEAM(pb + 14);
    }
#undef LA
#undef REPEAT
#undef IN
#undef INR
#undef SEAM
}

#ifndef MK_ONE_LAUNCH
#define MK_ONE_LAUNCH 0
#endif
#ifndef MAX_PHASE
#define MAX_PHASE N_PHASES
#endif
extern "C" void kernel_launch(void* const* d_in, const int* in_sizes, int n_in, void* d_out, int out_size, void* d_ws, size_t ws_size, hipStream_t stream) {
    static int grid = 0;
    if (grid == 0) {
        if (n_in != N_INPUTS || out_size != RL * D || ws_size < WS_END) { fprintf(stderr, "kernel_launch: unexpected shapes (n_in %d out %d ws %zu need %zu)\n", n_in, out_size, ws_size, (size_t)WS_END); grid = -1; return; }
        int dev = 0, cus = 0, per_cu = 0;
        if (hipGetDevice(&dev) != hipSuccess || hipDeviceGetAttribute(&cus, hipDeviceAttributeMultiprocessorCount, dev) != hipSuccess) { grid = -1; return; }
        if (hipFuncSetAttribute((const void*)hybrid_fwd, hipFuncAttributeMaxDynamicSharedMemorySize, LDS_BYTES) != hipSuccess) { fprintf(stderr, "kernel_launch: hipFuncSetAttribute failed\n"); grid = -1; return; }
        if (hipOccupancyMaxActiveBlocksPerMultiprocessor(&per_cu, (const void*)hybrid_fwd, NT, LDS_BYTES) != hipSuccess || per_cu < 1) fprintf(stderr, "kernel_launch: occupancy query says %d\n", per_cu);
        (void)hipGetLastError();
        grid = cus > 256 ? 256 : cus;
    }
    if (grid < 0) return;
    (void)hipMemsetAsync((char*)d_ws + WS_CTL, 0, CTL_BYTES, stream);
    Args a{};
    for (int i = 0; i < N_INPUTS; ++i) a.in[i] = (const float*)d_in[i];
    a.out = (float*)d_out; a.ws = (unsigned char*)d_ws;
#if MK_ONE_LAUNCH
    a.ph_lo = 0; a.ph_hi = N_PHASES;
    hipLaunchKernelGGL(hybrid_fwd, dim3(grid), dim3(NT), LDS_BYTES, stream, a);
#else
    for (int k = 0; k < MAX_PHASE; ++k) { a.ph_lo = k; a.ph_hi = k + 1; hipLaunchKernelGGL(hybrid_fwd, dim3(grid), dim3(NT), LDS_BYTES, stream, a); }
#endif
}
```

```cpp
#define MK_ONE_LAUNCH 1
#include <hip/hip_runtime.h>
#include <cstdio>
#include <cstdint>
#include <cstddef>

#define LAS __attribute__((address_space(3)))
typedef unsigned short bf16_t;
typedef short bf16x8 __attribute__((ext_vector_type(8)));
typedef short s16x4 __attribute__((ext_vector_type(4)));
typedef float f32x4 __attribute__((ext_vector_type(4)));
typedef float f32x2 __attribute__((ext_vector_type(2)));
typedef float f32x16 __attribute__((ext_vector_type(16)));
typedef unsigned u32x4 __attribute__((ext_vector_type(4)));
typedef unsigned u32x2 __attribute__((ext_vector_type(2)));

constexpr int D = 1024, NB = 2, SEQ = 16384, NCTX = 256, KVLEN = SEQ + NCTX, DEPTH = 2, GRIDW = 64;
constexpr int RL = NB * SEQ, RC = NB * NCTX, ROWS = RL + RC;
constexpr int NIN = 7328, NPRE = 3232, NPREP = 3328;
constexpr int NE = 16, CAPL = 2048, CAPC = 32, EH = 1024;
constexpr int XROWS = NE * 4096 + NE * 256;
constexpr float EPS = 1e-6f;
constexpr int NT = 512;

enum { I_X = 0, I_C, I_CTX, I_CCTX, I_ADAW, I_ADAB, I_GMIX, I_GFFN, I_WIN, I_DLAM, I_SUBLN, I_HSW, I_HSB, I_FW1, I_FB1, I_FFREQ, I_FW2, I_FB2, I_FW3, I_HSKIP,
       I_CDW, I_CLNG, I_CLNB, I_MQG, I_MKVG, I_WUQ, I_WUKV, I_WBR, I_WOUT, I_WROUTER, I_WEIN, I_WEOUT, I_FNORM, N_INPUTS };

constexpr size_t al256(size_t x) { return (x + 255) / 256 * 256; }
constexpr size_t WS_CTL = 0;
constexpr size_t CTL_BYTES = 65536;
constexpr size_t WS_MOD = WS_CTL + CTL_BYTES;
constexpr size_t WS_LAM = WS_MOD + al256((size_t)2 * 3 * 6144 * 4);
constexpr size_t WS_HID2 = WS_LAM + 256;
constexpr size_t WS_HID2C = WS_HID2 + (size_t)2 * SEQ * 64 * 4;
constexpr size_t WS_RS = WS_HID2C + (size_t)2 * NCTX * 64 * 4;
constexpr size_t WS_AFFT = WS_RS + al256((size_t)2 * ROWS * 4);
constexpr size_t WS_IDX = WS_AFFT + (size_t)(2 * 16 * SEQ + 2 * 16 * NCTX) * 4;
constexpr size_t WS_GATEV = WS_IDX + (size_t)(2 * 16 * CAPL + 2 * 16 * CAPC) * 4;
constexpr size_t WS_INV = WS_GATEV + (size_t)(2 * 16 * CAPL + 2 * 16 * CAPC) * 4;
constexpr size_t WS_HCTX = WS_INV + (size_t)ROWS * 16 * 4;
constexpr size_t WS_HC = WS_HCTX + (size_t)RC * D * 4;
constexpr size_t WS_GROW = WS_HC + (size_t)1024 * NCTX * 4;
constexpr size_t WS_WIN = WS_GROW + al256((size_t)XROWS * 4);
constexpr size_t WS_WG = WS_WIN + (size_t)2 * NPREP * D * 2;
constexpr size_t WS_WB = WS_WG + (size_t)2 * 4096 * D * 2;
constexpr size_t WS_WO = WS_WB + (size_t)2 * 4 * 1024 * 512 * 2;
constexpr size_t WS_WMLA = WS_WO + (size_t)2 * D * D * 2;
constexpr size_t WS_WEIN = WS_WMLA + (size_t)2 * 1024 * 384 * 2;
constexpr size_t WS_WEOUT = WS_WEIN + (size_t)NE * 2048 * D * 2;
constexpr size_t WS_U = WS_WEOUT + (size_t)NE * D * EH * 2;
constexpr size_t WS_Y = WS_U + (size_t)ROWS * D * 2;
constexpr size_t WS_R1 = WS_Y + (size_t)ROWS * 1280 * 2;
constexpr size_t WS_ZD = WS_R1;
constexpr size_t WS_ZH = WS_ZD + (size_t)ROWS * 1536 * 2;
constexpr size_t WS_ZC = WS_ZH + (size_t)ROWS * 768 * 2;
constexpr size_t WS_ZM = WS_ZC + (size_t)ROWS * 512 * 2;
constexpr size_t WS_SCRX = WS_ZM + (size_t)ROWS * 512 * 2;
constexpr size_t SCR_PER_BLOCK = 196608;
constexpr size_t WS_HYT = WS_ZM + (size_t)256 * SCR_PER_BLOCK;
constexpr size_t WS_HF = WS_HYT + (size_t)(2 * 768 * SEQ + 2 * 768 * NCTX) * 2;
constexpr size_t WS_KR = WS_HF + (size_t)1024 * SEQ * 2;
constexpr size_t WS_R1END_MIX = WS_KR + (size_t)ROWS * 32 * 2;
constexpr size_t WS_QM = WS_ZH;
constexpr size_t WS_HYO = WS_QM + (size_t)ROWS * 1024 * 2;
static_assert(WS_HYO + (size_t)(2 * 256 * SEQ + 2 * 256 * NCTX) * 2 <= WS_ZM, "QM/KVM/HYO must fit in ZH+ZC");
static_assert(WS_ZM + (size_t)256 * SCR_PER_BLOCK >= WS_SCRX, "scratch covers ZM");
constexpr size_t WS_P = WS_R1;
constexpr size_t WS_ACC = WS_Y;
constexpr size_t WS_XE = WS_R1;
constexpr size_t WS_HID = WS_XE + (size_t)XROWS * D * 2;
constexpr size_t WS_R1END_MOE = WS_HID + (size_t)XROWS * EH * 2;
constexpr size_t WS_R1END_P = WS_P + (size_t)ROWS * 4096 * 2;
constexpr size_t cmax(size_t a, size_t b) { return a > b ? a : b; }
constexpr size_t WS_END = cmax(WS_R1END_MIX, cmax(WS_R1END_MOE, WS_R1END_P));
static_assert(WS_END <= (size_t)660 * 1000 * 1000, "workspace budget");

__device__ __forceinline__ unsigned cvt_pk_bf16(float lo, float hi) { unsigned r; asm("v_cvt_pk_bf16_f32 %0, %1, %2" : "=v"(r) : "v"(lo), "v"(hi)); return r; }
__device__ __forceinline__ float bf2f(bf16_t b) { return __uint_as_float(((unsigned)b) << 16); }
__device__ __forceinline__ float bflo(unsigned w) { return __uint_as_float(w << 16); }
__device__ __forceinline__ float bfhi(unsigned w) { return __uint_as_float(w & 0xffff0000u); }
__device__ __forceinline__ bf16_t f2bf(float f) { return (bf16_t)(cvt_pk_bf16(f, 0.f) & 0xffffu); }
__device__ __forceinline__ float wave_sum(float v) {
#pragma unroll
    for (int o = 1; o < 64; o <<= 1) v += __shfl_xor(v, o);
    return v;
}
__device__ __forceinline__ float sigmoidf_(float x) { return __builtin_amdgcn_rcpf(1.0f + __expf(-x)); }
__device__ __forceinline__ float siluf_(float x) { return x * sigmoidf_(x); }
__device__ __forceinline__ int row_vec(int row) { return row < SEQ ? 0 : (row < RL ? 1 : 2); }

__device__ __forceinline__ int ltid() { int t = threadIdx.x; asm volatile("" : "+v"(t)); return t; }
struct Args { const float* in[N_INPUTS]; float* out; unsigned char* ws; int ph_lo, ph_hi; };

namespace pg8 {
constexpr int BM = 256, BK = 64, HALF = 128, HTB = HALF * BK * 2, STAGE_BYTES = 8 * HTB, NXCD = 8, WGM = 8;
__host__ __device__ __forceinline__ int lds_byte(int r, int c) { const int st = (r >> 4) * 2 + (c >> 5), rr = r & 15, cc = c & 31, ob = rr * 64 + cc * 2; return st * 1024 + (ob ^ (((ob >> 9) & 1) << 5)); }
__host__ __device__ __forceinline__ void stage_rc(int b, int& R, int& C) { const int st = b / 1024, sb = b % 1024, swz = sb ^ (((sb >> 9) & 1) << 5); R = (st >> 1) * 16 + swz / 64; C = (st & 1) * 32 + (swz % 64) / 2; }
__host__ __device__ __forceinline__ int perm32(int rho) { const int n = rho >> 4, i = rho & 15; return 8 * (i >> 2) + 4 * n + (i & 3); }
struct Unit { int pm, pn, nt, tag; const char* a; const char* b; };
struct Gemm { const bf16_t* A; const bf16_t* Bt; int M, N, K, lda, ldb; int gshift, gsplit; size_t bgs; };
struct StaticOrder {
    int nM, nN, nwg, G, c; Gemm g;
    __device__ void init(const Gemm& g_, int G_, int c_) { g = g_; nM = g.M / BM; nN = g.N / BM; nwg = nM * nN; G = G_; c = c_; }
    __device__ bool map(int i, int& pm, int& pn) const {
        const long L = (long)i * G + c; if (L >= nwg) return false;
        int wgid = (int)L; { const int q = nwg / NXCD, r = nwg % NXCD, xcd = wgid % NXCD, off = wgid / NXCD; wgid = (xcd < r ? xcd * (q + 1) : r * (q + 1) + (xcd - r) * q) + off; }
        const int nig = WGM * nN, gid = wgid / nig, fm = gid * WGM, gsz = (nM - fm) < WGM ? (nM - fm) : WGM;
        pm = fm + ((wgid % nig) % gsz); pn = (wgid % nig) / gsz; return true;
    }
    __device__ bool next(int i, Unit& u) const {
        if (!map(i, u.pm, u.pn)) return false;
        u.nt = g.K / BK; u.tag = 0; u.a = (const char*)g.A + (size_t)u.pm * BM * g.lda * 2;
        u.b = (const char*)g.Bt + (g.gshift >= 0 ? (size_t)(u.pm < g.gsplit ? (u.pm >> g.gshift) : (u.pm - g.gsplit)) * g.bgs * 2 : (size_t)0) + (size_t)u.pn * BM * g.ldb * 2;
        return true;
    }
};
struct BranchOrder : StaticOrder {
    __device__ bool next(int i, Unit& u) const {
        int q; if (!map(i, u.pm, q)) return false;
        const int br = q >> 2; u.pn = q & 3; u.tag = br; u.nt = br == 0 ? 8 : 4;
        const int start = br == 0 ? 0 : 512 + 256 * (br - 1);
        u.a = (const char*)g.A + ((size_t)u.pm * BM * g.lda + start) * 2; u.b = (const char*)g.Bt + ((size_t)br * 1024 * 512 + (size_t)u.pn * BM * 512) * 2;
        return true;
    }
};
template <class Epi, class Sched, bool GATHER = false>
__device__ __forceinline__ void gemm_phase(LAS unsigned char* lds, const Gemm g, const Sched& S, const Epi& E, const int* gidx = nullptr) {
    const int tid = ltid(), wid = __builtin_amdgcn_readfirstlane(tid >> 6), lane = tid & 63, wr = wid >> 2, wc = wid & 3, fr = lane & 15, fq = lane >> 4;
    unsigned voffA[2], voffB[2];
#pragma unroll
    for (int i = 0; i < 2; ++i) { int R, C; stage_rc(tid * 16 + i * 8192, R, C); const int Rb = Epi::PERM ? ((R & ~31) + perm32(R & 31)) : R;
        voffA[i] = (unsigned)(R * g.lda + C) * 2u; voffB[i] = (unsigned)(Rb * g.ldb + C) * 2u; }
    const size_t kstep = (size_t)(BK * 2);
    unsigned gvc[2][2] = {{0u, 0u}, {0u, 0u}}, gvn[2][2] = {{0u, 0u}, {0u, 0u}}; unsigned gR[2] = {0u, 0u}, gC[2] = {0u, 0u};
    const char* gA = (const char*)g.A;
    if constexpr (GATHER) {
#pragma unroll
        for (int i = 0; i < 2; ++i) { int R, C; stage_rc(tid * 16 + i * 8192, R, C); gR[i] = (unsigned)R; gC[i] = (unsigned)C * 2u; }
        LAS unsigned short* li = (LAS unsigned short*)(lds + STAGE_BYTES);
        for (int q = tid; q < 16 * 256; q += 512) { int pm, pn; if (S.map(q >> 8, pm, pn)) li[q] = (unsigned short)gidx[pm * 256 + (q & 255)]; }
        __syncthreads();
    }
#define PG8_GV(dst, u) do { const LAS unsigned short* _li = (const LAS unsigned short*)(lds + STAGE_BYTES) + (u) * 256; _Pragma("unroll") for (int _h = 0; _h < 2; ++_h) _Pragma("unroll") for (int _i = 0; _i < 2; ++_i) \
        dst[_h][_i] = (unsigned)_li[_h * HALF + gR[_i]] * (unsigned)(g.lda * 2) + gC[_i]; } while (0)
#define PG8_STAGE_G(bufoff, gbase, v0, v1) do { __builtin_amdgcn_global_load_lds((const unsigned*)((gbase) + (v0)), (LAS unsigned*)(lds + (bufoff) + ldsw), 16, 0, 0); \
        __builtin_amdgcn_global_load_lds((const unsigned*)((gbase) + (v1)), (LAS unsigned*)(lds + (bufoff) + ldsw + 8192), 16, 0, 0); } while (0)
    const size_t hstepA = (size_t)HALF * g.lda * 2, hstepB = (size_t)HALF * g.ldb * 2;
    const unsigned ldsw = (unsigned)wid * 1024u;
    const int aoff = lds_byte(wr * 64 + fr, fq * 8), boff = lds_byte(wc * 32 + fr, fq * 8);
#define PG8_SA(b, h) (((b) * 2 + (h)) * HTB)
#define PG8_SB(b, h) ((4 + (b) * 2 + (h)) * HTB)
#define PG8_STAGE(bufoff, gbase, voff) do { _Pragma("unroll") for (int _i = 0; _i < 2; ++_i) \
        __builtin_amdgcn_global_load_lds((const unsigned*)((const char*)(gbase) + (voff)[_i]), (LAS unsigned*)(lds + (bufoff) + ldsw + _i * 8192), 16, 0, 0); } while (0)
#define PG8_LDA(dst, b, h) do { _Pragma("unroll") for (int m = 0; m < 4; ++m) _Pragma("unroll") for (int k = 0; k < 2; ++k) dst[m][k] = *(const LAS bf16x8*)(lds + PG8_SA(b, h) + aoff + m * 2048 + k * 1024); } while (0)
#define PG8_LDB(dst, b, h) do { _Pragma("unroll") for (int n = 0; n < 2; ++n) _Pragma("unroll") for (int k = 0; k < 2; ++k) dst[n][k] = *(const LAS bf16x8*)(lds + PG8_SB(b, h) + boff + n * 2048 + k * 1024); } while (0)
#define PG8_MMA(ai, bj, At, Bt) do { __builtin_amdgcn_s_setprio(1); _Pragma("unroll") for (int m = 0; m < 4; ++m) _Pragma("unroll") for (int n = 0; n < 2; ++n) _Pragma("unroll") for (int k = 0; k < 2; ++k) \
        acc[ai][bj][m][n] = __builtin_amdgcn_mfma_f32_16x16x32_bf16(Bt[n][k], At[m][k], acc[ai][bj][m][n], 0, 0, 0); __builtin_amdgcn_s_setprio(0); } while (0)
#define PG8_WAIT_V(n) asm volatile("s_waitcnt vmcnt(" #n ")" ::: "memory")
#define PG8_WAIT_L(n) asm volatile("s_waitcnt lgkmcnt(" #n ")" ::: "memory")
#define PG8_BAR __builtin_amdgcn_s_barrier()
#define PG8_SCHED __builtin_amdgcn_sched_barrier(0)
    Unit cur, nxt; int ui = 0;
    if (!S.next(0, cur)) return;
    f32x4 acc[2][2][4][2];
#pragma unroll
    for (int a = 0; a < 2; ++a)
#pragma unroll
        for (int b = 0; b < 2; ++b)
#pragma unroll
            for (int m = 0; m < 4; ++m)
#pragma unroll
                for (int n = 0; n < 2; ++n) acc[a][b][m][n] = (f32x4){0.f, 0.f, 0.f, 0.f};
    bf16x8 At[4][2], B0[2][2], B1[2][2];
    const char* cA = cur.a; const char* cB = cur.b;
    if constexpr (GATHER) { PG8_GV(gvc, 0);
        PG8_STAGE(PG8_SB(0, 0), cB, voffB); PG8_STAGE_G(PG8_SA(0, 0), gA, gvc[0][0], gvc[0][1]); PG8_STAGE(PG8_SB(0, 1), cB + hstepB, voffB); PG8_STAGE_G(PG8_SA(0, 1), gA, gvc[1][0], gvc[1][1]); }
    else {
    PG8_STAGE(PG8_SB(0, 0), cB, voffB); PG8_STAGE(PG8_SA(0, 0), cA, voffA); PG8_STAGE(PG8_SB(0, 1), cB + hstepB, voffB); PG8_STAGE(PG8_SA(0, 1), cA + hstepA, voffA); }
    if (wr == 1) PG8_BAR;
    PG8_WAIT_V(4); PG8_BAR;
    PG8_STAGE(PG8_SB(1, 0), cB + kstep, voffB); if constexpr (GATHER) PG8_STAGE_G(PG8_SA(1, 0), gA + kstep, gvc[0][0], gvc[0][1]); else PG8_STAGE(PG8_SA(1, 0), cA + kstep, voffA); PG8_STAGE(PG8_SB(1, 1), cB + hstepB + kstep, voffB);
    PG8_WAIT_V(6); PG8_BAR;
    for (;;) {
        const bool has_next = S.next(ui + 1, nxt);
        const char* nA = has_next ? nxt.a : cA; const char* nB = has_next ? nxt.b : cB;
        if constexpr (GATHER) { if (has_next) PG8_GV(gvn, ui + 1); }
        const int nt = cur.nt;
        for (int t = 0; t < nt; t += 2) {
            const bool last = (t == nt - 2);
            const char* a1 = cA + (size_t)(t + 1) * kstep;
            const char* a2 = last ? nA : cA + (size_t)(t + 2) * kstep; const char* b2 = last ? nB : cB + (size_t)(t + 2) * kstep;
            const char* a3 = a2 + kstep; const char* b3 = b2 + kstep;
            const char* ga1 = gA + (size_t)(t + 1) * kstep; const char* ga2 = last ? gA : gA + (size_t)(t + 2) * kstep;
            const unsigned g00 = last ? gvn[0][0] : gvc[0][0], g01 = last ? gvn[0][1] : gvc[0][1], g10 = last ? gvn[1][0] : gvc[1][0], g11 = last ? gvn[1][1] : gvc[1][1];
            PG8_LDB(B0, 0, 0); PG8_SCHED; PG8_LDA(At, 0, 0); if constexpr (GATHER) PG8_STAGE_G(PG8_SA(1, 1), ga1, gvc[1][0], gvc[1][1]); else PG8_STAGE(PG8_SA(1, 1), a1 + hstepA, voffA);
            PG8_WAIT_L(8); PG8_BAR; PG8_WAIT_L(0); PG8_MMA(0, 0, At, B0); PG8_BAR; PG8_SCHED;
            PG8_LDB(B1, 0, 1); PG8_STAGE(PG8_SB(0, 0), b2, voffB);
            PG8_BAR; PG8_WAIT_L(0); PG8_MMA(0, 1, At, B1); PG8_BAR;
            PG8_LDA(At, 0, 1); if constexpr (GATHER) PG8_STAGE_G(PG8_SA(0, 0), ga2, g00, g01); else PG8_STAGE(PG8_SA(0, 0), a2, voffA);
            PG8_BAR; PG8_WAIT_L(0); PG8_MMA(1, 0, At, B0); PG8_BAR; PG8_SCHED;
            PG8_STAGE(PG8_SB(0, 1), b2 + hstepB, voffB);
            PG8_WAIT_V(6); PG8_BAR; PG8_MMA(1, 1, At, B1); PG8_BAR;
            PG8_LDB(B0, 1, 0); PG8_SCHED; PG8_LDA(At, 1, 0); if constexpr (GATHER) PG8_STAGE_G(PG8_SA(0, 1), ga2, g10, g11); else PG8_STAGE(PG8_SA(0, 1), a2 + hstepA, voffA);
            PG8_WAIT_L(8); PG8_BAR; PG8_WAIT_L(0); PG8_MMA(0, 0, At, B0); PG8_BAR; PG8_SCHED;
            PG8_LDB(B1, 1, 1); PG8_STAGE(PG8_SB(1, 0), b3, voffB);
            PG8_BAR; PG8_WAIT_L(0); PG8_MMA(0, 1, At, B1); PG8_BAR;
            PG8_LDA(At, 1, 1); if constexpr (GATHER) PG8_STAGE_G(PG8_SA(1, 0), ga2 + kstep, g00, g01); else PG8_STAGE(PG8_SA(1, 0), a3, voffA);
            PG8_BAR; PG8_WAIT_L(0); PG8_MMA(1, 0, At, B0); PG8_BAR; PG8_SCHED;
            PG8_STAGE(PG8_SB(1, 1), b3 + hstepB, voffB);
            PG8_WAIT_V(6); PG8_BAR; PG8_MMA(1, 1, At, B1); PG8_BAR;
        }
        { int frl = fr, fql = fq; asm volatile("" : "+v"(frl), "+v"(fql)); E(acc, cur, wr, wc, frl, fql); }
        if (!has_next) break;
#pragma unroll
        for (int a = 0; a < 2; ++a)
#pragma unroll
            for (int b = 0; b < 2; ++b)
#pragma unroll
                for (int m = 0; m < 4; ++m)
#pragma unroll
                    for (int n = 0; n < 2; ++n) acc[a][b][m][n] = (f32x4){0.f, 0.f, 0.f, 0.f};
        cur = nxt; cA = nA; cB = nB; ++ui;
        if constexpr (GATHER) { gvc[0][0] = gvn[0][0]; gvc[0][1] = gvn[0][1]; gvc[1][0] = gvn[1][0]; gvc[1][1] = gvn[1][1]; }
    }
    PG8_WAIT_V(0);
    if (wr == 0) PG8_BAR;
    PG8_BAR;
#undef PG8_SA
#undef PG8_SB
#undef PG8_STAGE
#undef PG8_STAGE_G
#undef PG8_GV
#undef PG8_LDA
#undef PG8_LDB
#undef PG8_MMA
#undef PG8_WAIT_V
#undef PG8_WAIT_L
#undef PG8_BAR
#undef PG8_SCHED
}
}

namespace att {
constexpr int KVBLK = 64;
constexpr int SHM_K = KVBLK * 256, SHM_V = KVBLK * 256;
constexpr int SHM_ATTN = 4 * SHM_K + 4 * SHM_V + 8 * 64 * 4;
#define KSWZ(row, colB) ((row) * 256 + ((colB) ^ (((row) & 7) << 4)))
#define SBAR() __builtin_amdgcn_sched_barrier(0)
__device__ __forceinline__ int crow(int r, int hi) { return (r & 3) + 8 * (r >> 2) + 4 * hi; }

template <int NQB>
__device__ __forceinline__ void k_load(bf16x8 (&k0)[NQB], bf16x8 (&k1)[NQB], const char* Ks, int r32, int hi, int koff) {
#pragma unroll
    for (int d0 = 0; d0 < NQB; ++d0) { const int cb = (koff + d0 * 16 + hi * 8) * 2;
        k0[d0] = *reinterpret_cast<const bf16x8*>(Ks + KSWZ(r32, cb)); k1[d0] = *reinterpret_cast<const bf16x8*>(Ks + KSWZ(32 + r32, cb)); }
}
__device__ __forceinline__ bf16x8 mk8(unsigned a, unsigned b, unsigned c, unsigned d) { u32x4 w = {a, b, c, d}; return *reinterpret_cast<bf16x8*>(&w); }
template <int NCB> __device__ __forceinline__ int v_st(int k, int c) { const int kk = (k & ~0xC) | ((k & 4) << 1) | ((k & 8) >> 1); return ((kk >> 3) * NCB + (c >> 5)) * 512 + ((kk & 7) * 32 + (c & 31)) * 2; }
__device__ __forceinline__ int v_rd_base(int lane) { return ((lane & 3) << 3) | (((lane >> 2) & 3) << 6) | (((lane >> 4) & 1) << 5) | (((lane >> 5) & 1) << 8); }
template <int NCB> constexpr int v_rd_off(int d0, int ks, int half) { return d0 * 512 + ks * (1024 * NCB) + half * (512 * NCB); }
template <int OFF> __device__ __forceinline__ s16x4 tr_read(int vb) {
    s16x4 r; asm volatile("ds_read_b64_tr_b16 %0, %1 offset:%2" : "=&v"(r) : "v"(vb), "i"(OFF) : "memory"); return r;
}
template <int NCB, int D0> __device__ __forceinline__ void tr8(int vb, s16x4 (&f)[8]) {
    f[0] = tr_read<v_rd_off<NCB>(D0, 0, 0)>(vb); f[1] = tr_read<v_rd_off<NCB>(D0, 0, 1)>(vb); f[2] = tr_read<v_rd_off<NCB>(D0, 1, 0)>(vb); f[3] = tr_read<v_rd_off<NCB>(D0, 1, 1)>(vb);
    f[4] = tr_read<v_rd_off<NCB>(D0, 2, 0)>(vb); f[5] = tr_read<v_rd_off<NCB>(D0, 2, 1)>(vb); f[6] = tr_read<v_rd_off<NCB>(D0, 3, 0)>(vb); f[7] = tr_read<v_rd_off<NCB>(D0, 3, 1)>(vb);
}
#define PK(L, H) (bf16x8){L[0], L[1], L[2], L[3], H[0], H[1], H[2], H[3]}
template <int NQB, int NCB, bool RELOAD, int SH>
__device__ __forceinline__ void seg_qk(f32x16& n0, f32x16& n1, f32x16& c0, f32x16& c1, float& l_reg, bf16x8& pa0, bf16x8& pa1, bf16x8& pa2, bf16x8& pa3,
                                       bf16x8 (&k0)[NQB], bf16x8 (&k1)[NQB], const bf16x8* qr, const char* Kn, int r32, int hi, int koff, int vbn, s16x4 (&f)[8]) {
    constexpr int NM = 2 * NQB;
    unsigned w0[8], w1[8];
    n0 = f32x16{}; n1 = f32x16{};
#pragma unroll
    for (int i = 0; i < NM; ++i) {
        const int d0 = i >> 1;
        if (i & 1) n1 = __builtin_amdgcn_mfma_f32_32x32x16_bf16(k1[d0], qr[d0], n1, 0, 0, 0);
        else       n0 = __builtin_amdgcn_mfma_f32_32x32x16_bf16(k0[d0], qr[d0], n0, 0, 0, 0);
        if (RELOAD && (i & 1)) { const int cb = (koff + d0 * 16 + hi * 8) * 2;
            k0[d0] = *reinterpret_cast<const bf16x8*>(Kn + KSWZ(r32, cb)); k1[d0] = *reinterpret_cast<const bf16x8*>(Kn + KSWZ(32 + r32, cb)); }
        const int k = (NM == 8) ? i : ((i % 3 == 2) ? -1 : (i / 3) * 2 + (i % 3));
        if (k >= 0) {
            if (SH != 3) { c1[2 * k] = __builtin_amdgcn_exp2f(c1[2 * k]); c1[2 * k + 1] = __builtin_amdgcn_exp2f(c1[2 * k + 1]); }
            w0[k] = cvt_pk_bf16(c0[2 * k], c0[2 * k + 1]);
            if (k > 0) { l_reg += c1[2 * k - 2]; l_reg += c1[2 * k - 1]; asm volatile("" : "+v"(l_reg)); w1[k - 1] = cvt_pk_bf16(c1[2 * k - 2], c1[2 * k - 1]); }
        }
        if (i == NM - 1) { l_reg += c1[14]; l_reg += c1[15]; asm volatile("" : "+v"(l_reg)); w1[7] = cvt_pk_bf16(c1[14], c1[15]); }
        if (i == NM / 2 && SH != 4) tr8<NCB, 0>(vbn, f);
        SBAR();
    }
    pa0 = mk8(w0[0], w0[1], w0[2], w0[3]); pa1 = mk8(w0[4], w0[5], w0[6], w0[7]); pa2 = mk8(w1[0], w1[1], w1[2], w1[3]); pa3 = mk8(w1[4], w1[5], w1[6], w1[7]);
    asm volatile("s_nop 7" : "+v"(pa0), "+v"(pa1), "+v"(pa2), "+v"(pa3));
}
__device__ __forceinline__ void sm2_only(f32x16& c0, f32x16& c1, float& l_reg, bf16x8& pa0, bf16x8& pa1, bf16x8& pa2, bf16x8& pa3) {
    unsigned w0[8], w1[8];
#pragma unroll
    for (int k = 0; k < 8; ++k) { c1[2 * k] = __builtin_amdgcn_exp2f(c1[2 * k]); c1[2 * k + 1] = __builtin_amdgcn_exp2f(c1[2 * k + 1]); }
#pragma unroll
    for (int k = 0; k < 8; ++k) { l_reg += c1[2 * k]; l_reg += c1[2 * k + 1]; w0[k] = cvt_pk_bf16(c0[2 * k], c0[2 * k + 1]); w1[k] = cvt_pk_bf16(c1[2 * k], c1[2 * k + 1]); }
    pa0 = mk8(w0[0], w0[1], w0[2], w0[3]); pa1 = mk8(w0[4], w0[5], w0[6], w0[7]); pa2 = mk8(w1[0], w1[1], w1[2], w1[3]); pa3 = mk8(w1[4], w1[5], w1[6], w1[7]);
    asm volatile("s_nop 7" : "+v"(pa0), "+v"(pa1), "+v"(pa2), "+v"(pa3));
}
template <int NCB, bool SM1, int W0, int SH>
__device__ __forceinline__ void seg_pv(f32x16* o, int vb, bf16x8 pa0, bf16x8 pa1, bf16x8 pa2, bf16x8 pa3, s16x4 (&f)[8], f32x16& n0, float& l_reg) {
    s16x4 g[8];
    if (SH == 4) {
#pragma unroll
        for (int q = 0; q < 8; ++q) g[q] = f[q]; }
    constexpr int STEP = NCB == 4 ? 2 : 1;
#define SEG_PV_FILL(J) do { if (SM1) { constexpr int _j = (J); \
        if (_j % STEP == 0 && SH != 3) { constexpr int _k = _j / STEP; n0[2 * _k] = __builtin_amdgcn_exp2f(n0[2 * _k]); n0[2 * _k + 1] = __builtin_amdgcn_exp2f(n0[2 * _k + 1]); } \
        if (STEP == 2 ? (_j % 2 == 1) : (_j > 0)) { constexpr int _k = STEP == 2 ? _j / 2 : (_j > 0 ? _j - 1 : 0); l_reg += n0[2 * _k]; l_reg += n0[2 * _k + 1]; asm volatile("" : "+v"(l_reg)); } } } while (0)
#define SEG_PV_GROUP(D0, CUR, NXT, HASNEXT, WAITN) do { constexpr int _da = (D0), _db = SH == 2 ? ((D0) + 1) % NCB : (D0); \
        asm volatile("s_waitcnt lgkmcnt(%0)" :: "n"(WAITN) : "memory"); SBAR(); \
        if (SH != 5) o[_da] = __builtin_amdgcn_mfma_f32_32x32x16_bf16(pa0, PK(CUR[0], CUR[1]), o[_da], 0, 0, 0); else asm volatile("" :: "v"(CUR[0]), "v"(CUR[1]), "v"(pa0)); \
        if constexpr (HASNEXT && SH != 4) tr8<NCB, (D0) + 1 < NCB ? (D0) + 1 : 0>(vb, NXT); SEG_PV_FILL(4 * (D0) + 0); SBAR(); \
        if (SH != 5) o[_db] = __builtin_amdgcn_mfma_f32_32x32x16_bf16(pa1, PK(CUR[2], CUR[3]), o[_db], 0, 0, 0); else asm volatile("" :: "v"(CUR[2]), "v"(CUR[3]), "v"(pa1)); SEG_PV_FILL(4 * (D0) + 1); SBAR(); \
        if (SH != 5) o[_da] = __builtin_amdgcn_mfma_f32_32x32x16_bf16(pa2, PK(CUR[4], CUR[5]), o[_da], 0, 0, 0); else asm volatile("" :: "v"(CUR[4]), "v"(CUR[5]), "v"(pa2)); SEG_PV_FILL(4 * (D0) + 2); SBAR(); \
        if (SH != 5) o[_db] = __builtin_amdgcn_mfma_f32_32x32x16_bf16(pa3, PK(CUR[6], CUR[7]), o[_db], 0, 0, 0); else asm volatile("" :: "v"(CUR[6]), "v"(CUR[7]), "v"(pa3)); SEG_PV_FILL(4 * (D0) + 3); SBAR(); } while (0)
    if constexpr (NCB == 4) { SEG_PV_GROUP(0, f, g, true, W0); SEG_PV_GROUP(1, g, f, true, 0); SEG_PV_GROUP(2, f, g, true, 0); SEG_PV_GROUP(3, g, f, false, 0); }
    else { SEG_PV_GROUP(0, f, g, true, W0); SEG_PV_GROUP(1, g, f, false, 0); if (SM1) { l_reg += n0[14]; l_reg += n0[15]; asm volatile("" : "+v"(l_reg)); } }
#undef SEG_PV_GROUP
#undef SEG_PV_FILL
}
#undef PK

struct Tensors { const char* base;   const bf16_t* ZD; const bf16_t* QM;   const bf16_t* KR; bf16_t* Y; const float* subln_g; float lam, one_minus_lam_init; };
template <bool DIFF, int SH = 0>
__device__ __forceinline__ void attn_unit(const Tensors& T, int b, int h, int q0, bool ctxq, char* lds) {
    constexpr int NQB = DIFF ? 4 : 6, NCB = DIFF ? 4 : 2, NLD = DIFF ? 4 : 3;
    const int tid = ltid(), wid = tid >> 6, lane = tid & 63, r32 = lane & 31, hi = lane >> 5;
    float* li_l = (float*)(lds + 4 * SHM_V + 4 * SHM_K) + wid * 64;
    const int map = DIFF ? (wid >> 2) : 0, wq = DIFF ? (wid & 3) : wid;
    const int koff = DIFF ? map * 64 : 0;
    const int NTILES = ctxq ? NCTX / KVBLK : KVLEN / KVBLK;
    const int qrow = (ctxq ? RL + b * NCTX : b * SEQ) + q0 + wq * 32 + r32;
    constexpr bool HALF = SH != 0;
    const bool act = SH != 9 || wid < 4;
    float l_reg = 0; f32x16 o[NCB]; bf16x8 qr[NQB];
#pragma unroll
    for (int d = 0; d < NCB; ++d) o[d] = f32x16{};
    {
        const bf16_t* Qw = DIFF ? T.ZD + (size_t)qrow * 1536 + h * 128 + map * 64 + hi * 8 : T.QM + (size_t)qrow * 1024 + h * 96 + hi * 8;
#pragma unroll
        for (int d0 = 0; d0 < NQB; ++d0) qr[d0] = *reinterpret_cast<const bf16x8*>(Qw + d0 * 16);
    }
#define KROW(kt) ((int)((ctxq || (kt) < NCTX / KVBLK) ? RL + b * NCTX + (kt) * KVBLK : b * SEQ + (kt) * KVBLK - NCTX))
    const int krow_t = tid >> 4, kc = (tid & 15) ^ (krow_t & 7);
    const int vkk = DIFF ? (tid >> 7) * 8 + ((tid & 31) >> 2) : (tid >> 6) * 8 + ((tid & 31) >> 2);
    const int vkey = vkk;
    const int vcol = (DIFF ? ((tid >> 5) & 3) : ((tid >> 5) & 1)) * 32 + (tid & 3) * 8;
    const char* gb = T.base; unsigned kofs, kstrB, vofs; bool k_ok = true;
    const unsigned zd_o = (unsigned)((const char*)T.ZD - T.base), qm_o = (unsigned)((const char*)T.QM - T.base), kr_o = (unsigned)((const char*)T.KR - T.base);
    constexpr unsigned vstrB = DIFF ? 3072u : 2048u;
    if constexpr (DIFF) { kofs = zd_o + (unsigned)(512 + h * 128 + krow_t * 1536 + kc * 8) * 2u; kstrB = 3072u; vofs = zd_o + (unsigned)(1024 + h * 128 + vkey * 1536 + vcol) * 2u; }
    else { k_ok = kc < 12;
        if (kc < 8) { kofs = qm_o + (unsigned)(384 + h * 128 + krow_t * 1024 + kc * 8) * 2u; kstrB = 2048u; } else { kofs = kr_o + (unsigned)(krow_t * 32 + (kc - 8) * 8) * 2u; kstrB = 64u; }
        vofs = qm_o + (unsigned)(384 + h * 128 + 64 + vkey * 1024 + vcol) * 2u; }
    LAS unsigned char* ldsl = (LAS unsigned char*)lds; const unsigned ldsw = (unsigned)__builtin_amdgcn_readfirstlane(wid) * 1024u;
#define KOFF(bb, ss) (((bb) * 2 + (ss)) * SHM_K)
#define VOFF(bb, ss) (4 * SHM_K + ((bb) * 2 + (ss)) * SHM_V)
#define DMA16(gp, loff) if (SH != 6) __builtin_amdgcn_global_load_lds((const unsigned*)(gp), (LAS unsigned*)(ldsl + (loff) + ldsw), 16, 0, 0)
#define DMA_K(bb, ss, kt) do { const unsigned _kr = (unsigned)KROW(kt); if (k_ok) { const unsigned _o = DIFF ? kofs + _kr * 3072u : kofs + _kr * kstrB; DMA16(gb + _o, KOFF(bb, ss)); DMA16(gb + (_o + 32u * (DIFF ? 3072u : kstrB)), KOFF(bb, ss) + 8192); } } while (0)
#define DMA_V(bb, ss, kt) do { const unsigned _o = vofs + (unsigned)KROW(kt) * vstrB; DMA16(gb + _o, VOFF(bb, ss)); if constexpr (DIFF) DMA16(gb + (_o + 32u * vstrB), VOFF(bb, ss) + 8192); } while (0)
    f32x16 sE0, sE1, sO0, sO1; bf16x8 pa0, pa1, pa2, pa3; bf16x8 kf0[NQB], kf1[NQB]; s16x4 vf[8];
    const int NR = NTILES / 2;
    const int vbase = (int)(uintptr_t)lds + v_rd_base(lane);
#define ROUND(cb, more, t0) do { \
    k_load<NQB>(kf0, kf1, lds + KOFF(cb, 0), r32, hi, koff); \
    if (more) { DMA_K(1 - (cb), 0, (t0) + 2); DMA_K(1 - (cb), 1, (t0) + 3); } \
    DMA_V(cb, 1, (t0) + 1); if (more) DMA_V(1 - (cb), 0, (t0) + 2); \
    SBAR(); if (act) { \
    seg_qk<NQB, NCB, true, SH>(sE0, sE1, sO0, sO1, l_reg, pa0, pa1, pa2, pa3, kf0, kf1, qr, lds + KOFF(cb, 1), r32, hi, koff, vbase + VOFF(1 - (cb), 1), vf); \
    seg_pv<NCB, true, NQB, SH>(o, vbase + VOFF(1 - (cb), 1), pa0, pa1, pa2, pa3, vf, sE0, l_reg); \
    seg_qk<NQB, NCB, false, SH>(sO0, sO1, sE0, sE1, l_reg, pa0, pa1, pa2, pa3, kf0, kf1, qr, lds, r32, hi, koff, vbase + VOFF(cb, 0), vf); \
    seg_pv<NCB, true, 0, SH>(o, vbase + VOFF(cb, 0), pa0, pa1, pa2, pa3, vf, sO0, l_reg); } \
    if (SH == 7) asm volatile("s_waitcnt vmcnt(8)" ::: "memory"); else asm volatile("s_waitcnt vmcnt(0)" ::: "memory"); __syncthreads(); } while (0)
    DMA_K(0, 0, 0); DMA_K(0, 1, 1); DMA_V(0, 0, 0);
    { u32x4 z = {0u, 0u, 0u, 0u}; *reinterpret_cast<u32x4*>(lds + VOFF(1, 1) + tid * 16) = z; *reinterpret_cast<u32x4*>(lds + VOFF(1, 1) + 8192 + tid * 16) = z; }
#pragma unroll
    for (int r = 0; r < 16; ++r) { sO0[r] = 0.f; sO1[r] = -1.0e30f; }
    if (SH == 4) {
#pragma unroll
        for (int q = 0; q < 8; ++q) vf[q] = *reinterpret_cast<const s16x4*>(&qr[q % NQB]); }
    asm volatile("s_waitcnt vmcnt(0)" ::: "memory"); __syncthreads();
    if (wid >= 4) __builtin_amdgcn_s_setprio(1);
    for (int r = 0; r < NR; r += 2) {
        ROUND(0, true, 2 * r);
        { const bool more = r + 2 < NR; ROUND(1, more, 2 * r + 2); }
    }
    __builtin_amdgcn_s_setprio(0);
    sm2_only(sO0, sO1, l_reg, pa0, pa1, pa2, pa3);
    tr8<NCB, 0>(vbase + VOFF(1, 1), vf);
    seg_pv<NCB, false, 0, SH>(o, vbase + VOFF(1, 1), pa0, pa1, pa2, pa3, vf, sO0, l_reg);
#undef ROUND
#undef DMA_K
#undef DMA_V
#undef DMA16
#undef KOFF
#undef VOFF
    asm volatile("s_waitcnt vmcnt(0)" ::: "memory");
    int zz = 0; asm volatile("" : "+v"(zz));
    const int r32e = r32 + zz, hie = hi + zz;
    { auto rr = __builtin_amdgcn_permlane32_swap(__float_as_uint(l_reg), __float_as_uint(l_reg), false, false); l_reg = __uint_as_float(rr[0]) + __uint_as_float(rr[1]); }
    if (hie == 0) li_l[r32e] = l_reg; asm volatile("s_waitcnt lgkmcnt(0)" ::: "memory");
    float rli[16];
#pragma unroll
    for (int r = 0; r < 16; ++r) rli[r] = __builtin_amdgcn_rcpf(li_l[crow(r, hie)]);
    const int orow0 = (ctxq ? RL + b * NCTX : b * SEQ) + q0 + wq * 32;
    if constexpr (HALF) {
        float chk = l_reg;
#pragma unroll
        for (int d0 = 0; d0 < NCB; ++d0)
#pragma unroll
            for (int r = 0; r < 16; ++r) chk += o[d0][r];
        if (chk == 123456.789f) T.Y[(size_t)orow0 * 1280] = f2bf(chk);
        __syncthreads();
    } else if constexpr (!DIFF) {
        bf16_t* Ow = T.Y + (size_t)orow0 * 1280 + 1024 + h * 64;
#pragma unroll
        for (int r = 0; r < 16; ++r) { const int orow = crow(r, hie);
#pragma unroll
            for (int d0 = 0; d0 < NCB; ++d0) Ow[(size_t)orow * 1280 + d0 * 32 + r32e] = f2bf(o[d0][r] * rli[r]); }
        __syncthreads();
    } else {
        __syncthreads();
        float* XB = (float*)lds + wq * (32 * 128);
        if (map == 1) {
#pragma unroll
            for (int r = 0; r < 16; ++r) { const int orow = crow(r, hie); const float s = rli[r] * T.lam;
#pragma unroll
                for (int d0 = 0; d0 < 4; ++d0) XB[orow * 128 + d0 * 32 + r32e] = o[d0][r] * s; }
        }
        __syncthreads();
        if (map == 0) {
            float gcol[4];
#pragma unroll
            for (int d0 = 0; d0 < 4; ++d0) gcol[d0] = T.subln_g[d0 * 32 + r32e + zz] * T.one_minus_lam_init;
            bf16_t* Ow = T.Y + (size_t)orow0 * 1280 + h * 128;
#pragma unroll
            for (int r = 0; r < 16; ++r) { const int orow = crow(r, hie); float a[4]; float ss = 0.f;
#pragma unroll
                for (int d0 = 0; d0 < 4; ++d0) { a[d0] = o[d0][r] * rli[r] - XB[orow * 128 + d0 * 32 + r32e]; ss += a[d0] * a[d0]; }
#pragma unroll
                for (int m = 1; m < 32; m <<= 1) ss += __shfl_xor(ss, m);
                const float rs = __builtin_amdgcn_rsqf(ss * (1.0f / 128.0f) + EPS);
#pragma unroll
                for (int d0 = 0; d0 < 4; ++d0) Ow[(size_t)orow * 1280 + d0 * 32 + r32e] = f2bf(a[d0] * rs * gcol[d0]); }
        }
        __syncthreads();
    }
#undef KROW
}
#undef KSWZ
#undef SBAR
}

#ifndef FFT_HOST
#define FFT_HD __device__ __forceinline__
#define FFT_BUF LAS hcx*
#define FFT_CBUF const LAS hcx*
#define FFT_COS(r) __builtin_amdgcn_cosf(r)
#define FFT_SIN(r) __builtin_amdgcn_sinf(r)
#endif
typedef _Float16 hcx __attribute__((ext_vector_type(2)));
typedef float cpx __attribute__((ext_vector_type(2)));
constexpr int FFT_N = 16384;
constexpr int FFT_BUF_ELEMS = FFT_N + FFT_N / 32;
constexpr int FFT_TA = 15 * 1024, FFT_TB = 15 * 64, FFT_TC = 15 * 4;
constexpr int FFT_TW_ELEMS = FFT_TA + FFT_TB + FFT_TC;
constexpr int FFT_LDS_BYTES = (FFT_BUF_ELEMS + FFT_TW_ELEMS) * 4;
FFT_HD int fpad(int i) { return i + (i >> 5); }
FFT_HD hcx hmk(float re, float im) { hcx r; r.x = (_Float16)re; r.y = (_Float16)im; return r; }
FFT_HD hcx hmul(hcx a, hcx w) { const hcx ax = {a.x, a.x}, ay = {a.y, a.y}, wr = {(_Float16)(-w.y), w.x}; return ax * w + ay * wr; }
FFT_HD hcx hconj(hcx a) { hcx r; r.x = a.x; r.y = (_Float16)(-a.y); return r; }
FFT_HD cpx cmul(cpx a, cpx b) { cpx r; r.x = a.x * b.x - a.y * b.y; r.y = a.x * b.y + a.y * b.x; return r; }
template <bool INV> FFT_HD cpx twid(float r) { cpx w; w.x = FFT_COS(r); const float s = FFT_SIN(r); w.y = INV ? s : -s; return w; }
template <bool INV> FFT_HD void dft4(hcx& a0, hcx& a1, hcx& a2, hcx& a3) {
    const hcx t0 = a0 + a2, t1 = a0 - a2, t2 = a1 + a3, d = a1 - a3;
    hcx t3; if (INV) { t3.x = (_Float16)(-d.y); t3.y = d.x; } else { t3.x = d.y; t3.y = (_Float16)(-d.x); }
    a0 = t0 + t2; a1 = t1 + t3; a2 = t0 - t2; a3 = t1 - t3;
}
template <bool INV> FFT_HD void dft16(hcx (&x)[16]) {
#pragma unroll
    for (int n1 = 0; n1 < 4; ++n1) dft4<INV>(x[n1], x[n1 + 4], x[n1 + 8], x[n1 + 12]);
    const float C1 = 0.92387953251128674f, S1 = 0.38268343236508977f, C2 = 0.70710678118654752f;
#define FFT_TW(idx, cr, ci) do { const hcx w = hmk((cr), INV ? -(ci) : (ci)); x[idx] = hmul(x[idx], w); } while (0)
    FFT_TW(1 + 4 * 1, C1, -S1);  FFT_TW(2 + 4 * 1, C2, -C2);  FFT_TW(3 + 4 * 1, S1, -C1);
    FFT_TW(1 + 4 * 2, C2, -C2);  FFT_TW(2 + 4 * 2, 0.f, -1.f); FFT_TW(3 + 4 * 2, -C2, -C2);
    FFT_TW(1 + 4 * 3, S1, -C1);  FFT_TW(2 + 4 * 3, -C2, -C2); FFT_TW(3 + 4 * 3, -C1, S1);
#undef FFT_TW
#pragma unroll
    for (int k2 = 0; k2 < 4; ++k2) dft4<INV>(x[4 * k2], x[4 * k2 + 1], x[4 * k2 + 2], x[4 * k2 + 3]);
#define FFT_SW(a, b) do { const hcx t = x[a]; x[a] = x[b]; x[b] = t; } while (0)
    FFT_SW(1, 4); FFT_SW(2, 8); FFT_SW(3, 12); FFT_SW(6, 9); FFT_SW(7, 13); FFT_SW(11, 14);
#undef FFT_SW
}
FFT_HD void fft_fill_tables(FFT_BUF tw, int tid) {
    for (int i = tid; i < FFT_TW_ELEMS; i += NT) {
        int idx = i, M, L;
        if (idx < FFT_TA) { M = 1024; L = 16384; } else if (idx < FFT_TA + FFT_TB) { idx -= FFT_TA; M = 64; L = 1024; } else { idx -= FFT_TA + FFT_TB; M = 4; L = 64; }
        const int p = idx / M + 1, j = idx - (p - 1) * M; const cpx w = twid<false>((float)(j * p) / (float)L);
        tw[i] = hmk(w.x, w.y);
    }
}
template <bool INV> FFT_HD void fft_pass16(FFT_BUF buf, FFT_CBUF tbl, int M, int tid) {
#pragma unroll 1
    for (int i = 0; i < 2; ++i) {
        const int bf = tid + NT * i, blk = bf / M, j = bf - blk * M, base = blk * 16 * M + j;
        hcx x[16];
#pragma unroll
        for (int q = 0; q < 16; ++q) x[q] = buf[fpad(base + M * q)];
        if (INV) {
#pragma unroll
            for (int p = 1; p < 16; ++p) x[p] = hmul(x[p], hconj(tbl[(p - 1) * M + j]));
        }
        dft16<INV>(x);
        if (!INV) {
#pragma unroll
            for (int p = 1; p < 16; ++p) x[p] = hmul(x[p], tbl[(p - 1) * M + j]);
        }
#pragma unroll
        for (int q = 0; q < 16; ++q) buf[fpad(base + M * q)] = x[q];
    }
}
#ifndef FFT_HOST
#define FFT_SYNC() __syncthreads()
FFT_HD void fft_fwd3(FFT_BUF buf, FFT_CBUF tw, int tid) { fft_pass16<false>(buf, tw, 1024, tid); FFT_SYNC(); fft_pass16<false>(buf, tw + FFT_TA, 64, tid); FFT_SYNC(); fft_pass16<false>(buf, tw + FFT_TA + FFT_TB, 4, tid); FFT_SYNC(); }
FFT_HD void fft_inv3(FFT_BUF buf, FFT_CBUF tw, int tid) { fft_pass16<true>(buf, tw + FFT_TA + FFT_TB, 4, tid); FFT_SYNC(); fft_pass16<true>(buf, tw + FFT_TA, 64, tid); FFT_SYNC(); fft_pass16<true>(buf, tw, 1024, tid); FFT_SYNC(); }
#endif
FFT_HD void fft_mid_load(FFT_BUF buf, int tid, int i, hcx (&e)[4]) {
    const int b0 = 4 * (tid + NT * i);
#pragma unroll
    for (int q = 0; q < 4; ++q) e[q] = buf[fpad(b0 + q)];
    dft4<false>(e[0], e[1], e[2], e[3]);
}
FFT_HD void fft_mid_mulstore(FFT_BUF buf, int tid, int i, hcx (&e)[4], const hcx (&k)[4]) {
    const int b0 = 4 * (tid + NT * i);
#pragma unroll
    for (int q = 0; q < 4; ++q) e[q] = hmul(e[q], k[q]);
    dft4<true>(e[0], e[1], e[2], e[3]);
#pragma unroll
    for (int q = 0; q < 4; ++q) buf[fpad(b0 + q)] = e[q];
}

#define WSP(T, off) ((T*)(A.ws + (off)))
__device__ __forceinline__ int gwave() { return blockIdx.x * 8 + (ltid() >> 6); }
__device__ __forceinline__ int ngwaves() { return gridDim.x * 8; }

template <class F>
__device__ __forceinline__ void tr_item(const float* W, int ldw, F colmap, const float* kscale, bf16_t* WT, int ldd, int ksrc0, int kdst0, int n0, float* scr, int lane, float nscale = 1.0f, int nscale_lim = 0) {
    const int n = n0 + (lane & 31); const int col = colmap(n); const float ns = n < nscale_lim ? nscale : 1.0f;
    float vv[32];
#pragma unroll
    for (int i = 0; i < 32; ++i) { const int kk = 2 * i + (lane >> 5); vv[i] = col >= 0 ? W[(size_t)(ksrc0 + kk) * ldw + col] : 0.f; }
#pragma unroll
    for (int i = 0; i < 32; ++i) { const int kk = 2 * i + (lane >> 5); float v = vv[i]; if (kscale) v *= kscale[ksrc0 + kk]; scr[kk * 33 + (lane & 31)] = v * ns; }
    asm volatile("s_waitcnt lgkmcnt(0)" ::: "memory");
    const int c = lane & 7;
#pragma unroll
    for (int j = 0; j < 4; ++j) { const int nn = (lane >> 3) + 8 * j; const float* s = scr + (8 * c) * 33 + nn;
        u32x4 o; o.x = cvt_pk_bf16(s[0 * 33], s[1 * 33]); o.y = cvt_pk_bf16(s[2 * 33], s[3 * 33]); o.z = cvt_pk_bf16(s[4 * 33], s[5 * 33]); o.w = cvt_pk_bf16(s[6 * 33], s[7 * 33]);
        *(u32x4*)(WT + (size_t)(n0 + nn) * ldd + kdst0 + 8 * c) = o; }
    asm volatile("s_waitcnt lgkmcnt(0)" ::: "memory");
}
__device__ __forceinline__ void conv_small_weights(const Args& A, int l, char* lds) {
    float* scr = (float*)lds + (ltid() >> 6) * (64 * 33); const int lane = ltid() & 63;
    constexpr int C_WIN = 16 * (NPREP / 32), C_WG = 16 * 128, C_WB = (8 + 4 + 4 + 4) * 32, C_WO = 16 * 32, C_WM = 6 * 32, C_ALL = C_WIN + C_WG + C_WB + C_WO + C_WM;
    for (int it = gwave(); it < C_ALL; it += ngwaves()) {
        int r = it;
        if (r < C_WIN) { const int kb = r / (NPREP / 32), nb = r % (NPREP / 32);
            tr_item(A.in[I_WIN] + (size_t)l * D * NIN, NIN, [](int n) { return n < NPRE ? n : -1; }, nullptr, WSP(bf16_t, WS_WIN) + (size_t)l * NPREP * D, D, kb * 64, kb * 64, nb * 32, scr, lane, 0.125f * 1.4426950408889634f, 512); continue; }
        r -= C_WIN;
        if (r < C_WG) { const int kb = r / 128, nb = r % 128;
            tr_item(A.in[I_WIN] + (size_t)l * D * NIN, NIN, [](int n) { const int pn = n >> 8, cl = n & 255, bj = cl >> 7, rr = cl & 127, wc = rr >> 5, r2 = rr & 31, nn = r2 >> 4, r3 = r2 & 15;
                                                                     return NPRE + (2 * bj + nn) * 1024 + pn * 64 + wc * 16 + r3; }, nullptr, WSP(bf16_t, WS_WG) + (size_t)l * 4096 * D, D, kb * 64, kb * 64, nb * 32, scr, lane); continue; }
        r -= C_WG;
        if (r < C_WB) { int br, kb; const int q = r / 32, nb = r % 32;
            if (q < 8) { br = 0; kb = q; } else if (q < 12) { br = 1; kb = q - 8; } else if (q < 16) { br = 2; kb = q - 12; } else { br = 3; kb = q - 16; }
            const int start = br == 0 ? 0 : 512 + 256 * (br - 1), Ki = br == 0 ? 512 : 256;
            tr_item(A.in[I_WBR] + (size_t)l * 1280 * D + (size_t)start * D, D, [](int n) { return n; }, nullptr, WSP(bf16_t, WS_WB) + ((size_t)l * 4 + br) * 1024 * 512, 512, kb * 64, kb * 64, nb * 32, scr, lane); continue; }
        r -= C_WB;
        if (r < C_WO) { const int kb = r / 32, nb = r % 32;
            tr_item(A.in[I_WOUT] + (size_t)l * D * D, D, [](int n) { return n; }, nullptr, WSP(bf16_t, WS_WO) + (size_t)l * D * D, D, kb * 64, kb * 64, nb * 32, scr, lane); continue; }
        r -= C_WO;
        { const int kb = r / 32, nb = r % 32; bf16_t* dst = WSP(bf16_t, WS_WMLA) + (size_t)l * 1024 * 384;
            if (kb < 4) tr_item(A.in[I_WUQ] + (size_t)l * 256 * 384, 384, [](int n) { return n < 384 ? n : -1; }, A.in[I_MQG] + l * 256, dst, 384, kb * 64, kb * 64, nb * 32, scr, lane, 0.10206207261596575f * 1.4426950408889634f, 384);
            else tr_item(A.in[I_WUKV] + (size_t)l * 128 * 512, 512, [](int n) { return (n >= 384 && n < 896) ? n - 384 : -1; }, A.in[I_MKVG] + l * 128, dst, 384, (kb - 4) * 64, kb * 64, nb * 32, scr, lane); }
    }
}
__device__ __forceinline__ void conv_expert_weights(const Args& A, int l, char* lds, int first_block = 0) {
    float* scr = (float*)lds + (ltid() >> 6) * (64 * 33); const int lane = ltid() & 63;
    constexpr int C_IN = NE * 16 * 64, C_OUT = NE * 16 * 32;
    if ((int)blockIdx.x < first_block) return;
    for (int it = ((int)blockIdx.x - first_block) * 8 + (ltid() >> 6); it < C_IN + C_OUT; it += ((int)gridDim.x - first_block) * 8) {
        if (it < C_IN) { const int e = it / (16 * 64), r = it % (16 * 64), kb = r / 64, nb = r % 64;
            tr_item(A.in[I_WEIN] + ((size_t)l * NE + e) * D * 2048, 2048, [](int n) { const int f = (n >> 8) * 128 + (n & 127); return ((n >> 7) & 1) ? 1024 + f : f; }, nullptr,
                    WSP(bf16_t, WS_WEIN) + (size_t)e * 2048 * D, D, kb * 64, kb * 64, nb * 32, scr, lane); }
        else { const int r0 = it - C_IN, e = r0 / (16 * 32), r = r0 % (16 * 32), kb = r / 32, nb = r % 32;
            tr_item(A.in[I_WEOUT] + ((size_t)l * NE + e) * EH * D, D, [](int n) { return n; }, nullptr, WSP(bf16_t, WS_WEOUT) + (size_t)e * D * EH, EH, kb * 64, kb * 64, nb * 32, scr, lane); }
    }
}
__device__ __forceinline__ void compute_mod(const Args& A, char* lds) {
    float* red = (float*)lds; float* sc = red + 8 * 3 * 64;
    const int tid = ltid(), w = tid >> 6, lane = tid & 63;
    if ((int)blockIdx.x < 2 * 96) { for (int i = tid; i < 3 * 1024; i += NT) sc[i] = siluf_(i < 2048 ? A.in[I_C][i] : A.in[I_CCTX][i - 2048]); __syncthreads(); }
    for (int it = blockIdx.x; it < 2 * 96; it += gridDim.x) {
        const int l = it / 96, col = (it % 96) * 64 + lane;
        const float* W = A.in[I_ADAW] + (size_t)l * D * 6144;
        float a0 = 0.f, a1 = 0.f, a2 = 0.f;
#pragma unroll 1
        for (int k0 = w * 128; k0 < w * 128 + 128; k0 += 32) { float wv[32];
#pragma unroll
            for (int q = 0; q < 32; ++q) wv[q] = W[(size_t)(k0 + q) * 6144 + col];
#pragma unroll
            for (int q = 0; q < 32; ++q) { a0 += sc[k0 + q] * wv[q]; a1 += sc[1024 + k0 + q] * wv[q]; a2 += sc[2048 + k0 + q] * wv[q]; } }
        red[(w * 3 + 0) * 64 + lane] = a0; red[(w * 3 + 1) * 64 + lane] = a1; red[(w * 3 + 2) * 64 + lane] = a2;
        __syncthreads();
        if (tid < 192) { const int v = tid >> 6; float s = 0.f;
#pragma unroll
            for (int q = 0; q < 8; ++q) s += red[(q * 3 + v) * 64 + lane];
            WSP(float, WS_MOD)[((size_t)l * 3 + v) * 6144 + col] = s + A.in[I_ADAB][l * 6144 + col]; }
        __syncthreads();
    }
    if (blockIdx.x == gridDim.x - 1 && tid < 128) {
        const int l = tid >> 6; const float* dl = A.in[I_DLAM] + l * 256;
        const float s1 = wave_sum(dl[lane] * dl[64 + lane]), s2 = wave_sum(dl[128 + lane] * dl[192 + lane]);
        const float lam_init = l == 0 ? 0.2f : 0.35550907f;
        if (lane == 0) WSP(float, WS_LAM)[l] = __expf(s1) - __expf(s2) + lam_init;
    }
}
__device__ __forceinline__ void compute_hid2(const Args& A, char* lds) {
    float* zs = (float*)lds; float* hs = zs + 128 * 34;
    const int tid = ltid(), tl = tid & 127, og = tid >> 7;
    constexpr int IT_L = SEQ / 128, IT_C = NCTX / 128, IT = 2 * (IT_L + IT_C);
    for (int it = (blockIdx.x + gridDim.x - 192u % gridDim.x) % gridDim.x; it < IT; it += gridDim.x) {
        const int l = it / (IT_L + IT_C), r = it % (IT_L + IT_C); const bool isc = r >= IT_L; const int n = isc ? NCTX : SEQ, t = (isc ? r - IT_L : r) * 128 + tl;
        if (og == 0) {
            const float tn = (float)t / (float)(n - 1), tr = (float)t / (float)n;
            zs[tl * 34] = tn;
            for (int k = 0; k < 16; ++k) { const float f = 1e-4f + (float)k * ((15.0f - 1e-4f) / 15.0f); const float rv = f * tr;
                zs[tl * 34 + 1 + k] = __builtin_amdgcn_cosf(rv); zs[tl * 34 + 17 + k] = -__builtin_amdgcn_sinf(rv); }
        }
        __syncthreads();
        float acc[16];
        { const float* w1 = A.in[I_FW1] + l * 33 * 64; const float* b1 = A.in[I_FB1] + l * 64;
#pragma unroll
          for (int j = 0; j < 16; ++j) acc[j] = b1[og * 16 + j];
          for (int k = 0; k < 33; ++k) { const float z = zs[tl * 34 + k];
#pragma unroll
              for (int j = 0; j < 16; ++j) acc[j] += z * w1[k * 64 + og * 16 + j]; }
          const float* fq = A.in[I_FFREQ] + l * 128;
#pragma unroll
          for (int j = 0; j < 16; ++j) hs[tl * 65 + og * 16 + j] = __builtin_amdgcn_sinf(fq[og * 16 + j] * acc[j] * 0.15915494309189535f); }
        __syncthreads();
        { const float* w2 = A.in[I_FW2] + l * 64 * 64; const float* b2 = A.in[I_FB2] + l * 64;
#pragma unroll
          for (int j = 0; j < 16; ++j) acc[j] = b2[og * 16 + j];
          for (int k = 0; k < 64; ++k) { const float z = hs[tl * 65 + k];
#pragma unroll
              for (int j = 0; j < 16; ++j) acc[j] += z * w2[k * 64 + og * 16 + j]; }
          const float* fq = A.in[I_FFREQ] + l * 128 + 64;
          float* dst = isc ? WSP(float, WS_HID2C) + ((size_t)l * NCTX + t) * 64 : WSP(float, WS_HID2) + ((size_t)l * SEQ + t) * 64;
#pragma unroll
          for (int j = 0; j < 16; ++j) dst[og * 16 + j] = __builtin_amdgcn_sinf(fq[og * 16 + j] * acc[j] * 0.15915494309189535f); }
        __syncthreads();
    }
}
__device__ __forceinline__ void norm_mod_store(const f32x4 (&v)[4], const float* g, const float* shift, const float* scale, bf16_t* urow, int lane) {
    float ss = 0.f;
#pragma unroll
    for (int j = 0; j < 4; ++j) ss += (v[j].x * v[j].x + v[j].y * v[j].y) + (v[j].z * v[j].z + v[j].w * v[j].w);
    const float rs = 1.0f / sqrtf(wave_sum(ss) * (1.0f / D) + EPS);
#pragma unroll
    for (int j = 0; j < 4; ++j) { const int c = 4 * lane + 256 * j; const f32x4 gg = *(const f32x4*)(g + c), sh = *(const f32x4*)(shift + c), sc = *(const f32x4*)(scale + c);
        const f32x4 u = v[j] * rs * gg * (sc + 1.0f) + sh;
        u32x2 w; w.x = cvt_pk_bf16(u.x, u.y); w.y = cvt_pk_bf16(u.z, u.w); *(u32x2*)(urow + c) = w; }
}
__device__ __forceinline__ void rows_to_u_layer0(const Args& A) {
    const int lane = ltid() & 63;
    for (int row = gwave(); row < ROWS; row += ngwaves()) {
        const float* src = row < RL ? A.in[I_X] + (size_t)row * D : A.in[I_CTX] + (size_t)(row - RL) * D;
        f32x4 v[4];
#pragma unroll
        for (int j = 0; j < 4; ++j) v[j] = *(const f32x4*)(src + 4 * lane + 256 * j);
        const float* mod = WSP(float, WS_MOD) + (size_t)(0 * 3 + row_vec(row)) * 6144;
        norm_mod_store(v, A.in[I_GMIX], mod, mod + 1024, WSP(bf16_t, WS_U) + (size_t)row * D, lane);
    }
}
__device__ __forceinline__ void post_rows(const Args& A) {
    const int lane = ltid() & 63;
    bf16_t* ZD = WSP(bf16_t, WS_ZD); bf16_t* ZM = WSP(bf16_t, WS_ZM); bf16_t* KR = WSP(bf16_t, WS_KR);
    for (int row = gwave(); row < ROWS; row += ngwaves()) {
        const bool lat = row < RL; const int tok = row & (SEQ - 1); const float prow = (float)(tok >> 6), pcol = (float)(tok & 63);
        if (lat) {
            const int blk = lane >> 2, j0 = (lane & 3) * 8; bf16_t* p = ZD + (size_t)row * 1536 + blk * 64 + j0;
            const u32x4 a = *(const u32x4*)p, bq = *(const u32x4*)(p + 32);
            const float pos = j0 < 16 ? prow : pcol; const int jb = j0 & 15;
            float x1[8], x2[8]; const unsigned aw[4] = {a.x, a.y, a.z, a.w}, bw[4] = {bq.x, bq.y, bq.z, bq.w};
#pragma unroll
            for (int e = 0; e < 4; ++e) { x1[2 * e] = bflo(aw[e]); x1[2 * e + 1] = bfhi(aw[e]); x2[2 * e] = bflo(bw[e]); x2[2 * e + 1] = bfhi(bw[e]); }
            float y1[8], y2[8];
#pragma unroll
            for (int e = 0; e < 8; ++e) { const float inv = exp2f(-(float)(jb + e) * (13.287712379549449f / 16.0f)); const float rev = pos * inv * 0.15915494309189535f;
                const float c = __builtin_amdgcn_cosf(rev), s = __builtin_amdgcn_sinf(rev); y1[e] = x1[e] * c - x2[e] * s; y2[e] = x1[e] * s + x2[e] * c; }
            u32x4 oa, ob; oa.x = cvt_pk_bf16(y1[0], y1[1]); oa.y = cvt_pk_bf16(y1[2], y1[3]); oa.z = cvt_pk_bf16(y1[4], y1[5]); oa.w = cvt_pk_bf16(y1[6], y1[7]);
            ob.x = cvt_pk_bf16(y2[0], y2[1]); ob.y = cvt_pk_bf16(y2[2], y2[3]); ob.z = cvt_pk_bf16(y2[4], y2[5]); ob.w = cvt_pk_bf16(y2[6], y2[7]);
            *(u32x4*)p = oa; *(u32x4*)(p + 32) = ob;
        }
        bf16_t* zm = ZM + (size_t)row * 512;
        { const u32x2 q = *(const u32x2*)(zm + 4 * lane); const float a0 = bflo(q.x), a1 = bfhi(q.x), a2 = bflo(q.y), a3 = bfhi(q.y);
          const float rs = 1.0f / sqrtf(wave_sum((a0 * a0 + a1 * a1) + (a2 * a2 + a3 * a3)) * (1.0f / 256.0f) + EPS);
          u32x2 o; o.x = cvt_pk_bf16(a0 * rs, a1 * rs); o.y = cvt_pk_bf16(a2 * rs, a3 * rs); *(u32x2*)(zm + 4 * lane) = o; }
        { float a0 = 0.f, a1 = 0.f, a2 = 0.f, a3 = 0.f; if (lane < 32) { const u32x2 q = *(const u32x2*)(zm + 256 + 4 * lane); a0 = bflo(q.x); a1 = bfhi(q.x); a2 = bflo(q.y); a3 = bfhi(q.y); }
          const float rs = 1.0f / sqrtf(wave_sum((a0 * a0 + a1 * a1) + (a2 * a2 + a3 * a3)) * (1.0f / 128.0f) + EPS);
          if (lane < 32) { u32x2 o; o.x = cvt_pk_bf16(a0 * rs, a1 * rs); o.y = cvt_pk_bf16(a2 * rs, a3 * rs); *(u32x2*)(zm + 256 + 4 * lane) = o; } }
        if (lane < 16) { const float x1 = bf2f(zm[384 + lane]), x2 = bf2f(zm[384 + 16 + lane]); float y1 = x1, y2 = x2;
            if (lat) { const float pos = lane < 8 ? prow : pcol; const float inv = exp2f(-(float)(lane & 7) * (13.287712379549449f / 8.0f)); const float rev = pos * inv * 0.15915494309189535f;
                const float c = __builtin_amdgcn_cosf(rev), s = __builtin_amdgcn_sinf(rev); y1 = x1 * c - x2 * s; y2 = x1 * s + x2 * c; }
            KR[(size_t)row * 32 + lane] = f2bf(y1); KR[(size_t)row * 32 + 16 + lane] = f2bf(y2); }
    }
}
__device__ __forceinline__ void mla_q_rope(const Args& A) {
    const int lane = ltid() & 63; bf16_t* QM = WSP(bf16_t, WS_QM);
    for (int row = gwave(); row < RL; row += ngwaves()) {
        const int tok = row & (SEQ - 1); const int h = lane >> 4, j = lane & 15; bf16_t* p = QM + (size_t)row * 1024 + h * 96 + 64 + j;
        const float x1 = bf2f(p[0]), x2 = bf2f(p[16]); const float pos = j < 8 ? (float)(tok >> 6) : (float)(tok & 63);
        const float inv = exp2f(-(float)(j & 7) * (13.287712379549449f / 8.0f)); const float rev = pos * inv * 0.15915494309189535f;
        const float c = __builtin_amdgcn_cosf(rev), s = __builtin_amdgcn_sinf(rev);
        p[0] = f2bf(x1 * c - x2 * s); p[16] = f2bf(x1 * s + x2 * c);
    }
}

__device__ __forceinline__ void seq_bounds(int row, int& lo, int& hi) { if (row < RL) { lo = row & ~(SEQ - 1); hi = lo + SEQ; } else { lo = RL + ((row - RL) & ~(NCTX - 1)); hi = lo + NCTX; } }

__device__ __forceinline__ void conformer_tiles(const Args& A, int l, char* lds, int nrows) {
    float* glu = (float*)lds; float* ub = glu + 62 * 256;
    const int tid = ltid(), lane = tid & 63, w = tid >> 6, c = tid & 255, half = tid >> 8;
    const bf16_t* ZC = WSP(bf16_t, WS_ZC); bf16_t* Y = WSP(bf16_t, WS_Y);
    float wk[31];
#pragma unroll
    for (int k = 0; k < 31; ++k) wk[k] = A.in[I_CDW][(size_t)l * 31 * 256 + k * 256 + c];
    const f32x4 lg = *(const f32x4*)(A.in[I_CLNG] + l * 256 + 4 * lane), lb = *(const f32x4*)(A.in[I_CLNB] + l * 256 + 4 * lane);
    for (int it = blockIdx.x; it < nrows / 32; it += gridDim.x) {
        const int row0 = it * 32; int lo, hi; seq_bounds(row0, lo, hi);
        for (int idx = tid; idx < 62 * 64; idx += NT) { const int r = idx >> 6, c4 = (idx & 63) * 4, grow = row0 - 15 + r; f32x4 g = {0.f, 0.f, 0.f, 0.f};
            if (grow >= lo && grow < hi) { const u32x2 a = *(const u32x2*)(ZC + (size_t)grow * 512 + c4), b = *(const u32x2*)(ZC + (size_t)grow * 512 + 256 + c4);
                g.x = bflo(a.x) * sigmoidf_(bflo(b.x)); g.y = bfhi(a.x) * sigmoidf_(bfhi(b.x)); g.z = bflo(a.y) * sigmoidf_(bflo(b.y)); g.w = bfhi(a.y) * sigmoidf_(bfhi(b.y)); }
            *(f32x4*)(glu + r * 256 + c4) = g; }
        __syncthreads();
        { float win[46];
#pragma unroll
            for (int k = 0; k < 46; ++k) win[k] = glu[(half * 16 + k) * 256 + c];
#pragma unroll
            for (int q = 0; q < 16; ++q) { float s = 0.f;
#pragma unroll
                for (int k = 0; k < 31; ++k) s += wk[k] * win[q + k];
                ub[(half * 16 + q) * 256 + c] = s; } }
        __syncthreads();
#pragma unroll
        for (int q = 0; q < 4; ++q) { const int tt = w * 4 + q; const f32x4 x = *(const f32x4*)(ub + tt * 256 + 4 * lane);
            const float mu = wave_sum((x.x + x.y) + (x.z + x.w)) * (1.0f / 256.0f); const f32x4 d = x - mu;
            const float var = wave_sum((d.x * d.x + d.y * d.y) + (d.z * d.z + d.w * d.w)) * (1.0f / 256.0f); const float rstd = 1.0f / sqrtf(var + EPS);
            const f32x4 y = d * rstd * lg + lb;
            u32x2 o; o.x = cvt_pk_bf16(siluf_(y.x), siluf_(y.y)); o.y = cvt_pk_bf16(siluf_(y.z), siluf_(y.w));
            *(u32x2*)(Y + (size_t)(row0 + tt) * 1280 + 768 + 4 * lane) = o; }
        __syncthreads();
    }
}
__device__ __forceinline__ void hyena_pre_tiles(const Args& A, int l, char* lds, int nrows) {
    bf16_t* zt = (bf16_t*)lds;
    const int tid = ltid(), lane = tid & 63, w = tid >> 6;
    const bf16_t* ZH = WSP(bf16_t, WS_ZH); bf16_t* HYT = WSP(bf16_t, WS_HYT);
    for (int it = (blockIdx.x + gridDim.x - 16u % gridDim.x) % gridDim.x; it < (nrows / 128) * 3; it += gridDim.x) {
        const int tile = it / 3, cg = it % 3, row0 = tile * 128; int lo, hi; seq_bounds(row0, lo, hi);
        for (int idx = tid; idx < 130 * 32; idx += NT) { const int r = idx >> 5, c8 = (idx & 31) * 8, grow = row0 - 1 + r; u32x4 v = {0u, 0u, 0u, 0u};
            if (grow >= lo && grow < hi) v = *(const u32x4*)(ZH + (size_t)grow * 768 + cg * 256 + c8);
            unsigned* d = (unsigned*)(zt + r * 258 + c8); d[0] = v.x; d[1] = v.y; d[2] = v.z; d[3] = v.w; }
        __syncthreads();
        const bool lat = row0 < RL; const int b = lat ? row0 / SEQ : (row0 - RL) / NCTX, t0 = lat ? row0 % SEQ : (row0 - RL) % NCTX;
        const int gchl = cg * 256 + w * 32 + (lane & 31);
        const float w0l = A.in[I_HSW][(size_t)l * 3 * 768 + gchl], w1l = A.in[I_HSW][(size_t)l * 3 * 768 + 768 + gchl], w2l = A.in[I_HSW][(size_t)l * 3 * 768 + 1536 + gchl], bbl = A.in[I_HSB][l * 768 + gchl];
        for (int q = 0; q < 32; ++q) { const int ch = w * 32 + q, gch = cg * 256 + ch;
            const float w0 = __uint_as_float(__builtin_amdgcn_readlane(__float_as_uint(w0l), q)), w1 = __uint_as_float(__builtin_amdgcn_readlane(__float_as_uint(w1l), q)),
                        w2 = __uint_as_float(__builtin_amdgcn_readlane(__float_as_uint(w2l), q)), bb = __uint_as_float(__builtin_amdgcn_readlane(__float_as_uint(bbl), q));
            const float z0 = bf2f(zt[(2 * lane) * 258 + ch]), z1 = bf2f(zt[(2 * lane + 1) * 258 + ch]), z2 = bf2f(zt[(2 * lane + 2) * 258 + ch]), z3 = bf2f(zt[(2 * lane + 3) * 258 + ch]);
            const float o0 = w0 * z0 + w1 * z1 + w2 * z2 + bb, o1 = w0 * z1 + w1 * z2 + w2 * z3 + bb;
            bf16_t* dst = lat ? HYT + ((size_t)(b * 768 + gch)) * SEQ + t0 : HYT + (size_t)2 * 768 * SEQ + ((size_t)(b * 768 + gch)) * NCTX + t0;
            *(unsigned*)(dst + 2 * lane) = cvt_pk_bf16(o0, o1); }
        __syncthreads();
    }
}
typedef _Float16 f16x8 __attribute__((ext_vector_type(8)));
__device__ __forceinline__ void hyena_filters(const Args& A, int l, char* lds, bool with_ctx) {
    float* h2 = (float*)lds; float* w3s = h2 + 256 * 68;
    const int tid = ltid(), lane = tid & 63, w = tid >> 6, l16 = lane & 15, lg = lane >> 4;
    const int nit = 64 * 8 + (with_ctx ? 8 : 0);
    for (int it = (blockIdx.x + gridDim.x - 32u % gridDim.x) % gridDim.x; it < nit; it += gridDim.x) {
        const bool isc = it >= 512; const int r = isc ? it - 512 : it, tt = r >> 3, ct = r & 7, n = isc ? NCTX : SEQ, t0 = tt * 256, col0 = ct * 128;
        const float* hsrc = isc ? WSP(float, WS_HID2C) + (size_t)l * NCTX * 64 : WSP(float, WS_HID2) + (size_t)l * SEQ * 64;
        for (int idx = tid; idx < 256 * 16; idx += NT) { const int rr = idx >> 4, c4 = (idx & 15) * 4; *(f32x4*)(h2 + rr * 68 + c4) = *(const f32x4*)(hsrc + (size_t)(t0 + rr) * 64 + c4); }
        for (int idx = tid; idx < 64 * 32; idx += NT) { const int j = idx >> 5, c4 = (idx & 31) * 4; *(f32x4*)(w3s + j * 132 + c4) = *(const f32x4*)(A.in[I_FW3] + (size_t)l * 64 * 1024 + j * 1024 + col0 + c4); }
        __syncthreads();
        f16x8 bt[2][2];
#pragma unroll
        for (int tb = 0; tb < 2; ++tb)
#pragma unroll
            for (int ks = 0; ks < 2; ++ks) { const float* hp = h2 + (w * 32 + tb * 16 + l16) * 68 + ks * 32 + lg * 8; const f32x4 x0 = *(const f32x4*)hp, x1 = *(const f32x4*)(hp + 4);
                bt[tb][ks] = (f16x8){(_Float16)x0.x, (_Float16)x0.y, (_Float16)x0.z, (_Float16)x0.w, (_Float16)x1.x, (_Float16)x1.y, (_Float16)x1.z, (_Float16)x1.w}; }
        const int t_l = t0 + w * 32 + l16;
#pragma unroll
        for (int cb = 0; cb < 8; ++cb) {
            f16x8 at[2];
#pragma unroll
            for (int ks = 0; ks < 2; ++ks) { const float* wp = w3s + (ks * 32 + lg * 8) * 132 + cb * 16 + l16;
                at[ks] = (f16x8){(_Float16)wp[0], (_Float16)wp[132], (_Float16)wp[2 * 132], (_Float16)wp[3 * 132], (_Float16)wp[4 * 132], (_Float16)wp[5 * 132], (_Float16)wp[6 * 132], (_Float16)wp[7 * 132]}; }
#pragma unroll
            for (int tb = 0; tb < 2; ++tb) { f32x4 d = {0.f, 0.f, 0.f, 0.f};
                d = __builtin_amdgcn_mfma_f32_16x16x32_f16(at[0], bt[tb][0], d, 0, 0, 0); d = __builtin_amdgcn_mfma_f32_16x16x32_f16(at[1], bt[tb][1], d, 0, 0, 0);
                const int t = t_l + tb * 16; const float tn = (float)t / (float)(n - 1);
#pragma unroll
                for (int i = 0; i < 4; ++i) { const int col = col0 + cb * 16 + lg * 4 + i, ch = col & 255; const float delta = 3.0701134573253945f + (float)ch * (12.280453829301578f / 255.0f);
                    const float v = d[i] * __expf(-tn * delta);
                    if (isc) WSP(float, WS_HC)[(size_t)col * NCTX + t] = v; else WSP(bf16_t, WS_HF)[(size_t)col * SEQ + t] = f2bf(v); } }
        }
        __syncthreads();
    }
}

__device__ __forceinline__ unsigned hcx_bits(hcx h) { return __builtin_bit_cast(unsigned, h); }
__device__ __forceinline__ hcx bits_hcx(unsigned u) { return __builtin_bit_cast(hcx, u); }
__device__ __forceinline__ float block_sum(float v, float* red) {
    v = wave_sum(v); if ((ltid() & 63) == 0) red[ltid() >> 6] = v; __syncthreads();
    float s = 0.f;
#pragma unroll
    for (int q = 0; q < 8; ++q) s += red[q];
    __syncthreads(); return s;
}
__device__ __forceinline__ void ld8bf(const bf16_t* p, float (&v)[8]) { const u32x4 q = *(const u32x4*)p; v[0] = bflo(q.x); v[1] = bfhi(q.x); v[2] = bflo(q.y); v[3] = bfhi(q.y); v[4] = bflo(q.z); v[5] = bfhi(q.z); v[6] = bflo(q.w); v[7] = bfhi(q.w); }
__device__ __forceinline__ void hyena_item(const Args& A, int l, int c, char* lds, unsigned char* scr) {
    LAS hcx* buf = (LAS hcx*)(LAS char*)lds; LAS hcx* tw = buf + FFT_BUF_ELEMS; float* red = (float*)(lds + FFT_LDS_BYTES);
    const int tid = ltid(); constexpr int n = SEQ; constexpr float inv2n = 1.0f / (2.0f * n);
    constexpr float FS = 16384.0f, DS = 1.0f / 128.0f, OS = 128.0f / (2.0f * n); const _Float16 KS = (_Float16)(1.0f / 16384.0f);
    const bf16_t* HYT = WSP(bf16_t, WS_HYT); const bf16_t* HF = WSP(bf16_t, WS_HF); bf16_t* HYO = WSP(bf16_t, WS_HYO);
    cpx* yev = (cpx*)scr; unsigned* v1s = (unsigned*)(scr + 131072);
    int tl;
#define LAUNDER() do { tl = tid; asm volatile("" : "+v"(tl)); } while (0)
    fft_fill_tables(tw, tid);
    __syncthreads();
#pragma unroll 1
    for (int o = 0; o < 2; ++o) {
        const bf16_t* hf = HF + (size_t)(o * 512 + c) * SEQ; const bf16_t* hb = HF + (size_t)(o * 512 + 256 + c) * SEQ;
        float sf = 0.f, sb = 0.f;
        LAUNDER();
#pragma unroll
        for (int cc = 0; cc < 4; ++cc) { const int t0 = 8 * (tl + NT * cc); float a[8], b[8]; ld8bf(hf + t0, a); ld8bf(hb + t0, b);
#pragma unroll
            for (int e = 0; e < 8; ++e) { sf += fabsf(a[e]); sb += fabsf(b[e]); } }
        sf = block_sum(sf, red); sb = block_sum(sb, red);
        const float inf = FS / sf, inb = FS / sb;
        u32x4 zr[4][2];
        { const bf16_t* vin0 = HYT + (size_t)(0 * 768 + 512 + c) * SEQ; const bf16_t* vin1 = HYT + (size_t)(1 * 768 + 512 + c) * SEQ; LAUNDER();
#pragma unroll
          for (int cc = 0; cc < 4; ++cc) { const int t0 = 8 * (tl + NT * cc);
              if (o == 0) { zr[cc][0] = *(const u32x4*)(vin0 + t0); zr[cc][1] = *(const u32x4*)(vin1 + t0); } else { zr[cc][0] = *(const u32x4*)(v1s + t0); zr[cc][1] = *(const u32x4*)(v1s + t0 + 4); } } }
        unsigned Ke[8][4], Ko[8][4];
        LAUNDER();
#pragma unroll 2
        for (int cc = 0; cc < 4; ++cc) { const int t0 = 8 * (tl + NT * cc); float a[8], b[8]; ld8bf(hf + t0, a); ld8bf(hb + (n - 8 - t0), b);
#pragma unroll
            for (int e = 0; e < 8; ++e) { const float hbp = (t0 + e) >= 1 ? b[7 - e] * inb : 0.f; buf[fpad(t0 + e)] = hmk(a[e] * inf + hbp, 0.f); } }
        __syncthreads(); fft_fwd3(buf, tw, tid);
LAUNDER();
#pragma unroll
        for (int i = 0; i < 8; ++i) { hcx e[4]; fft_mid_load(buf, tl, i, e);
#pragma unroll
            for (int q = 0; q < 4; ++q) Ke[i][q] = hcx_bits(e[q] * KS);
            asm volatile("" : "+v"(Ke[i][0]), "+v"(Ke[i][1]), "+v"(Ke[i][2]), "+v"(Ke[i][3]) :: "memory"); }
        __syncthreads();
        LAUNDER();
#pragma unroll 2
        for (int cc = 0; cc < 4; ++cc) { const int t0 = 8 * (tl + NT * cc); float a[8], b[8]; ld8bf(hf + t0, a); ld8bf(hb + (n - 8 - t0), b);
#pragma unroll
            for (int e = 0; e < 8; ++e) { const float hbp = (t0 + e) >= 1 ? b[7 - e] * inb : 0.f; const float r = a[e] * inf - hbp; const cpx w = twid<false>((float)(t0 + e) * inv2n);
                buf[fpad(t0 + e)] = hmk(r * w.x, r * w.y); } }
        __syncthreads(); fft_fwd3(buf, tw, tid);
LAUNDER();
#pragma unroll
        for (int i = 0; i < 8; ++i) { hcx e[4]; fft_mid_load(buf, tl, i, e);
#pragma unroll
            for (int q = 0; q < 4; ++q) Ko[i][q] = hcx_bits(e[q] * KS);
            asm volatile("" : "+v"(Ko[i][0]), "+v"(Ko[i][1]), "+v"(Ko[i][2]), "+v"(Ko[i][3]) :: "memory"); }
        __syncthreads();
#define UNPACK_Z(cc, z0, z1) do { const u32x4 qa = zr[cc][0], qb = zr[cc][1]; if (o == 0) { \
            z0[0] = bflo(qa.x); z0[1] = bfhi(qa.x); z0[2] = bflo(qa.y); z0[3] = bfhi(qa.y); z0[4] = bflo(qa.z); z0[5] = bfhi(qa.z); z0[6] = bflo(qa.w); z0[7] = bfhi(qa.w); \
            z1[0] = bflo(qb.x); z1[1] = bfhi(qb.x); z1[2] = bflo(qb.y); z1[3] = bfhi(qb.y); z1[4] = bflo(qb.z); z1[5] = bfhi(qb.z); z1[6] = bflo(qb.w); z1[7] = bfhi(qb.w); } else { \
            z0[0] = bflo(qa.x); z1[0] = bfhi(qa.x); z0[1] = bflo(qa.y); z1[1] = bfhi(qa.y); z0[2] = bflo(qa.z); z1[2] = bfhi(qa.z); z0[3] = bflo(qa.w); z1[3] = bfhi(qa.w); \
            z0[4] = bflo(qb.x); z1[4] = bfhi(qb.x); z0[5] = bflo(qb.y); z1[5] = bfhi(qb.y); z0[6] = bflo(qb.z); z1[6] = bfhi(qb.z); z0[7] = bflo(qb.w); z1[7] = bfhi(qb.w); } } while (0)
        LAUNDER();
#pragma unroll
        for (int cc = 0; cc < 4; ++cc) { const int t0 = 8 * (tl + NT * cc); float z0[8], z1[8]; UNPACK_Z(cc, z0, z1);
#pragma unroll
            for (int e = 0; e < 8; ++e) buf[fpad(t0 + e)] = hmk(z0[e] * DS, z1[e] * DS); }
        __syncthreads(); fft_fwd3(buf, tw, tid);
LAUNDER();
#pragma unroll
        for (int i = 0; i < 8; ++i) { hcx e[4], k[4]; fft_mid_load(buf, tl, i, e);
#pragma unroll
            for (int q = 0; q < 4; ++q) k[q] = bits_hcx(Ke[i][q]);
            fft_mid_mulstore(buf, tl, i, e, k); asm volatile("" ::: "memory"); }
        __syncthreads(); fft_inv3(buf, tw, tid);
        LAUNDER();
        unsigned yv[4][8];
#pragma unroll
        for (int cc = 0; cc < 4; ++cc) { const int t0 = 8 * (tl + NT * cc);
#pragma unroll
            for (int e = 0; e < 8; ++e) yv[cc][e] = hcx_bits(buf[fpad(t0 + e)]);
            asm volatile("" : "+v"(yv[cc][0]), "+v"(yv[cc][1]), "+v"(yv[cc][2]), "+v"(yv[cc][3]), "+v"(yv[cc][4]), "+v"(yv[cc][5]), "+v"(yv[cc][6]), "+v"(yv[cc][7]) :: "memory"); }
        __syncthreads();
        LAUNDER();
#pragma unroll
        for (int cc = 0; cc < 4; ++cc) { const int t0 = 8 * (tl + NT * cc); float z0[8], z1[8]; UNPACK_Z(cc, z0, z1);
#pragma unroll
            for (int e = 0; e < 8; ++e) { cpx z; z.x = z0[e] * DS; z.y = z1[e] * DS; z = cmul(z, twid<false>((float)(t0 + e) * inv2n)); buf[fpad(t0 + e)] = hmk(z.x, z.y); } }
        __syncthreads(); fft_fwd3(buf, tw, tid);
LAUNDER();
#pragma unroll
        for (int i = 0; i < 8; ++i) { hcx e[4], k[4]; fft_mid_load(buf, tl, i, e);
#pragma unroll
            for (int q = 0; q < 4; ++q) k[q] = bits_hcx(Ko[i][q]);
            fft_mid_mulstore(buf, tl, i, e, k); asm volatile("" ::: "memory"); }
        __syncthreads(); fft_inv3(buf, tw, tid);
        const float skip = A.in[I_HSKIP][l * 512 + o * 256 + c];
        const bf16_t* g0 = HYT + (size_t)(0 * 768 + o * 256 + c) * SEQ; const bf16_t* g1 = HYT + (size_t)(1 * 768 + o * 256 + c) * SEQ;
        LAUNDER();
#pragma unroll
        for (int cc = 0; cc < 4; ++cc) { const int t0 = 8 * (tl + NT * cc); float z0[8], z1[8], ga[8], gb[8]; UNPACK_Z(cc, z0, z1); ld8bf(g0 + t0, ga); ld8bf(g1 + t0, gb);
            float r0[8], r1[8];
#pragma unroll
            for (int e = 0; e < 8; e += 2) { const hcx y0 = bits_hcx(yv[cc][e]), y1 = bits_hcx(yv[cc][e + 1]); const hcx h0 = buf[fpad(t0 + e)], h1 = buf[fpad(t0 + e + 1)];
                cpx b0; b0.x = (float)h0.x; b0.y = (float)h0.y; cpx b1; b1.x = (float)h1.x; b1.y = (float)h1.y;
                const cpx yo0 = cmul(b0, twid<true>((float)(t0 + e) * inv2n)), yo1 = cmul(b1, twid<true>((float)(t0 + e + 1) * inv2n));
                r0[e] = ga[e] * (((float)y0.x + yo0.x) * OS + skip * z0[e]); r1[e] = gb[e] * (((float)y0.y + yo0.y) * OS + skip * z1[e]);
                r0[e + 1] = ga[e + 1] * (((float)y1.x + yo1.x) * OS + skip * z0[e + 1]); r1[e + 1] = gb[e + 1] * (((float)y1.y + yo1.y) * OS + skip * z1[e + 1]); }
            if (o == 0) { u32x4 qa, qb; qa.x = cvt_pk_bf16(r0[0], r1[0]); qa.y = cvt_pk_bf16(r0[1], r1[1]); qa.z = cvt_pk_bf16(r0[2], r1[2]); qa.w = cvt_pk_bf16(r0[3], r1[3]);
                qb.x = cvt_pk_bf16(r0[4], r1[4]); qb.y = cvt_pk_bf16(r0[5], r1[5]); qb.z = cvt_pk_bf16(r0[6], r1[6]); qb.w = cvt_pk_bf16(r0[7], r1[7]);
                *(u32x4*)(v1s + t0) = qa; *(u32x4*)(v1s + t0 + 4) = qb; }
            else { u32x4 qa, qb; qa.x = cvt_pk_bf16(r0[0], r0[1]); qa.y = cvt_pk_bf16(r0[2], r0[3]); qa.z = cvt_pk_bf16(r0[4], r0[5]); qa.w = cvt_pk_bf16(r0[6], r0[7]);
                qb.x = cvt_pk_bf16(r1[0], r1[1]); qb.y = cvt_pk_bf16(r1[2], r1[3]); qb.z = cvt_pk_bf16(r1[4], r1[5]); qb.w = cvt_pk_bf16(r1[6], r1[7]);
                *(u32x4*)(HYO + (size_t)(0 * 256 + c) * SEQ + t0) = qa; *(u32x4*)(HYO + (size_t)(1 * 256 + c) * SEQ + t0) = qb; } }
        __syncthreads();
    }
#undef UNPACK_Z
#undef LAUNDER
}
__device__ __forceinline__ void hyena_ctx_item(const Args& A, int l, int c, char* lds) {
    float* hfl = (float*)lds; float* hbl = hfl + 512; float* vv = hbl + 512; float* nrm = vv + 512;
    const int tid = ltid(), t = tid & 255, b = tid >> 8, lane = tid & 63, w = tid >> 6;
    const float* HC = WSP(float, WS_HC); const bf16_t* HYTC = WSP(bf16_t, WS_HYT) + (size_t)2 * 768 * SEQ; bf16_t* HYOC = WSP(bf16_t, WS_HYO) + (size_t)2 * 256 * SEQ;
    if (w < 4) { const int col = (w >> 1) * 512 + (w & 1) * 256 + c; float s = 0.f;
#pragma unroll
        for (int q = 0; q < 4; ++q) s += fabsf(HC[(size_t)col * NCTX + lane + 64 * q]);
        s = wave_sum(s); if (lane == 0) nrm[w] = s; }
    vv[b * 256 + t] = bf2f(HYTC[(size_t)(b * 768 + 512 + c) * NCTX + t]);
    __syncthreads();
    hfl[b * 256 + t] = HC[(size_t)(b * 512 + c) * NCTX + t] / nrm[b * 2];
    hbl[b * 256 + t] = HC[(size_t)(b * 512 + 256 + c) * NCTX + t] / nrm[b * 2 + 1];
    __syncthreads();
    for (int o = 0; o < 2; ++o) {
        float y = 0.f;
        for (int s = 0; s < NCTX; ++s) { const float k = s <= t ? hfl[o * 256 + t - s] : hbl[o * 256 + s - t - 1]; y += k * vv[b * 256 + s]; }
        const float gate = bf2f(HYTC[(size_t)(b * 768 + o * 256 + c) * NCTX + t]); const float r = gate * (y + A.in[I_HSKIP][l * 512 + o * 256 + c] * vv[b * 256 + t]);
        __syncthreads();
        vv[b * 256 + t] = r;
        __syncthreads();
    }
    HYOC[(size_t)(b * 256 + c) * NCTX + t] = f2bf(vv[b * 256 + t]);
    __syncthreads();
}
__device__ __forceinline__ void hyena_post_tiles(const Args& A, char* lds, int nrows) {
    bf16_t* tl = (bf16_t*)lds;
    const int tid = ltid(); const bf16_t* HYO = WSP(bf16_t, WS_HYO); bf16_t* Y = WSP(bf16_t, WS_Y);
    for (int it = blockIdx.x; it < nrows / 64; it += gridDim.x) {
        const int row0 = it * 64; const bool lat = row0 < RL; const int b = lat ? row0 / SEQ : (row0 - RL) / NCTX, t0 = lat ? row0 % SEQ : (row0 - RL) % NCTX;
        for (int idx = tid; idx < 256 * 8; idx += NT) { const int ch = idx >> 3, c8 = (idx & 7) * 8;
            const bf16_t* src = lat ? HYO + (size_t)(b * 256 + ch) * SEQ + t0 + c8 : HYO + (size_t)2 * 256 * SEQ + (size_t)(b * 256 + ch) * NCTX + t0 + c8;
            const u32x4 v = *(const u32x4*)src; unsigned* d = (unsigned*)(tl + ch * 66 + c8); d[0] = v.x; d[1] = v.y; d[2] = v.z; d[3] = v.w; }
        __syncthreads();
        for (int idx = tid; idx < 64 * 32; idx += NT) { const int tok = idx >> 5, c8 = (idx & 31) * 8; unsigned short e[8];
#pragma unroll
            for (int q = 0; q < 8; ++q) e[q] = tl[(c8 + q) * 66 + tok];
            u32x4 o; o.x = e[0] | ((unsigned)e[1] << 16); o.y = e[2] | ((unsigned)e[3] << 16); o.z = e[4] | ((unsigned)e[5] << 16); o.w = e[6] | ((unsigned)e[7] << 16);
            *(u32x4*)(Y + (size_t)(row0 + tok) * 1280 + 512 + c8) = o; }
        __syncthreads();
    }
}

namespace epi {
using pg8::Unit; using pg8::BM; using pg8::HALF;
__device__ __forceinline__ u32x4 pack8(const f32x4& a, const f32x4& b) { u32x4 w; w.x = cvt_pk_bf16(a[0], a[1]); w.y = cvt_pk_bf16(a[2], a[3]); w.z = cvt_pk_bf16(b[0], b[1]); w.w = cvt_pk_bf16(b[2], b[3]); return w; }
struct Win { static constexpr bool PERM = true; bf16_t *zd, *zh, *zc, *zm;
    __device__ __forceinline__ void operator()(const f32x4 (&acc)[2][2][4][2], const Unit& u, int wr, int wc, int fr, int fq) const {
        bf16_t* base; int ldc, colt; const int pn = u.pn;
        if (pn < 6) { base = zd; ldc = 1536; colt = pn * 256; } else if (pn < 9) { base = zh; ldc = 768; colt = (pn - 6) * 256; } else if (pn < 11) { base = zc; ldc = 512; colt = (pn - 9) * 256; } else { base = zm; ldc = 512; colt = (pn - 11) * 256; }
        const int row0 = u.pm * BM + wr * 64 + fr, col0 = colt + wc * 32 + 8 * fq;
#pragma unroll
        for (int ai = 0; ai < 2; ++ai)
#pragma unroll
            for (int m = 0; m < 4; ++m) { bf16_t* rowp = base + (size_t)(row0 + ai * HALF + m * 16) * ldc + col0;
#pragma unroll
                for (int bj = 0; bj < 2; ++bj) *(u32x4*)(rowp + bj * HALF) = pack8(acc[ai][bj][m][0], acc[ai][bj][m][1]); }
    } };
struct Mla { static constexpr bool PERM = true; bf16_t* qkv;
    __device__ __forceinline__ void operator()(const f32x4 (&acc)[2][2][4][2], const Unit& u, int wr, int wc, int fr, int fq) const {
        const int row0 = u.pm * BM + wr * 64 + fr, col0 = u.pn * BM + wc * 32 + 8 * fq;
#pragma unroll
        for (int ai = 0; ai < 2; ++ai)
#pragma unroll
            for (int m = 0; m < 4; ++m) { bf16_t* rowp = qkv + (size_t)(row0 + ai * HALF + m * 16) * 1024 + col0;
#pragma unroll
                for (int bj = 0; bj < 2; ++bj) *(u32x4*)(rowp + bj * HALF) = pack8(acc[ai][bj][m][0], acc[ai][bj][m][1]); }
    } };
struct PBranch { static constexpr bool PERM = true; bf16_t* P;
    __device__ __forceinline__ void operator()(const f32x4 (&acc)[2][2][4][2], const Unit& u, int wr, int wc, int fr, int fq) const {
        const int row0 = u.pm * BM + wr * 64 + fr, col0 = u.tag * 1024 + u.pn * BM + wc * 32 + 8 * fq;
#pragma unroll
        for (int ai = 0; ai < 2; ++ai)
#pragma unroll
            for (int m = 0; m < 4; ++m) { bf16_t* rowp = P + (size_t)(row0 + ai * HALF + m * 16) * 4096 + col0;
#pragma unroll
                for (int bj = 0; bj < 2; ++bj) *(u32x4*)(rowp + bj * HALF) = pack8(acc[ai][bj][m][0], acc[ai][bj][m][1]); }
    } };
struct Gate { static constexpr bool PERM = false; const bf16_t* P; bf16_t* ACC;
    __device__ __forceinline__ void operator()(const f32x4 (&acc)[2][2][4][2], const Unit& u, int wr, int wc, int fr, int fq) const {
        const int row0 = u.pm * BM + wr * 64 + fr, chan = u.pn * 64 + wc * 16 + 4 * fq;
#pragma unroll
        for (int ai = 0; ai < 2; ++ai) {
            u32x2 pw[4][4];
#pragma unroll
            for (int m = 0; m < 4; ++m) { const bf16_t* pp = P + (size_t)(row0 + ai * HALF + m * 16) * 4096 + chan;
#pragma unroll
                for (int i = 0; i < 4; ++i) pw[m][i] = *(const u32x2*)(pp + i * 1024); }
            asm volatile("" ::: "memory");
#pragma unroll
            for (int m = 0; m < 4; ++m) { const int row = row0 + ai * HALF + m * 16; f32x4 s = {0.f, 0.f, 0.f, 0.f};
#pragma unroll
                for (int i = 0; i < 4; ++i) { const f32x4 g = acc[ai][i >> 1][m][i & 1];
                    s[0] += sigmoidf_(g[0]) * bflo(pw[m][i].x); s[1] += sigmoidf_(g[1]) * bfhi(pw[m][i].x); s[2] += sigmoidf_(g[2]) * bflo(pw[m][i].y); s[3] += sigmoidf_(g[3]) * bfhi(pw[m][i].y); }
                u32x2 w; w.x = cvt_pk_bf16(s[0], s[1]); w.y = cvt_pk_bf16(s[2], s[3]); *(u32x2*)(ACC + (size_t)row * 1024 + chan) = w; }
        }
    } };
struct Out { static constexpr bool PERM = false; const float* hsrc_lat; float* hdst_lat; const float* hsrc_ctx; float* hdst_ctx; const float* mod2;
    __device__ __forceinline__ void operator()(const f32x4 (&acc)[2][2][4][2], const Unit& u, int wr, int wc, int fr, int fq) const {
        const int v = u.pm < 64 ? 0 : (u.pm < 128 ? 1 : 2); const bool lat = u.pm < 128;
        const float* src = lat ? hsrc_lat : hsrc_ctx - (size_t)RL * D; float* dst = lat ? hdst_lat : hdst_ctx - (size_t)RL * D;
        const int row0 = u.pm * BM + wr * 64 + fr, col0 = u.pn * BM + wc * 32 + 4 * fq; const float* mg = mod2 + (size_t)v * 6144 + col0;
        f32x4 gv[2][2];
#pragma unroll
        for (int bj = 0; bj < 2; ++bj)
#pragma unroll
            for (int n = 0; n < 2; ++n) gv[bj][n] = *(const f32x4*)(mg + bj * HALF + n * 16);
#pragma unroll
        for (int ai = 0; ai < 2; ++ai)
#pragma unroll
            for (int m = 0; m < 4; ++m) { const size_t off = (size_t)(row0 + ai * HALF + m * 16) * D + col0;
#pragma unroll
                for (int bj = 0; bj < 2; ++bj)
#pragma unroll
                    for (int n = 0; n < 2; ++n) { const f32x4 hs = *(const f32x4*)(src + off + bj * HALF + n * 16); *(f32x4*)(dst + off + bj * HALF + n * 16) = hs + gv[bj][n] * acc[ai][bj][m][n]; } }
    } };
struct Ex1 { static constexpr bool PERM = true; bf16_t* HID;
    __device__ __forceinline__ void operator()(const f32x4 (&acc)[2][2][4][2], const Unit& u, int wr, int wc, int fr, int fq) const {
        const int row0 = u.pm * BM + wr * 64 + fr, f0 = u.pn * 128 + wc * 32 + 8 * fq;
#pragma unroll
        for (int ai = 0; ai < 2; ++ai)
#pragma unroll
            for (int m = 0; m < 4; ++m) { f32x4 a, b; const f32x4 g0 = acc[ai][0][m][0], g1 = acc[ai][0][m][1], u0 = acc[ai][1][m][0], u1 = acc[ai][1][m][1];
#pragma unroll
                for (int j = 0; j < 4; ++j) { a[j] = siluf_(g0[j]) * u0[j]; b[j] = siluf_(g1[j]) * u1[j]; }
                *(u32x4*)(HID + (size_t)(row0 + ai * HALF + m * 16) * EH + f0) = pack8(a, b); }
    } };
struct Ex2 { static constexpr bool PERM = true; bf16_t* YE; const float* grow;
    __device__ __forceinline__ void operator()(const f32x4 (&acc)[2][2][4][2], const Unit& u, int wr, int wc, int fr, int fq) const {
        const int row0 = u.pm * BM + wr * 64 + fr, col0 = u.pn * BM + wc * 32 + 8 * fq;
#pragma unroll
        for (int ai = 0; ai < 2; ++ai)
#pragma unroll
            for (int m = 0; m < 4; ++m) { const int row = row0 + ai * HALF + m * 16; const float g = grow[row];
#pragma unroll
                for (int bj = 0; bj < 2; ++bj) *(u32x4*)(YE + (size_t)row * D + col0 + bj * HALF) = pack8(acc[ai][bj][m][0] * g, acc[ai][bj][m][1] * g); }
    } };
}

__device__ __forceinline__ void router_rows(const Args& A, int l, char* lds, int nrows) {
    float* wrT = (float*)lds; const int tid = ltid(), lane = tid & 63;
    constexpr int WRS = 1028;
    { f32x4 lw[8];
#pragma unroll
      for (int q = 0; q < 8; ++q) lw[q] = *(const f32x4*)(A.in[I_WROUTER] + (size_t)l * D * NE + 4 * (tid + NT * q));
#pragma unroll
      for (int q = 0; q < 8; ++q) { const int i4 = 4 * (tid + NT * q), k = i4 >> 4, e0 = i4 & 15; wrT[(e0 + 0) * WRS + k] = lw[q].x; wrT[(e0 + 1) * WRS + k] = lw[q].y; wrT[(e0 + 2) * WRS + k] = lw[q].z; wrT[(e0 + 3) * WRS + k] = lw[q].w; } }
    __syncthreads();
    float* AFFT = WSP(float, WS_AFFT); int* INV = WSP(int, WS_INV);
    const int stride = ngwaves(); int row = gwave(); f32x4 vn[4];
#define RROW_PTR(r) ((r) < RL ? A.out + (size_t)(r) * D : WSP(float, WS_HCTX) + (size_t)((r) - RL) * D)
    if (row < nrows) { const float* src = RROW_PTR(row);
#pragma unroll
        for (int j = 0; j < 4; ++j) vn[j] = *(const f32x4*)(src + 4 * lane + 256 * j); }
    for (; row < nrows; row += stride) {
        f32x4 v[4]; float ss = 0.f;
#pragma unroll
        for (int j = 0; j < 4; ++j) { v[j] = vn[j]; ss += (v[j].x * v[j].x + v[j].y * v[j].y) + (v[j].z * v[j].z + v[j].w * v[j].w); }
        if (row + stride < nrows) { const float* src = RROW_PTR(row + stride);
#pragma unroll
            for (int j = 0; j < 4; ++j) vn[j] = *(const f32x4*)(src + 4 * lane + 256 * j); }
        const float rs = 1.0f / sqrtf(wave_sum(ss) * (1.0f / D) + EPS);
        const float* mod = WSP(float, WS_MOD) + (size_t)(l * 3 + row_vec(row)) * 6144; const float* g = A.in[I_GFFN] + l * D;
        bf16_t* urow = WSP(bf16_t, WS_U) + (size_t)row * D;
#pragma unroll
        for (int j = 0; j < 4; ++j) { const int c = 4 * lane + 256 * j; const f32x4 gg = *(const f32x4*)(g + c), sh = *(const f32x4*)(mod + 3 * 1024 + c), sc = *(const f32x4*)(mod + 4 * 1024 + c);
            v[j] = v[j] * rs * gg * (sc + 1.0f) + sh;
            u32x2 w; w.x = cvt_pk_bf16(v[j].x, v[j].y); w.y = cvt_pk_bf16(v[j].z, v[j].w); *(u32x2*)(urow + c) = w; }
        float lg[16];
#pragma unroll
        for (int e = 0; e < 16; ++e) { float s = 0.f;
#pragma unroll
            for (int j = 0; j < 4; ++j) { const f32x4 w = *(const f32x4*)(wrT + e * WRS + 4 * lane + 256 * j); s += (v[j].x * w.x + v[j].y * w.y) + (v[j].z * w.z + v[j].w * w.w); }
            lg[e] = s; }
#pragma unroll
        for (int i = 0; i < 8; ++i) { const bool up = (lane & 32) != 0; const float send = up ? lg[i] : lg[i + 8], keep = up ? lg[i + 8] : lg[i]; lg[i] = keep + __shfl_xor(send, 32); }
#pragma unroll
        for (int i = 0; i < 4; ++i) { const bool up = (lane & 16) != 0; const float send = up ? lg[i] : lg[i + 4], keep = up ? lg[i + 4] : lg[i]; lg[i] = keep + __shfl_xor(send, 16); }
#pragma unroll
        for (int i = 0; i < 2; ++i) { const bool up = (lane & 8) != 0; const float send = up ? lg[i] : lg[i + 2], keep = up ? lg[i + 2] : lg[i]; lg[i] = keep + __shfl_xor(send, 8); }
        { const bool up = (lane & 4) != 0; const float send = up ? lg[0] : lg[1], keep = up ? lg[1] : lg[0]; lg[0] = keep + __shfl_xor(send, 4); }
        float logit = lg[0]; logit += __shfl_xor(logit, 2); logit += __shfl_xor(logit, 1);
        const int e = ((lane >> 5) & 1) * 8 + ((lane >> 4) & 1) * 4 + ((lane >> 3) & 1) * 2 + ((lane >> 2) & 1);
        float mx = logit;
#pragma unroll
        for (int o = 4; o < 64; o <<= 1) mx = fmaxf(mx, __shfl_xor(mx, o));
        const float ex = __expf(logit - mx); float den = ex;
#pragma unroll
        for (int o = 4; o < 64; o <<= 1) den += __shfl_xor(den, o);
        const float mine = ex / den;
        if ((lane & 3) == 0) { const bool lat = row < RL;
            if (lat) AFFT[((size_t)(row / SEQ) * 16 + e) * SEQ + (row % SEQ)] = mine;
            else AFFT[(size_t)2 * 16 * SEQ + ((size_t)((row - RL) / NCTX) * 16 + e) * NCTX + ((row - RL) % NCTX)] = mine;
            INV[(size_t)row * 16 + e] = -1; }
    }
#undef RROW_PTR
}
__device__ __forceinline__ int block_sum_i(int v, int* red) {
#pragma unroll
    for (int o = 1; o < 64; o <<= 1) v += __shfl_xor(v, o);
    if ((ltid() & 63) == 0) red[ltid() >> 6] = v; __syncthreads();
    int s = 0;
#pragma unroll
    for (int q = 0; q < 8; ++q) s += red[q];
    __syncthreads(); return s;
}
__device__ __forceinline__ int block_excl_scan(int v, int* red) {
    const int lane = ltid() & 63, w = ltid() >> 6; int inc = v;
#pragma unroll
    for (int o = 1; o < 64; o <<= 1) { const int t = __shfl_up(inc, o); if (lane >= o) inc += t; }
    if (lane == 63) red[w] = inc; __syncthreads();
    int base = 0;
#pragma unroll
    for (int q = 0; q < 8; ++q) base += (q < w) ? red[q] : 0;
    __syncthreads(); return base + inc - v;
}
__device__ __forceinline__ void topk_select(const Args& A, char* lds, bool with_ctx) {
    int* red = (int*)lds; const int tid = ltid();
    const float* AFFT = WSP(float, WS_AFFT); int* SROW = WSP(int, WS_IDX); float* GROW = WSP(float, WS_GROW); int* INV = WSP(int, WS_INV);
    for (int it = blockIdx.x; it < (with_ctx ? 64 : 32); it += gridDim.x) {
        const bool isc = it >= 32; const int r = it & 31, b = r >> 4, e = r & 15; const int n = isc ? NCTX : SEQ, cap = isc ? CAPC : CAPL;
        const float* src = isc ? AFFT + (size_t)2 * 16 * SEQ + (size_t)(b * 16 + e) * NCTX : AFFT + (size_t)(b * 16 + e) * SEQ;
        unsigned key[32];
#pragma unroll
        for (int i = 0; i < 32; ++i) { const int t = tid + NT * i; key[i] = t < n ? __float_as_uint(src[t]) : 0u; }
        unsigned prefix = 0u; int krem = cap;
        for (int bit = 30; bit >= 0; --bit) { const unsigned cand = prefix | (1u << bit); int cnt = 0;
#pragma unroll
            for (int i = 0; i < 32; ++i) cnt += ((key[i] >> bit) == (cand >> bit)) ? 1 : 0;
            cnt = block_sum_i(cnt, red);
            if (cnt >= krem) prefix = cand; else krem -= cnt; }
        int cg = 0, ce = 0;
#pragma unroll
        for (int i = 0; i < 32; ++i) { cg += key[i] > prefix ? 1 : 0; ce += key[i] == prefix ? 1 : 0; }
        int sg = block_excl_scan(cg, red), se = block_excl_scan(ce, red);
        const int ngreater = cap - krem;
        const int xbase = isc ? NE * 4096 + e * 256 + b * CAPC : e * 4096 + b * CAPL;
        const int rowbase = isc ? RL + b * NCTX : b * SEQ;
#pragma unroll
        for (int i = 0; i < 32; ++i) { const int t = tid + NT * i; int slot = -1;
            if (key[i] > prefix) slot = sg++; else if (key[i] == prefix && prefix != 0u) { if (se < krem) slot = ngreater + se; ++se; }
            if (slot >= 0) { SROW[xbase + slot] = rowbase + t; GROW[xbase + slot] = __uint_as_float(key[i]); INV[(size_t)(rowbase + t) * 16 + e] = slot; } }
        if (isc && b == 0 && tid < 256 - 2 * CAPC) { SROW[NE * 4096 + e * 256 + 2 * CAPC + tid] = 0; GROW[NE * 4096 + e * 256 + 2 * CAPC + tid] = 0.f; }
        __syncthreads();
    }
}
__device__ __forceinline__ void moe_gather(const Args& A, bool with_ctx, float* GROW) {
    const int lane = ltid() & 63; const int* IDX = WSP(int, WS_IDX); const float* GV = WSP(float, WS_GATEV); const bf16_t* U = WSP(bf16_t, WS_U); bf16_t* XE = WSP(bf16_t, WS_XE);
    const int nx = with_ctx ? XROWS : NE * 4096;
    for (int xr = gwave(); xr < nx; xr += ngwaves()) {
        int srow = 0; float g = 0.f;
        if (xr < NE * 4096) { const int e = xr >> 12, s = xr & 4095, b = s >> 11, i = s & 2047; srow = b * SEQ + IDX[(b * 16 + e) * CAPL + i]; g = GV[(b * 16 + e) * CAPL + i]; }
        else { const int q = xr - NE * 4096, e = q >> 8, s = q & 255; if (s < 2 * CAPC) { const int b = s >> 5, i = s & 31; srow = RL + b * NCTX + IDX[2 * 16 * CAPL + (b * 16 + e) * CAPC + i]; g = GV[2 * 16 * CAPL + (b * 16 + e) * CAPC + i]; } }
        const u32x4* s4 = (const u32x4*)(U + (size_t)srow * D); u32x4* d4 = (u32x4*)(XE + (size_t)xr * D);
        d4[lane] = s4[lane]; d4[64 + lane] = s4[64 + lane];
        if (lane == 0) GROW[xr] = g;
    }
}
__device__ __forceinline__ void moe_combine(const Args& A, int l) {
    const int lane = ltid() & 63; const int* INV = WSP(int, WS_INV); const bf16_t* YE = WSP(bf16_t, WS_XE);
    const int nrows = l == 0 ? ROWS : RL;
    const int stride = ngwaves(); int row = gwave(); f32x4 vn[4]; int invn = -1;
#define CROW_PTR(r) ((r) < RL ? A.out + (size_t)(r) * D : WSP(float, WS_HCTX) + (size_t)((r) - RL) * D)
    if (row < nrows) { const float* src = CROW_PTR(row);
#pragma unroll
        for (int j = 0; j < 4; ++j) vn[j] = *(const f32x4*)(src + 4 * lane + 256 * j);
        invn = lane < 16 ? INV[(size_t)row * 16 + lane] : -1; }
    for (; row < nrows; row += stride) {
        const bool lat = row < RL; float* hp = CROW_PTR(row);
        f32x4 v[4], s[4];
#pragma unroll
        for (int j = 0; j < 4; ++j) { v[j] = vn[j]; s[j] = (f32x4){0.f, 0.f, 0.f, 0.f}; }
        const int myinv = invn;
        if (row + stride < nrows) { const float* src = CROW_PTR(row + stride);
#pragma unroll
            for (int j = 0; j < 4; ++j) vn[j] = *(const f32x4*)(src + 4 * lane + 256 * j);
            invn = lane < 16 ? INV[(size_t)(row + stride) * 16 + lane] : -1; }
        const int b = lat ? row / SEQ : (row - RL) / NCTX;
        unsigned m = (unsigned)(__ballot(myinv >= 0) & 0xFFFFull);
        while (m) {
            const bf16_t* yr[4]; float wq[4];
#pragma unroll
            for (int q = 0; q < 4; ++q) { const bool ok = m != 0u; const int e = ok ? __builtin_ctz(m) : 0; if (ok) m &= m - 1u;
                const int slot = ok ? __builtin_amdgcn_readlane(myinv, e) : 0;
                const size_t xr = lat ? (size_t)e * 4096 + b * 2048 + slot : (size_t)NE * 4096 + e * 256 + b * 32 + slot;
                yr[q] = (ok || q == 0) ? YE + xr * D : yr[0]; wq[q] = ok ? 1.f : 0.f; }
            u32x2 qv[4][4];
#pragma unroll
            for (int q = 0; q < 4; ++q)
#pragma unroll
                for (int j = 0; j < 4; ++j) qv[q][j] = *(const u32x2*)(yr[q] + 4 * lane + 256 * j);
#pragma unroll
            for (int q = 0; q < 4; ++q)
#pragma unroll
                for (int j = 0; j < 4; ++j) { s[j].x += wq[q] * bflo(qv[q][j].x); s[j].y += wq[q] * bfhi(qv[q][j].x); s[j].z += wq[q] * bflo(qv[q][j].y); s[j].w += wq[q] * bfhi(qv[q][j].y); }
        }
        const int vv = row_vec(row); const float* mod = WSP(float, WS_MOD) + (size_t)(l * 3 + vv) * 6144;
#pragma unroll
        for (int j = 0; j < 4; ++j) { const f32x4 g5 = *(const f32x4*)(mod + 5 * 1024 + 4 * lane + 256 * j); v[j] = v[j] + g5 * s[j]; }
        if (l == 0) {
#pragma unroll
            for (int j = 0; j < 4; ++j) *(f32x4*)(hp + 4 * lane + 256 * j) = v[j];
            const float* mod1 = WSP(float, WS_MOD) + (size_t)(1 * 3 + vv) * 6144;
            norm_mod_store(v, A.in[I_GMIX] + D, mod1, mod1 + 1024, WSP(bf16_t, WS_U) + (size_t)row * D, lane);
        } else {
            float ss = 0.f;
#pragma unroll
            for (int j = 0; j < 4; ++j) ss += (v[j].x * v[j].x + v[j].y * v[j].y) + (v[j].z * v[j].z + v[j].w * v[j].w);
            const float rs = 1.0f / sqrtf(wave_sum(ss) * (1.0f / D) + EPS);
#pragma unroll
            for (int j = 0; j < 4; ++j) { const f32x4 g = *(const f32x4*)(A.in[I_FNORM] + 4 * lane + 256 * j); *(f32x4*)(hp + 4 * lane + 256 * j) = v[j] * rs * g; }
        }
    }
#undef CROW_PTR
}

#define XB_TMO      128
#define XB_XCNT(j)  (256  + 64 * (j))
#define XB_XSUB(j)  (1280 + 64 * (j))
#define XB_XGEN(j)  (2304 + 64 * (j))
#define XB_TOP      3328
#define XB_TOPGEN   3392
#define XCD_BAR_WORDS 3456
#define XB_SPIN_CAP (1u << 22)
__device__ __forceinline__ unsigned xb_ld(unsigned* p)              { return __hip_atomic_load(p, __ATOMIC_RELAXED, __HIP_MEMORY_SCOPE_AGENT); }
__device__ __forceinline__ unsigned xb_add(unsigned* p, unsigned v) { return __hip_atomic_fetch_add(p, v, __ATOMIC_RELAXED, __HIP_MEMORY_SCOPE_AGENT); }
__device__ __forceinline__ unsigned xb_xcc_id() { return (unsigned)__builtin_amdgcn_s_getreg((3 << 11) | 20) & 0xFu; }
#define XB_SPIN(cond, bar) do { unsigned _sp = 0; while (cond) { __builtin_amdgcn_s_sleep(1); \
    if ((++_sp & 255u) == 0u) { if (xb_ld(&(bar)[XB_TMO])) break; if (_sp > XB_SPIN_CAP) { atomicAdd(&(bar)[XB_TMO], 1u); break; } } } } while (0)
struct XcdBarrier { unsigned* bar; unsigned x; volatile LAS unsigned* st; };
__device__ __forceinline__ XcdBarrier xcd_barrier_post(unsigned* bar, volatile LAS unsigned* st) {
    XcdBarrier b; b.bar = bar; b.x = xb_xcc_id(); b.st = st;
    if (threadIdx.x == 0) (void)xb_add(&bar[XB_XCNT(b.x)], 1u);
    return b;
}
__device__ __forceinline__ void xcd_barrier_complete(unsigned* bar, unsigned x, unsigned& nloc, unsigned& nx) {
    const unsigned G = gridDim.x * gridDim.y * gridDim.z;
    unsigned sum, cnt, mine, sp = 0u;
    for (;;) {
        sum = 0u; cnt = 0u; mine = 0u;
#pragma unroll
        for (unsigned j = 0; j < 16; ++j) { const unsigned c = xb_ld(&bar[XB_XCNT(j)]); sum += c; cnt += (c > 0u) ? 1u : 0u; mine = (j == x) ? c : mine; }
        if (sum == G) break;
        __builtin_amdgcn_s_sleep(1);
        if ((++sp & 255u) == 0u) { if (xb_ld(&bar[XB_TMO])) break; if (sp > XB_SPIN_CAP) { atomicAdd(&bar[XB_TMO], 1u); break; } }
    }
    nloc = mine > 0u ? mine : 1u; nx = cnt > 0u ? cnt : 1u;
}
__device__ __forceinline__ void xcd_barrier(const XcdBarrier& b) {
    asm volatile("s_waitcnt vmcnt(0)" ::: "memory");
    __syncthreads();
    if (threadIdx.x == 0) {
        unsigned* bar = b.bar;
        __builtin_amdgcn_s_waitcnt(0);
        unsigned nloc = b.st[0], nx = b.st[1];
        if (nloc == 0u) { xcd_barrier_complete(bar, b.x, nloc, nx); b.st[0] = nloc; b.st[1] = nx; }
        const unsigned old = xb_add(&bar[XB_XSUB(b.x)], 1u);
        const unsigned gen = old / nloc;
        if (old + 1u == (gen + 1u) * nloc) {
            __builtin_amdgcn_fence(__ATOMIC_RELEASE, "agent");
            asm volatile("s_waitcnt vmcnt(0)" ::: "memory");
            const unsigned og = xb_add(&bar[XB_TOP], 1u);
            const unsigned tg = og / nx;
            if (og + 1u == (tg + 1u) * nx) xb_add(&bar[XB_TOPGEN], 1u);
            else XB_SPIN(xb_ld(&bar[XB_TOPGEN]) == tg, bar);
            __builtin_amdgcn_fence(__ATOMIC_ACQUIRE, "agent");
            xb_add(&bar[XB_XGEN(b.x)], 1u);
            asm volatile("s_waitcnt vmcnt(0)" ::: "memory");
        } else {
            XB_SPIN(xb_ld(&bar[XB_XGEN(b.x)]) == gen, bar);
            __builtin_amdgcn_fence(__ATOMIC_ACQUIRE, "agent");
            asm volatile("s_waitcnt vmcnt(0)" ::: "memory");
        }
    }
    __syncthreads();
}

constexpr int LDS_MAIN = 136 * 1024;
constexpr int LDS_BYTES = LDS_MAIN + 16;
constexpr int PH_PER_LAYER = 15, N_PHASES = 2 + 2 * PH_PER_LAYER;

__global__ void __launch_bounds__(NT, 2) hybrid_fwd(Args A0) {
    extern __shared__ __attribute__((aligned(16))) unsigned char lds_raw[];
    char* lds = (char*)lds_raw;
    const int tid = threadIdx.x;
    if (tid < 4) ((volatile LAS unsigned*)(LAS unsigned char*)(lds_raw + LDS_MAIN))[tid] = 0u;
    __syncthreads();
    const bool multi = (A0.ph_hi - A0.ph_lo) > 1;
    XcdBarrier bar; bar.bar = (unsigned*)(A0.ws + WS_CTL); bar.x = 0; bar.st = nullptr;
    if (multi) bar = xcd_barrier_post((unsigned*)(A0.ws + WS_CTL), (volatile LAS unsigned*)(LAS unsigned char*)(lds_raw + LDS_MAIN));
    const int lo = A0.ph_lo, hi = A0.ph_hi;
#ifndef PROBE_PHASE
#define PROBE_PHASE -1
#endif
#ifndef PROBE_B
#define PROBE_B -1
#endif
#ifndef PROBE_C
#define PROBE_C -1
#endif
#ifndef PROBE_D
#define PROBE_D -1
#endif
#define REPEAT(j) _Pragma("unroll 1") for (int _rep = 0; _rep < ((PROBE_PHASE == (j) || PROBE_B == (j) || PROBE_C == (j) || PROBE_D == (j)) ? 2 : 1); ++_rep)
#define LA Args A = A0; asm volatile("" : "+s"(A.ws))
#ifdef DIAG_PHASE
#define DIAGOK(k) ((k) < 2 ? (k) == DIAG_PHASE : (((k) - 2) % PH_PER_LAYER) + 2 == DIAG_PHASE)
#else
#define DIAGOK(k) true
#endif
#define IN(k) (DIAGOK(k) && lo <= (k) && (k) < hi)
#define INR(k) (lo <= (k) && (k) < hi)
#define SEAM(k) do { if (INR(k) && INR((k) + 1)) xcd_barrier(bar); } while (0)
    const int G = gridDim.x, bx = blockIdx.x;
    LAS unsigned char* ldsl = (LAS unsigned char*)lds_raw;

    if (IN(0)) { LA; REPEAT(200) { conv_small_weights(A, 0, lds); conv_small_weights(A, 1, lds); __syncthreads(); } REPEAT(201) compute_mod(A, lds); REPEAT(202) compute_hid2(A, lds); }
    SEAM(0);
    if (IN(1)) { LA; REPEAT(203) rows_to_u_layer0(A); }
    SEAM(1);

#pragma unroll 1
    for (int l = 0; l < DEPTH; ++l) {
        const int pb = 2 + l * PH_PER_LAYER; const bool first = (l == 0);
        const int Mtok = first ? ROWS : RL;
        if (IN(pb + 0)) { LA;
            pg8::Gemm g{WSP(bf16_t, WS_U), WSP(bf16_t, WS_WIN) + (size_t)l * NPREP * D, ROWS, NPREP, D, D, D, -1, 0, 0};
            pg8::StaticOrder S; S.init(g, G, bx);
            epi::Win E{WSP(bf16_t, WS_ZD), WSP(bf16_t, WS_ZH), WSP(bf16_t, WS_ZC), WSP(bf16_t, WS_ZM)};
            REPEAT(0) pg8::gemm_phase(ldsl, g, S, E);
        }
        SEAM(pb + 0);
        if (IN(pb + 1)) { LA;
            post_rows(A);
            REPEAT(10) conformer_tiles(A, l, lds, Mtok);
            REPEAT(11) hyena_pre_tiles(A, l, lds, Mtok);
            REPEAT(12) hyena_filters(A, l, lds, first);
        }
        SEAM(pb + 1);
        if (IN(pb + 2)) { LA;
            pg8::Gemm g{WSP(bf16_t, WS_ZM), WSP(bf16_t, WS_WMLA) + (size_t)l * 1024 * 384, ROWS, 1024, 384, 512, 384, -1, 0, 0};
            pg8::StaticOrder S; S.init(g, G, bx);
            epi::Mla E{WSP(bf16_t, WS_QM)};
            REPEAT(2) pg8::gemm_phase(ldsl, g, S, E);
        }
        SEAM(pb + 2);
        if (IN(pb + 3)) { LA; mla_q_rope(A); }
        SEAM(pb + 3);
        if (IN(pb + 4)) { LA;
            att::Tensors T{(const char*)A.ws, WSP(bf16_t, WS_ZD), WSP(bf16_t, WS_QM), WSP(bf16_t, WS_KR), WSP(bf16_t, WS_Y), A.in[I_SUBLN] + l * 128, WSP(float, WS_LAM)[l], first ? 0.8f : 0.64449093f};
            constexpr int N_DL = 1024, N_ML = 512, N_HL = 256, N_DC = 16, N_MC = 8, N_HC = 256;
#if !defined(DIAG_SUB) || DIAG_SUB == 0
            REPEAT(40) for (int r = bx; r < N_DL; r += G) att::attn_unit<true>(T, r >> 9, (r >> 7) & 3, (r & 127) * 128, false, lds);
#endif
#if !defined(DIAG_SUB) || DIAG_SUB == 1
            REPEAT(41) for (int r = bx; r < N_ML; r += G) att::attn_unit<false>(T, r >> 8, (r >> 6) & 3, (r & 63) * 256, false, lds);
#endif
#if defined(PROBE_HALF) && PROBE_HALF == 1
            for (int r = bx; r < N_ML; r += G) att::attn_unit<false, PROBE_SH>(T, r >> 8, (r >> 6) & 3, (r & 63) * 256, false, lds);
#endif
#if defined(PROBE_HALF) && PROBE_HALF == 2
            for (int r = bx; r < N_DL; r += G) att::attn_unit<true, PROBE_SH>(T, r >> 9, (r >> 7) & 3, (r & 127) * 128, false, lds);
#endif
#if !defined(DIAG_SUB) || DIAG_SUB == 2
            REPEAT(42) for (int r = bx; r < N_HL; r += G) hyena_item(A, l, r, lds, A.ws + WS_ZM + (size_t)bx * SCR_PER_BLOCK);
#endif
#if !defined(DIAG_SUB) || DIAG_SUB == 3
            if (first) {
                for (int r = bx; r < N_DC; r += G) att::attn_unit<true>(T, r >> 3, (r >> 1) & 3, (r & 1) * 128, true, lds);
                for (int r = G >= 32 ? bx - 16 : bx; r >= 0 && r < N_MC; r += G) att::attn_unit<false>(T, r >> 2, r & 3, 0, true, lds);
                for (int r = bx; r < N_HC; r += G) hyena_ctx_item(A, l, r, lds);
            }
#endif
        }
        SEAM(pb + 4);
        if (IN(pb + 5)) { LA; REPEAT(5) hyena_post_tiles(A, lds, Mtok); }
        SEAM(pb + 5);
#if defined(SENS) && SENS == 3
        if (multi) { for (int q = 0; q < 10; ++q) xcd_barrier(bar); }
#endif
        if (IN(pb + 6)) { LA;
            pg8::Gemm g{WSP(bf16_t, WS_Y), WSP(bf16_t, WS_WB) + (size_t)l * 4 * 1024 * 512, Mtok, 4096, 512, 1280, 512, -1, 0, 0};
            pg8::BranchOrder S; S.init(g, G, bx);
            epi::PBranch E{WSP(bf16_t, WS_P)};
            REPEAT(6) pg8::gemm_phase(ldsl, g, S, E);
        }
        SEAM(pb + 6);
        if (IN(pb + 7)) { LA;
            pg8::Gemm g{WSP(bf16_t, WS_U), WSP(bf16_t, WS_WG) + (size_t)l * 4096 * D, Mtok, 4096, D, D, D, -1, 0, 0};
            pg8::StaticOrder S; S.init(g, G, bx);
            epi::Gate E{WSP(bf16_t, WS_P), WSP(bf16_t, WS_ACC)};
            REPEAT(7) pg8::gemm_phase(ldsl, g, S, E);
        }
        SEAM(pb + 7);
        if (IN(pb + 8)) { LA;
            pg8::Gemm g{WSP(bf16_t, WS_ACC), WSP(bf16_t, WS_WO) + (size_t)l * D * D, Mtok, D, D, D, D, -1, 0, 0};
            pg8::StaticOrder S; S.init(g, G, bx);
            epi::Out E{first ? A.in[I_X] : A.out, A.out, A.in[I_CTX], WSP(float, WS_HCTX), WSP(float, WS_MOD) + (size_t)l * 3 * 6144 + 2 * 1024};
            pg8::gemm_phase(ldsl, g, S, E);
        }
        SEAM(pb + 8);
        if (IN(pb + 9)) { LA; REPEAT(90) { router_rows(A, l, lds, Mtok); __syncthreads(); } }
        SEAM(pb + 9);
        if (IN(pb + 10)) { LA; REPEAT(100) topk_select(A, lds, first); __syncthreads(); conv_expert_weights(A, l, lds, G >= 128 ? (first ? 64 : 32) : 0); }
        SEAM(pb + 10);
        if (IN(pb + 12)) { LA;
            pg8::Gemm g{WSP(bf16_t, WS_U), WSP(bf16_t, WS_WEIN), first ? XROWS : NE * 4096, 2048, D, D, D, 4, 256, (size_t)2048 * D};
            pg8::StaticOrder S; S.init(g, G, bx);
            epi::Ex1 E{WSP(bf16_t, WS_HID)};
            REPEAT(120) pg8::gemm_phase<epi::Ex1, pg8::StaticOrder, true>(ldsl, g, S, E, WSP(int, WS_IDX));
        }
        SEAM(pb + 12);
        if (IN(pb + 13)) { LA;
            pg8::Gemm g{WSP(bf16_t, WS_HID), WSP(bf16_t, WS_WEOUT), first ? XROWS : NE * 4096, D, EH, EH, EH, 4, 256, (size_t)D * EH};
            pg8::StaticOrder S; S.init(g, G, bx);
            epi::Ex2 E{WSP(bf16_t, WS_XE), WSP(float, WS_GROW)};
            REPEAT(130) pg8::gemm_phase(ldsl, g, S, E);
        }
        SEAM(pb + 13);
        if (IN(pb + 14)) { LA; moe_combine(A, l); }
        if (l + 1 < DEPTH) SEAM(pb + 14);
    }
#undef LA
#undef REPEAT
#undef IN
#undef INR
#undef SEAM
}

#ifndef MK_ONE_LAUNCH
#define MK_ONE_LAUNCH 0
#endif
#ifndef MAX_PHASE
#define MAX_PHASE N_PHASES
#endif
extern "C" void kernel_launch(void* const* d_in, const int* in_sizes, int n_in, void* d_out, int out_size, void* d_ws, size_t ws_size, hipStream_t stream) {
    static int grid = 0;
    if (grid == 0) {
        if (n_in != N_INPUTS || out_size != RL * D || ws_size < WS_END) { fprintf(stderr, "kernel_launch: unexpected shapes (n_in %d out %d ws %zu need %zu)\n", n_in, out_size, ws_size, (size_t)WS_END); grid = -1; return; }
        int dev = 0, cus = 0, per_cu = 0;
        if (hipGetDevice(&dev) != hipSuccess || hipDeviceGetAttribute(&cus, hipDeviceAttributeMultiprocessorCount, dev) != hipSuccess) { grid = -1; return; }
        if (hipFuncSetAttribute((const void*)hybrid_fwd, hipFuncAttributeMaxDynamicSharedMemorySize, LDS_BYTES) != hipSuccess) { fprintf(stderr, "kernel_launch: hipFuncSetAttribute failed\n"); grid = -1; return; }
        if (hipOccupancyMaxActiveBlocksPerMultiprocessor(&per_cu, (const void*)hybrid_fwd, NT, LDS_BYTES) != hipSuccess || per_cu < 1) fprintf(stderr, "kernel_launch: occupancy query says %d\n", per_cu);
        (void)hipGetLastError();
        grid = cus > 256 ? 256 : cus;
    }
    if (grid < 0) return;
    (void)hipMemsetAsync((char*)d_ws + WS_CTL, 0, CTL_BYTES, stream);
    Args a{};
    for (int i = 0; i < N_INPUTS; ++i) a.in[i] = (const float*)d_in[i];
    a.out = (float*)d_out; a.ws = (unsigned char*)d_ws;
#if MK_ONE_LAUNCH
    a.ph_lo = 0; a.ph_hi = N_PHASES;
    hipLaunchKernelGGL(hybrid_fwd, dim3(grid), dim3(NT), LDS_BYTES, stream, a);
#else
    for (int k = 0; k < MAX_PHASE; ++k) { a.ph_lo = k; a.ph_hi = k + 1; hipLaunchKernelGGL(hybrid_fwd, dim3(grid), dim3(NT), LDS_BYTES, stream, a); }
#endif
}
```

```cpp
#define MK_ONE_LAUNCH 1
#include <hip/hip_runtime.h>
#include <cstdio>
#include <cstdint>
#include <cstddef>

#define LAS __attribute__((address_space(3)))
typedef unsigned short bf16_t;
typedef short bf16x8 __attribute__((ext_vector_type(8)));
typedef short s16x4 __attribute__((ext_vector_type(4)));
typedef float f32x4 __attribute__((ext_vector_type(4)));
typedef float f32x2 __attribute__((ext_vector_type(2)));
typedef float f32x16 __attribute__((ext_vector_type(16)));
typedef unsigned u32x4 __attribute__((ext_vector_type(4)));
typedef unsigned u32x2 __attribute__((ext_vector_type(2)));

constexpr int D = 1024, NB = 2, SEQ = 16384, NCTX = 256, KVLEN = SEQ + NCTX, DEPTH = 2, GRIDW = 64;
constexpr int RL = NB * SEQ, RC = NB * NCTX, ROWS = RL + RC;
constexpr int NIN = 7328, NPRE = 3232, NPREP = 3328;
constexpr int NE = 16, CAPL = 2048, CAPC = 32, EH = 1024;
constexpr int XROWS = NE * 4096 + NE * 256;
constexpr float EPS = 1e-6f;
constexpr int NT = 512;

enum { I_X = 0, I_C, I_CTX, I_CCTX, I_ADAW, I_ADAB, I_GMIX, I_GFFN, I_WIN, I_DLAM, I_SUBLN, I_HSW, I_HSB, I_FW1, I_FB1, I_FFREQ, I_FW2, I_FB2, I_FW3, I_HSKIP,
       I_CDW, I_CLNG, I_CLNB, I_MQG, I_MKVG, I_WUQ, I_WUKV, I_WBR, I_WOUT, I_WROUTER, I_WEIN, I_WEOUT, I_FNORM, N_INPUTS };

constexpr size_t al256(size_t x) { return (x + 255) / 256 * 256; }
constexpr size_t WS_CTL = 0;
constexpr size_t CTL_BYTES = 65536;
constexpr size_t WS_MOD = WS_CTL + CTL_BYTES;
constexpr size_t WS_LAM = WS_MOD + al256((size_t)2 * 3 * 6144 * 4);
constexpr size_t WS_HID2 = WS_LAM + 256;
constexpr size_t WS_HID2C = WS_HID2 + (size_t)2 * SEQ * 64 * 4;
constexpr size_t WS_RS = WS_HID2C + (size_t)2 * NCTX * 64 * 4;
constexpr size_t WS_AFFT = WS_RS + al256((size_t)2 * ROWS * 4);
constexpr size_t WS_IDX = WS_AFFT + (size_t)(2 * 16 * SEQ + 2 * 16 * NCTX) * 4;
constexpr size_t WS_GATEV = WS_IDX + (size_t)(2 * 16 * CAPL + 2 * 16 * CAPC) * 4;
constexpr size_t WS_INV = WS_GATEV + (size_t)(2 * 16 * CAPL + 2 * 16 * CAPC) * 4;
constexpr size_t WS_HCTX = WS_INV + (size_t)ROWS * 16 * 4;
constexpr size_t WS_HC = WS_HCTX + (size_t)RC * D * 4;
constexpr size_t WS_GROW = WS_HC + (size_t)1024 * NCTX * 4;
constexpr size_t WS_WIN = WS_GROW + al256((size_t)XROWS * 4);
constexpr size_t WS_WG = WS_WIN + (size_t)2 * NPREP * D * 2;
constexpr size_t WS_WB = WS_WG + (size_t)2 * 4096 * D * 2;
constexpr size_t WS_WO = WS_WB + (size_t)2 * 4 * 1024 * 512 * 2;
constexpr size_t WS_WMLA = WS_WO + (size_t)2 * D * D * 2;
constexpr size_t WS_WEIN = WS_WMLA + (size_t)2 * 1024 * 384 * 2;
constexpr size_t WS_WEOUT = WS_WEIN + (size_t)NE * 2048 * D * 2;
constexpr size_t WS_U = WS_WEOUT + (size_t)NE * D * EH * 2;
constexpr size_t WS_Y = WS_U + (size_t)ROWS * D * 2;
constexpr size_t WS_HB = WS_Y + (size_t)ROWS * 1280 * 2;
constexpr size_t WS_R1 = WS_HB + (size_t)ROWS * D * 2;
constexpr size_t WS_ZD = WS_R1;
constexpr size_t WS_ZH = WS_ZD + (size_t)ROWS * 1536 * 2;
constexpr size_t WS_ZC = WS_ZH + (size_t)ROWS * 768 * 2;
constexpr size_t WS_ZM = WS_ZC + (size_t)ROWS * 512 * 2;
constexpr size_t WS_SCRX = WS_ZM + (size_t)ROWS * 512 * 2;
constexpr size_t SCR_PER_BLOCK = 196608;
constexpr size_t WS_HYT = WS_ZM + (size_t)256 * SCR_PER_BLOCK;
constexpr size_t WS_HF = WS_HYT + (size_t)(2 * 768 * SEQ + 2 * 768 * NCTX) * 2;
constexpr size_t WS_KR = WS_HF + (size_t)1024 * SEQ * 2;
constexpr size_t WS_R1END_MIX = WS_KR + (size_t)ROWS * 32 * 2;
constexpr size_t WS_QM = WS_ZH;
constexpr size_t WS_HYO = WS_QM + (size_t)ROWS * 1024 * 2;
static_assert(WS_HYO + (size_t)(2 * 256 * SEQ + 2 * 256 * NCTX) * 2 <= WS_ZM, "QM/KVM/HYO must fit in ZH+ZC");
static_assert(WS_ZM + (size_t)256 * SCR_PER_BLOCK >= WS_SCRX, "scratch covers ZM");
constexpr size_t WS_P = WS_R1;
constexpr size_t WS_ACC = WS_Y;
constexpr size_t WS_XE = WS_R1;
constexpr size_t WS_HID = WS_XE + (size_t)XROWS * D * 2;
constexpr size_t WS_R1END_MOE = WS_HID + (size_t)XROWS * EH * 2;
constexpr size_t WS_R1END_P = WS_P + (size_t)ROWS * 4096 * 2;
constexpr size_t cmax(size_t a, size_t b) { return a > b ? a : b; }
constexpr size_t WS_END = cmax(WS_R1END_MIX, cmax(WS_R1END_MOE, WS_R1END_P));
static_assert(WS_END <= (size_t)760 * 1000 * 1000, "workspace budget");

__device__ __forceinline__ unsigned cvt_pk_bf16(float lo, float hi) { unsigned r; asm("v_cvt_pk_bf16_f32 %0, %1, %2" : "=v"(r) : "v"(lo), "v"(hi)); return r; }
__device__ __forceinline__ float bf2f(bf16_t b) { return __uint_as_float(((unsigned)b) << 16); }
__device__ __forceinline__ float bflo(unsigned w) { return __uint_as_float(w << 16); }
__device__ __forceinline__ float bfhi(unsigned w) { return __uint_as_float(w & 0xffff0000u); }
__device__ __forceinline__ bf16_t f2bf(float f) { return (bf16_t)(cvt_pk_bf16(f, 0.f) & 0xffffu); }
__device__ __forceinline__ float wave_sum(float v) {
#pragma unroll
    for (int o = 1; o < 64; o <<= 1) v += __shfl_xor(v, o);
    return v;
}
__device__ __forceinline__ float sigmoidf_(float x) { return __builtin_amdgcn_rcpf(1.0f + __expf(-x)); }
__device__ __forceinline__ float siluf_(float x) { return x * sigmoidf_(x); }
__device__ __forceinline__ int row_vec(int row) { return row < SEQ ? 0 : (row < RL ? 1 : 2); }

__device__ __forceinline__ int ltid() { int t = threadIdx.x; asm volatile("" : "+v"(t)); return t; }
struct Args { const float* in[N_INPUTS]; float* out; unsigned char* ws; int ph_lo, ph_hi; };

namespace pg8 {
constexpr int BM = 256, BK = 64, HALF = 128, HTB = HALF * BK * 2, STAGE_BYTES = 8 * HTB, NXCD = 8, WGM = 8;
__host__ __device__ __forceinline__ int lds_byte(int r, int c) { const int st = (r >> 4) * 2 + (c >> 5), rr = r & 15, cc = c & 31, ob = rr * 64 + cc * 2; return st * 1024 + (ob ^ (((ob >> 9) & 1) << 5)); }
__host__ __device__ __forceinline__ void stage_rc(int b, int& R, int& C) { const int st = b / 1024, sb = b % 1024, swz = sb ^ (((sb >> 9) & 1) << 5); R = (st >> 1) * 16 + swz / 64; C = (st & 1) * 32 + (swz % 64) / 2; }
__host__ __device__ __forceinline__ int perm32(int rho) { const int n = rho >> 4, i = rho & 15; return 8 * (i >> 2) + 4 * n + (i & 3); }
struct Unit { int pm, pn, nt, tag; const char* a; const char* b; };
struct Gemm { const bf16_t* A; const bf16_t* Bt; int M, N, K, lda, ldb; int gshift, gsplit; size_t bgs; };
struct StaticOrder {
    int nM, nN, nwg, G, c; Gemm g;
    __device__ void init(const Gemm& g_, int G_, int c_) { g = g_; nM = g.M / BM; nN = g.N / BM; nwg = nM * nN; G = G_; c = c_; }
    __device__ bool map(int i, int& pm, int& pn) const {
        const long L = (long)i * G + c; if (L >= nwg) return false;
        int wgid = (int)L; { const int q = nwg / NXCD, r = nwg % NXCD, xcd = wgid % NXCD, off = wgid / NXCD; wgid = (xcd < r ? xcd * (q + 1) : r * (q + 1) + (xcd - r) * q) + off; }
        const int nig = WGM * nN, gid = wgid / nig, fm = gid * WGM, gsz = (nM - fm) < WGM ? (nM - fm) : WGM;
        pm = fm + ((wgid % nig) % gsz); pn = (wgid % nig) / gsz; return true;
    }
    __device__ bool next(int i, Unit& u) const {
        if (!map(i, u.pm, u.pn)) return false;
        u.nt = g.K / BK; u.tag = 0; u.a = (const char*)g.A + (size_t)u.pm * BM * g.lda * 2;
        u.b = (const char*)g.Bt + (g.gshift >= 0 ? (size_t)(u.pm < g.gsplit ? (u.pm >> g.gshift) : (u.pm - g.gsplit)) * g.bgs * 2 : (size_t)0) + (size_t)u.pn * BM * g.ldb * 2;
        return true;
    }
};
struct BranchOrder : StaticOrder {
    __device__ bool next(int i, Unit& u) const {
        int q; if (!map(i, u.pm, q)) return false;
        const int br = q >> 2; u.pn = q & 3; u.tag = br; u.nt = br == 0 ? 8 : 4;
        const int start = br == 0 ? 0 : 512 + 256 * (br - 1);
        u.a = (const char*)g.A + ((size_t)u.pm * BM * g.lda + start) * 2; u.b = (const char*)g.Bt + ((size_t)br * 1024 * 512 + (size_t)u.pn * BM * 512) * 2;
        return true;
    }
};
template <class Epi, class Sched, bool GATHER = false>
__device__ __forceinline__ void gemm_phase(LAS unsigned char* lds, const Gemm g, const Sched& S, const Epi& E, const int* gidx = nullptr) {
    const int tid = ltid(), wid = __builtin_amdgcn_readfirstlane(tid >> 6), lane = tid & 63, wr = wid >> 2, wc = wid & 3, fr = lane & 15, fq = lane >> 4;
    unsigned voffA[2], voffB[2];
#pragma unroll
    for (int i = 0; i < 2; ++i) { int R, C; stage_rc(tid * 16 + i * 8192, R, C); const int Rb = Epi::PERM ? ((R & ~31) + perm32(R & 31)) : R;
        voffA[i] = (unsigned)(R * g.lda + C) * 2u; voffB[i] = (unsigned)(Rb * g.ldb + C) * 2u; }
    const size_t kstep = (size_t)(BK * 2);
    unsigned gvc[2][2] = {{0u, 0u}, {0u, 0u}}, gvn[2][2] = {{0u, 0u}, {0u, 0u}}; unsigned gR[2] = {0u, 0u}, gC[2] = {0u, 0u};
    const char* gA = (const char*)g.A;
    if constexpr (GATHER) {
#pragma unroll
        for (int i = 0; i < 2; ++i) { int R, C; stage_rc(tid * 16 + i * 8192, R, C); gR[i] = (unsigned)R; gC[i] = (unsigned)C * 2u; }
        LAS unsigned short* li = (LAS unsigned short*)(lds + STAGE_BYTES);
        for (int q = tid; q < 16 * 256; q += 512) { int pm, pn; if (S.map(q >> 8, pm, pn)) li[q] = (unsigned short)gidx[pm * 256 + (q & 255)]; }
        __syncthreads();
    }
#define PG8_GV(dst, u) do { const LAS unsigned short* _li = (const LAS unsigned short*)(lds + STAGE_BYTES) + (u) * 256; _Pragma("unroll") for (int _h = 0; _h < 2; ++_h) _Pragma("unroll") for (int _i = 0; _i < 2; ++_i) \
        dst[_h][_i] = (unsigned)_li[_h * HALF + gR[_i]] * (unsigned)(g.lda * 2) + gC[_i]; } while (0)
#define PG8_STAGE_G(bufoff, gbase, v0, v1) do { __builtin_amdgcn_global_load_lds((const unsigned*)((gbase) + (v0)), (LAS unsigned*)(lds + (bufoff) + ldsw), 16, 0, 0); \
        __builtin_amdgcn_global_load_lds((const unsigned*)((gbase) + (v1)), (LAS unsigned*)(lds + (bufoff) + ldsw + 8192), 16, 0, 0); } while (0)
    const size_t hstepA = (size_t)HALF * g.lda * 2, hstepB = (size_t)HALF * g.ldb * 2;
    const unsigned ldsw = (unsigned)wid * 1024u;
    const int aoff = lds_byte(wr * 64 + fr, fq * 8), boff = lds_byte(wc * 32 + fr, fq * 8);
#define PG8_SA(b, h) (((b) * 2 + (h)) * HTB)
#define PG8_SB(b, h) ((4 + (b) * 2 + (h)) * HTB)
#define PG8_STAGE(bufoff, gbase, voff) do { _Pragma("unroll") for (int _i = 0; _i < 2; ++_i) \
        __builtin_amdgcn_global_load_lds((const unsigned*)((const char*)(gbase) + (voff)[_i]), (LAS unsigned*)(lds + (bufoff) + ldsw + _i * 8192), 16, 0, 0); } while (0)
#define PG8_LDA(dst, b, h) do { _Pragma("unroll") for (int m = 0; m < 4; ++m) _Pragma("unroll") for (int k = 0; k < 2; ++k) dst[m][k] = *(const LAS bf16x8*)(lds + PG8_SA(b, h) + aoff + m * 2048 + k * 1024); } while (0)
#define PG8_LDB(dst, b, h) do { _Pragma("unroll") for (int n = 0; n < 2; ++n) _Pragma("unroll") for (int k = 0; k < 2; ++k) dst[n][k] = *(const LAS bf16x8*)(lds + PG8_SB(b, h) + boff + n * 2048 + k * 1024); } while (0)
#define PG8_MMA(ai, bj, At, Bt) do { __builtin_amdgcn_s_setprio(1); _Pragma("unroll") for (int m = 0; m < 4; ++m) _Pragma("unroll") for (int n = 0; n < 2; ++n) _Pragma("unroll") for (int k = 0; k < 2; ++k) \
        acc[ai][bj][m][n] = __builtin_amdgcn_mfma_f32_16x16x32_bf16(Bt[n][k], At[m][k], acc[ai][bj][m][n], 0, 0, 0); __builtin_amdgcn_s_setprio(0); } while (0)
#define PG8_WAIT_V(n) asm volatile("s_waitcnt vmcnt(" #n ")" ::: "memory")
#define PG8_WAIT_L(n) asm volatile("s_waitcnt lgkmcnt(" #n ")" ::: "memory")
#define PG8_BAR __builtin_amdgcn_s_barrier()
#define PG8_SCHED __builtin_amdgcn_sched_barrier(0)
    Unit cur, nxt; int ui = 0;
    if (!S.next(0, cur)) return;
    f32x4 acc[2][2][4][2];
#pragma unroll
    for (int a = 0; a < 2; ++a)
#pragma unroll
        for (int b = 0; b < 2; ++b)
#pragma unroll
            for (int m = 0; m < 4; ++m)
#pragma unroll
                for (int n = 0; n < 2; ++n) acc[a][b][m][n] = (f32x4){0.f, 0.f, 0.f, 0.f};
    bf16x8 At[4][2], B0[2][2], B1[2][2];
    const char* cA = cur.a; const char* cB = cur.b;
    if constexpr (GATHER) { PG8_GV(gvc, 0);
        PG8_STAGE(PG8_SB(0, 0), cB, voffB); PG8_STAGE_G(PG8_SA(0, 0), gA, gvc[0][0], gvc[0][1]); PG8_STAGE(PG8_SB(0, 1), cB + hstepB, voffB); PG8_STAGE_G(PG8_SA(0, 1), gA, gvc[1][0], gvc[1][1]); }
    else {
    PG8_STAGE(PG8_SB(0, 0), cB, voffB); PG8_STAGE(PG8_SA(0, 0), cA, voffA); PG8_STAGE(PG8_SB(0, 1), cB + hstepB, voffB); PG8_STAGE(PG8_SA(0, 1), cA + hstepA, voffA); }
    if (wr == 1) PG8_BAR;
    PG8_WAIT_V(4); PG8_BAR;
    PG8_STAGE(PG8_SB(1, 0), cB + kstep, voffB); if constexpr (GATHER) PG8_STAGE_G(PG8_SA(1, 0), gA + kstep, gvc[0][0], gvc[0][1]); else PG8_STAGE(PG8_SA(1, 0), cA + kstep, voffA); PG8_STAGE(PG8_SB(1, 1), cB + hstepB + kstep, voffB);
    PG8_WAIT_V(6); PG8_BAR;
    for (;;) {
        const bool has_next = S.next(ui + 1, nxt);
        const char* nA = has_next ? nxt.a : cA; const char* nB = has_next ? nxt.b : cB;
        if constexpr (GATHER) { if (has_next) PG8_GV(gvn, ui + 1); }
        const int nt = cur.nt;
        for (int t = 0; t < nt; t += 2) {
            const bool last = (t == nt - 2);
            const char* a1 = cA + (size_t)(t + 1) * kstep;
            const char* a2 = last ? nA : cA + (size_t)(t + 2) * kstep; const char* b2 = last ? nB : cB + (size_t)(t + 2) * kstep;
            const char* a3 = a2 + kstep; const char* b3 = b2 + kstep;
            const char* ga1 = gA + (size_t)(t + 1) * kstep; const char* ga2 = last ? gA : gA + (size_t)(t + 2) * kstep;
            const unsigned g00 = last ? gvn[0][0] : gvc[0][0], g01 = last ? gvn[0][1] : gvc[0][1], g10 = last ? gvn[1][0] : gvc[1][0], g11 = last ? gvn[1][1] : gvc[1][1];
            PG8_LDB(B0, 0, 0); PG8_SCHED; PG8_LDA(At, 0, 0); if constexpr (GATHER) PG8_STAGE_G(PG8_SA(1, 1), ga1, gvc[1][0], gvc[1][1]); else PG8_STAGE(PG8_SA(1, 1), a1 + hstepA, voffA);
            PG8_WAIT_L(8); PG8_BAR; PG8_WAIT_L(0); PG8_MMA(0, 0, At, B0); PG8_BAR; PG8_SCHED;
            PG8_LDB(B1, 0, 1); PG8_STAGE(PG8_SB(0, 0), b2, voffB);
            PG8_BAR; PG8_WAIT_L(0); PG8_MMA(0, 1, At, B1); PG8_BAR;
            PG8_LDA(At, 0, 1); if constexpr (GATHER) PG8_STAGE_G(PG8_SA(0, 0), ga2, g00, g01); else PG8_STAGE(PG8_SA(0, 0), a2, voffA);
            PG8_BAR; PG8_WAIT_L(0); PG8_MMA(1, 0, At, B0); PG8_BAR; PG8_SCHED;
            PG8_STAGE(PG8_SB(0, 1), b2 + hstepB, voffB);
            PG8_WAIT_V(6); PG8_BAR; PG8_MMA(1, 1, At, B1); PG8_BAR;
            PG8_LDB(B0, 1, 0); PG8_SCHED; PG8_LDA(At, 1, 0); if constexpr (GATHER) PG8_STAGE_G(PG8_SA(0, 1), ga2, g10, g11); else PG8_STAGE(PG8_SA(0, 1), a2 + hstepA, voffA);
            PG8_WAIT_L(8); PG8_BAR; PG8_WAIT_L(0); PG8_MMA(0, 0, At, B0); PG8_BAR; PG8_SCHED;
            PG8_LDB(B1, 1, 1); PG8_STAGE(PG8_SB(1, 0), b3, voffB);
            PG8_BAR; PG8_WAIT_L(0); PG8_MMA(0, 1, At, B1); PG8_BAR;
            PG8_LDA(At, 1, 1); if constexpr (GATHER) PG8_STAGE_G(PG8_SA(1, 0), ga2 + kstep, g00, g01); else PG8_STAGE(PG8_SA(1, 0), a3, voffA);
            PG8_BAR; PG8_WAIT_L(0); PG8_MMA(1, 0, At, B0); PG8_BAR; PG8_SCHED;
            PG8_STAGE(PG8_SB(1, 1), b3 + hstepB, voffB);
            PG8_WAIT_V(6); PG8_BAR; PG8_MMA(1, 1, At, B1); PG8_BAR;
        }
        { int frl = fr, fql = fq; asm volatile("" : "+v"(frl), "+v"(fql)); E(acc, cur, wr, wc, frl, fql); }
        if (!has_next) break;
#pragma unroll
        for (int a = 0; a < 2; ++a)
#pragma unroll
            for (int b = 0; b < 2; ++b)
#pragma unroll
                for (int m = 0; m < 4; ++m)
#pragma unroll
                    for (int n = 0; n < 2; ++n) acc[a][b][m][n] = (f32x4){0.f, 0.f, 0.f, 0.f};
        cur = nxt; cA = nA; cB = nB; ++ui;
        if constexpr (GATHER) { gvc[0][0] = gvn[0][0]; gvc[0][1] = gvn[0][1]; gvc[1][0] = gvn[1][0]; gvc[1][1] = gvn[1][1]; }
    }
    PG8_WAIT_V(0);
    if (wr == 0) PG8_BAR;
    PG8_BAR;
#undef PG8_SA
#undef PG8_SB
#undef PG8_STAGE
#undef PG8_STAGE_G
#undef PG8_GV
#undef PG8_LDA
#undef PG8_LDB
#undef PG8_MMA
#undef PG8_WAIT_V
#undef PG8_WAIT_L
#undef PG8_BAR
#undef PG8_SCHED
}
}

namespace att {
constexpr int KVBLK = 64;
constexpr int SHM_K = KVBLK * 256, SHM_V = KVBLK * 256;
constexpr int SHM_ATTN = 4 * SHM_K + 4 * SHM_V + 8 * 64 * 4;
#define KSWZ(row, colB) ((row) * 256 + ((colB) ^ (((row) & 7) << 4)))
#define SBAR() __builtin_amdgcn_sched_barrier(0)
__device__ __forceinline__ int crow(int r, int hi) { return (r & 3) + 8 * (r >> 2) + 4 * hi; }

template <int NQB>
__device__ __forceinline__ void k_load(bf16x8 (&k0)[NQB], bf16x8 (&k1)[NQB], const char* Ks, int r32, int hi, int koff) {
#pragma unroll
    for (int d0 = 0; d0 < NQB; ++d0) { const int cb = (koff + d0 * 16 + hi * 8) * 2;
        k0[d0] = *reinterpret_cast<const bf16x8*>(Ks + KSWZ(r32, cb)); k1[d0] = *reinterpret_cast<const bf16x8*>(Ks + KSWZ(32 + r32, cb)); }
}
__device__ __forceinline__ bf16x8 mk8(unsigned a, unsigned b, unsigned c, unsigned d) { u32x4 w = {a, b, c, d}; return *reinterpret_cast<bf16x8*>(&w); }
template <int NCB> __device__ __forceinline__ int v_st(int k, int c) { const int kk = (k & ~0xC) | ((k & 4) << 1) | ((k & 8) >> 1); return ((kk >> 3) * NCB + (c >> 5)) * 512 + ((kk & 7) * 32 + (c & 31)) * 2; }
__device__ __forceinline__ int v_rd_base(int lane) { return ((lane & 3) << 3) | (((lane >> 2) & 3) << 6) | (((lane >> 4) & 1) << 5) | (((lane >> 5) & 1) << 8); }
template <int NCB> constexpr int v_rd_off(int d0, int ks, int half) { return d0 * 512 + ks * (1024 * NCB) + half * (512 * NCB); }
template <int OFF> __device__ __forceinline__ s16x4 tr_read(int vb) {
    s16x4 r; asm volatile("ds_read_b64_tr_b16 %0, %1 offset:%2" : "=&v"(r) : "v"(vb), "i"(OFF) : "memory"); return r;
}
template <int NCB, int D0> __device__ __forceinline__ void tr8(int vb, s16x4 (&f)[8]) {
    f[0] = tr_read<v_rd_off<NCB>(D0, 0, 0)>(vb); f[1] = tr_read<v_rd_off<NCB>(D0, 0, 1)>(vb); f[2] = tr_read<v_rd_off<NCB>(D0, 1, 0)>(vb); f[3] = tr_read<v_rd_off<NCB>(D0, 1, 1)>(vb);
    f[4] = tr_read<v_rd_off<NCB>(D0, 2, 0)>(vb); f[5] = tr_read<v_rd_off<NCB>(D0, 2, 1)>(vb); f[6] = tr_read<v_rd_off<NCB>(D0, 3, 0)>(vb); f[7] = tr_read<v_rd_off<NCB>(D0, 3, 1)>(vb);
}
#define PK(L, H) (bf16x8){L[0], L[1], L[2], L[3], H[0], H[1], H[2], H[3]}
template <int NQB, int NCB, bool RELOAD, int SH>
__device__ __forceinline__ void seg_qk(f32x16& n0, f32x16& n1, f32x16& c0, f32x16& c1, float& l_reg, bf16x8& pa0, bf16x8& pa1, bf16x8& pa2, bf16x8& pa3,
                                       bf16x8 (&k0)[NQB], bf16x8 (&k1)[NQB], const bf16x8* qr, const char* Kn, int r32, int hi, int koff, int vbn, s16x4 (&f)[8]) {
    constexpr int NM = 2 * NQB;
    unsigned w0[8], w1[8];
    n0 = f32x16{}; n1 = f32x16{};
#pragma unroll
    for (int i = 0; i < NM; ++i) {
        const int d0 = i >> 1;
        if (i & 1) n1 = __builtin_amdgcn_mfma_f32_32x32x16_bf16(k1[d0], qr[d0], n1, 0, 0, 0);
        else       n0 = __builtin_amdgcn_mfma_f32_32x32x16_bf16(k0[d0], qr[d0], n0, 0, 0, 0);
        if (RELOAD && (i & 1)) { const int cb = (koff + d0 * 16 + hi * 8) * 2;
            k0[d0] = *reinterpret_cast<const bf16x8*>(Kn + KSWZ(r32, cb)); k1[d0] = *reinterpret_cast<const bf16x8*>(Kn + KSWZ(32 + r32, cb)); }
        const int k = (NM == 8) ? i : ((i % 3 == 2) ? -1 : (i / 3) * 2 + (i % 3));
        if (k >= 0) {
            if (SH != 3) { c1[2 * k] = __builtin_amdgcn_exp2f(c1[2 * k]); c1[2 * k + 1] = __builtin_amdgcn_exp2f(c1[2 * k + 1]); }
            w0[k] = cvt_pk_bf16(c0[2 * k], c0[2 * k + 1]);
            if (k > 0) { l_reg += c1[2 * k - 2]; l_reg += c1[2 * k - 1]; asm volatile("" : "+v"(l_reg)); w1[k - 1] = cvt_pk_bf16(c1[2 * k - 2], c1[2 * k - 1]); }
        }
        if (i == NM - 1) { l_reg += c1[14]; l_reg += c1[15]; asm volatile("" : "+v"(l_reg)); w1[7] = cvt_pk_bf16(c1[14], c1[15]); }
        if (i == NM / 2 && SH != 4) tr8<NCB, 0>(vbn, f);
        SBAR();
    }
    pa0 = mk8(w0[0], w0[1], w0[2], w0[3]); pa1 = mk8(w0[4], w0[5], w0[6], w0[7]); pa2 = mk8(w1[0], w1[1], w1[2], w1[3]); pa3 = mk8(w1[4], w1[5], w1[6], w1[7]);
    asm volatile("s_nop 7" : "+v"(pa0), "+v"(pa1), "+v"(pa2), "+v"(pa3));
}
__device__ __forceinline__ void sm2_only(f32x16& c0, f32x16& c1, float& l_reg, bf16x8& pa0, bf16x8& pa1, bf16x8& pa2, bf16x8& pa3) {
    unsigned w0[8], w1[8];
#pragma unroll
    for (int k = 0; k < 8; ++k) { c1[2 * k] = __builtin_amdgcn_exp2f(c1[2 * k]); c1[2 * k + 1] = __builtin_amdgcn_exp2f(c1[2 * k + 1]); }
#pragma unroll
    for (int k = 0; k < 8; ++k) { l_reg += c1[2 * k]; l_reg += c1[2 * k + 1]; w0[k] = cvt_pk_bf16(c0[2 * k], c0[2 * k + 1]); w1[k] = cvt_pk_bf16(c1[2 * k], c1[2 * k + 1]); }
    pa0 = mk8(w0[0], w0[1], w0[2], w0[3]); pa1 = mk8(w0[4], w0[5], w0[6], w0[7]); pa2 = mk8(w1[0], w1[1], w1[2], w1[3]); pa3 = mk8(w1[4], w1[5], w1[6], w1[7]);
    asm volatile("s_nop 7" : "+v"(pa0), "+v"(pa1), "+v"(pa2), "+v"(pa3));
}
template <int NCB, bool SM1, int W0, int SH>
__device__ __forceinline__ void seg_pv(f32x16* o, int vb, bf16x8 pa0, bf16x8 pa1, bf16x8 pa2, bf16x8 pa3, s16x4 (&f)[8], f32x16& n0, float& l_reg) {
    s16x4 g[8];
    if (SH == 4) {
#pragma unroll
        for (int q = 0; q < 8; ++q) g[q] = f[q]; }
    constexpr int STEP = NCB == 4 ? 2 : 1;
#define SEG_PV_FILL(J) do { if (SM1) { constexpr int _j = (J); \
        if (_j % STEP == 0 && SH != 3) { constexpr int _k = _j / STEP; n0[2 * _k] = __builtin_amdgcn_exp2f(n0[2 * _k]); n0[2 * _k + 1] = __builtin_amdgcn_exp2f(n0[2 * _k + 1]); } \
        if (STEP == 2 ? (_j % 2 == 1) : (_j > 0)) { constexpr int _k = STEP == 2 ? _j / 2 : (_j > 0 ? _j - 1 : 0); l_reg += n0[2 * _k]; l_reg += n0[2 * _k + 1]; asm volatile("" : "+v"(l_reg)); } } } while (0)
#define SEG_PV_GROUP(D0, CUR, NXT, HASNEXT, WAITN) do { constexpr int _da = (D0), _db = SH == 2 ? ((D0) + 1) % NCB : (D0); \
        asm volatile("s_waitcnt lgkmcnt(%0)" :: "n"(WAITN) : "memory"); SBAR(); \
        if (SH != 5) o[_da] = __builtin_amdgcn_mfma_f32_32x32x16_bf16(pa0, PK(CUR[0], CUR[1]), o[_da], 0, 0, 0); else asm volatile("" :: "v"(CUR[0]), "v"(CUR[1]), "v"(pa0)); \
        if constexpr (HASNEXT && SH != 4) tr8<NCB, (D0) + 1 < NCB ? (D0) + 1 : 0>(vb, NXT); SEG_PV_FILL(4 * (D0) + 0); SBAR(); \
        if (SH != 5) o[_db] = __builtin_amdgcn_mfma_f32_32x32x16_bf16(pa1, PK(CUR[2], CUR[3]), o[_db], 0, 0, 0); else asm volatile("" :: "v"(CUR[2]), "v"(CUR[3]), "v"(pa1)); SEG_PV_FILL(4 * (D0) + 1); SBAR(); \
        if (SH != 5) o[_da] = __builtin_amdgcn_mfma_f32_32x32x16_bf16(pa2, PK(CUR[4], CUR[5]), o[_da], 0, 0, 0); else asm volatile("" :: "v"(CUR[4]), "v"(CUR[5]), "v"(pa2)); SEG_PV_FILL(4 * (D0) + 2); SBAR(); \
        if (SH != 5) o[_db] = __builtin_amdgcn_mfma_f32_32x32x16_bf16(pa3, PK(CUR[6], CUR[7]), o[_db], 0, 0, 0); else asm volatile("" :: "v"(CUR[6]), "v"(CUR[7]), "v"(pa3)); SEG_PV_FILL(4 * (D0) + 3); SBAR(); } while (0)
    if constexpr (NCB == 4) { SEG_PV_GROUP(0, f, g, true, W0); SEG_PV_GROUP(1, g, f, true, 0); SEG_PV_GROUP(2, f, g, true, 0); SEG_PV_GROUP(3, g, f, false, 0); }
    else { SEG_PV_GROUP(0, f, g, true, W0); SEG_PV_GROUP(1, g, f, false, 0); if (SM1) { l_reg += n0[14]; l_reg += n0[15]; asm volatile("" : "+v"(l_reg)); } }
#undef SEG_PV_GROUP
#undef SEG_PV_FILL
}
#undef PK

struct Tensors { const char* base;   const bf16_t* ZD; const bf16_t* QM;   const bf16_t* KR; bf16_t* Y; const float* subln_g; float lam, one_minus_lam_init; };
template <bool DIFF, int SH = 0>
__device__ __forceinline__ void attn_unit(const Tensors& T, int b, int h, int q0, bool ctxq, char* lds) {
    constexpr int NQB = DIFF ? 4 : 6, NCB = DIFF ? 4 : 2, NLD = DIFF ? 4 : 3;
    const int tid = ltid(), wid = tid >> 6, lane = tid & 63, r32 = lane & 31, hi = lane >> 5;
    float* li_l = (float*)(lds + 4 * SHM_V + 4 * SHM_K) + wid * 64;
    const int map = DIFF ? (wid >> 2) : 0, wq = DIFF ? (wid & 3) : wid;
    const int koff = DIFF ? map * 64 : 0;
    const int NTILES = ctxq ? NCTX / KVBLK : KVLEN / KVBLK;
    const int qrow = (ctxq ? RL + b * NCTX : b * SEQ) + q0 + wq * 32 + r32;
    constexpr bool HALF = SH != 0;
    const bool act = SH != 9 || wid < 4;
    float l_reg = 0; f32x16 o[NCB]; bf16x8 qr[NQB];
#pragma unroll
    for (int d = 0; d < NCB; ++d) o[d] = f32x16{};
    {
        const bf16_t* Qw = DIFF ? T.ZD + (size_t)qrow * 1536 + h * 128 + map * 64 + hi * 8 : T.QM + (size_t)qrow * 1024 + h * 96 + hi * 8;
#pragma unroll
        for (int d0 = 0; d0 < NQB; ++d0) qr[d0] = *reinterpret_cast<const bf16x8*>(Qw + d0 * 16);
    }
    if constexpr (!DIFF) {
        if (!ctxq) { const int tokq = qrow & (SEQ - 1); const float posq = hi == 0 ? (float)(tokq >> 6) : (float)(tokq & 63);
#pragma unroll
            for (int e = 0; e < 8; ++e) { const float x1 = bf2f((bf16_t)qr[4][e]), x2 = bf2f((bf16_t)qr[5][e]);
                const float inv = exp2f(-(float)e * (13.287712379549449f / 8.0f)); const float rev = posq * inv * 0.15915494309189535f;
                const float c = __builtin_amdgcn_cosf(rev), sn = __builtin_amdgcn_sinf(rev);
                qr[4][e] = (short)f2bf(x1 * c - x2 * sn); qr[5][e] = (short)f2bf(x1 * sn + x2 * c); } }
    }
#define KROW(kt) ((int)((ctxq || (kt) < NCTX / KVBLK) ? RL + b * NCTX + (kt) * KVBLK : b * SEQ + (kt) * KVBLK - NCTX))
    const int krow_t = tid >> 4, kc = (tid & 15) ^ (krow_t & 7);
    const int vkk = DIFF ? (tid >> 7) * 8 + ((tid & 31) >> 2) : (tid >> 6) * 8 + ((tid & 31) >> 2);
    const int vkey = vkk;
    const int vcol = (DIFF ? ((tid >> 5) & 3) : ((tid >> 5) & 1)) * 32 + (tid & 3) * 8;
    const char* gb = T.base; unsigned kofs, kstrB, vofs; bool k_ok = true;
    const unsigned zd_o = (unsigned)((const char*)T.ZD - T.base), qm_o = (unsigned)((const char*)T.QM - T.base), kr_o = (unsigned)((const char*)T.KR - T.base);
    constexpr unsigned vstrB = DIFF ? 3072u : 2048u;
    if constexpr (DIFF) { kofs = zd_o + (unsigned)(512 + h * 128 + krow_t * 1536 + kc * 8) * 2u; kstrB = 3072u; vofs = zd_o + (unsigned)(1024 + h * 128 + vkey * 1536 + vcol) * 2u; }
    else { k_ok = kc < 12;
        if (kc < 8) { kofs = qm_o + (unsigned)(384 + h * 128 + krow_t * 1024 + kc * 8) * 2u; kstrB = 2048u; } else { kofs = kr_o + (unsigned)(krow_t * 32 + (kc - 8) * 8) * 2u; kstrB = 64u; }
        vofs = qm_o + (unsigned)(384 + h * 128 + 64 + vkey * 1024 + vcol) * 2u; }
    LAS unsigned char* ldsl = (LAS unsigned char*)lds; const unsigned ldsw = (unsigned)__builtin_amdgcn_readfirstlane(wid) * 1024u;
#define KOFF(bb, ss) (((bb) * 2 + (ss)) * SHM_K)
#define VOFF(bb, ss) (4 * SHM_K + ((bb) * 2 + (ss)) * SHM_V)
#define DMA16(gp, loff) if (SH != 6) __builtin_amdgcn_global_load_lds((const unsigned*)(gp), (LAS unsigned*)(ldsl + (loff) + ldsw), 16, 0, 0)
#define DMA_K(bb, ss, kt) do { const unsigned _kr = (unsigned)KROW(kt); if (k_ok) { const unsigned _o = DIFF ? kofs + _kr * 3072u : kofs + _kr * kstrB; DMA16(gb + _o, KOFF(bb, ss)); DMA16(gb + (_o + 32u * (DIFF ? 3072u : kstrB)), KOFF(bb, ss) + 8192); } } while (0)
#define DMA_V(bb, ss, kt) do { const unsigned _o = vofs + (unsigned)KROW(kt) * vstrB; DMA16(gb + _o, VOFF(bb, ss)); if constexpr (DIFF) DMA16(gb + (_o + 32u * vstrB), VOFF(bb, ss) + 8192); } while (0)
    f32x16 sE0, sE1, sO0, sO1; bf16x8 pa0, pa1, pa2, pa3; bf16x8 kf0[NQB], kf1[NQB]; s16x4 vf[8];
    const int NR = NTILES / 2;
    const int vbase = (int)(uintptr_t)lds + v_rd_base(lane);
#define ROUND(cb, more, t0) do { \
    k_load<NQB>(kf0, kf1, lds + KOFF(cb, 0), r32, hi, koff); \
    if (more) { DMA_K(1 - (cb), 0, (t0) + 2); DMA_K(1 - (cb), 1, (t0) + 3); } \
    DMA_V(cb, 1, (t0) + 1); if (more) DMA_V(1 - (cb), 0, (t0) + 2); \
    SBAR(); if (act) { \
    seg_qk<NQB, NCB, true, SH>(sE0, sE1, sO0, sO1, l_reg, pa0, pa1, pa2, pa3, kf0, kf1, qr, lds + KOFF(cb, 1), r32, hi, koff, vbase + VOFF(1 - (cb), 1), vf); \
    seg_pv<NCB, true, NQB, SH>(o, vbase + VOFF(1 - (cb), 1), pa0, pa1, pa2, pa3, vf, sE0, l_reg); \
    seg_qk<NQB, NCB, false, SH>(sO0, sO1, sE0, sE1, l_reg, pa0, pa1, pa2, pa3, kf0, kf1, qr, lds, r32, hi, koff, vbase + VOFF(cb, 0), vf); \
    seg_pv<NCB, true, 0, SH>(o, vbase + VOFF(cb, 0), pa0, pa1, pa2, pa3, vf, sO0, l_reg); } \
    if (SH == 7) asm volatile("s_waitcnt vmcnt(8)" ::: "memory"); else asm volatile("s_waitcnt vmcnt(0)" ::: "memory"); __syncthreads(); } while (0)
    DMA_K(0, 0, 0); DMA_K(0, 1, 1); DMA_V(0, 0, 0);
    { u32x4 z = {0u, 0u, 0u, 0u}; *reinterpret_cast<u32x4*>(lds + VOFF(1, 1) + tid * 16) = z; *reinterpret_cast<u32x4*>(lds + VOFF(1, 1) + 8192 + tid * 16) = z; }
#pragma unroll
    for (int r = 0; r < 16; ++r) { sO0[r] = 0.f; sO1[r] = -1.0e30f; }
    if (SH == 4) {
#pragma unroll
        for (int q = 0; q < 8; ++q) vf[q] = *reinterpret_cast<const s16x4*>(&qr[q % NQB]); }
    asm volatile("s_waitcnt vmcnt(0)" ::: "memory"); __syncthreads();
    if (wid >= 4) __builtin_amdgcn_s_setprio(1);
    for (int r = 0; r < NR; r += 2) {
        ROUND(0, true, 2 * r);
        { const bool more = r + 2 < NR; ROUND(1, more, 2 * r + 2); }
    }
    __builtin_amdgcn_s_setprio(0);
    sm2_only(sO0, sO1, l_reg, pa0, pa1, pa2, pa3);
    tr8<NCB, 0>(vbase + VOFF(1, 1), vf);
    seg_pv<NCB, false, 0, SH>(o, vbase + VOFF(1, 1), pa0, pa1, pa2, pa3, vf, sO0, l_reg);
#undef ROUND
#undef DMA_K
#undef DMA_V
#undef DMA16
#undef KOFF
#undef VOFF
    asm volatile("s_waitcnt vmcnt(0)" ::: "memory");
    int zz = 0; asm volatile("" : "+v"(zz));
    const int r32e = r32 + zz, hie = hi + zz;
    { auto rr = __builtin_amdgcn_permlane32_swap(__float_as_uint(l_reg), __float_as_uint(l_reg), false, false); l_reg = __uint_as_float(rr[0]) + __uint_as_float(rr[1]); }
    if (hie == 0) li_l[r32e] = l_reg; asm volatile("s_waitcnt lgkmcnt(0)" ::: "memory");
    float rli[16];
#pragma unroll
    for (int r = 0; r < 16; ++r) rli[r] = __builtin_amdgcn_rcpf(li_l[crow(r, hie)]);
    const int orow0 = (ctxq ? RL + b * NCTX : b * SEQ) + q0 + wq * 32;
    if constexpr (HALF) {
        float chk = l_reg;
#pragma unroll
        for (int d0 = 0; d0 < NCB; ++d0)
#pragma unroll
            for (int r = 0; r < 16; ++r) chk += o[d0][r];
        if (chk == 123456.789f) T.Y[(size_t)orow0 * 1280] = f2bf(chk);
        __syncthreads();
    } else if constexpr (!DIFF) {
        bf16_t* Ow = T.Y + (size_t)orow0 * 1280 + 1024 + h * 64;
#pragma unroll
        for (int r = 0; r < 16; ++r) { const int orow = crow(r, hie);
#pragma unroll
            for (int d0 = 0; d0 < NCB; ++d0) Ow[(size_t)orow * 1280 + d0 * 32 + r32e] = f2bf(o[d0][r] * rli[r]); }
        __syncthreads();
    } else {
        __syncthreads();
        float* XB = (float*)lds + wq * (32 * 128);
        if (map == 1) {
#pragma unroll
            for (int r = 0; r < 16; ++r) { const int orow = crow(r, hie); const float s = rli[r] * T.lam;
#pragma unroll
                for (int d0 = 0; d0 < 4; ++d0) XB[orow * 128 + d0 * 32 + r32e] = o[d0][r] * s; }
        }
        __syncthreads();
        if (map == 0) {
            float gcol[4];
#pragma unroll
            for (int d0 = 0; d0 < 4; ++d0) gcol[d0] = T.subln_g[d0 * 32 + r32e + zz] * T.one_minus_lam_init;
            bf16_t* Ow = T.Y + (size_t)orow0 * 1280 + h * 128;
#pragma unroll
            for (int r = 0; r < 16; ++r) { const int orow = crow(r, hie); float a[4]; float ss = 0.f;
#pragma unroll
                for (int d0 = 0; d0 < 4; ++d0) { a[d0] = o[d0][r] * rli[r] - XB[orow * 128 + d0 * 32 + r32e]; ss += a[d0] * a[d0]; }
#pragma unroll
                for (int m = 1; m < 32; m <<= 1) ss += __shfl_xor(ss, m);
                const float rs = __builtin_amdgcn_rsqf(ss * (1.0f / 128.0f) + EPS);
#pragma unroll
                for (int d0 = 0; d0 < 4; ++d0) Ow[(size_t)orow * 1280 + d0 * 32 + r32e] = f2bf(a[d0] * rs * gcol[d0]); }
        }
        __syncthreads();
    }
#undef KROW
}
#undef KSWZ
#undef SBAR
}

#ifndef FFT_HOST
#define FFT_HD __device__ __forceinline__
#define FFT_BUF LAS hcx*
#define FFT_CBUF const LAS hcx*
#define FFT_COS(r) __builtin_amdgcn_cosf(r)
#define FFT_SIN(r) __builtin_amdgcn_sinf(r)
#endif
typedef _Float16 hcx __attribute__((ext_vector_type(2)));
typedef float cpx __attribute__((ext_vector_type(2)));
constexpr int FFT_N = 16384;
constexpr int FFT_BUF_ELEMS = FFT_N + FFT_N / 32;
constexpr int FFT_TA = 15 * 1024, FFT_TB = 15 * 64, FFT_TC = 15 * 4;
constexpr int FFT_TW_ELEMS = FFT_TA + FFT_TB + FFT_TC;
constexpr int FFT_LDS_BYTES = (FFT_BUF_ELEMS + FFT_TW_ELEMS) * 4;
FFT_HD int fpad(int i) { return i + (i >> 5); }
FFT_HD hcx hmk(float re, float im) { hcx r; r.x = (_Float16)re; r.y = (_Float16)im; return r; }
FFT_HD hcx hmul(hcx a, hcx w) { const hcx ax = {a.x, a.x}, ay = {a.y, a.y}, wr = {(_Float16)(-w.y), w.x}; return ax * w + ay * wr; }
FFT_HD hcx hconj(hcx a) { hcx r; r.x = a.x; r.y = (_Float16)(-a.y); return r; }
FFT_HD cpx cmul(cpx a, cpx b) { cpx r; r.x = a.x * b.x - a.y * b.y; r.y = a.x * b.y + a.y * b.x; return r; }
template <bool INV> FFT_HD cpx twid(float r) { cpx w; w.x = FFT_COS(r); const float s = FFT_SIN(r); w.y = INV ? s : -s; return w; }
template <bool INV> FFT_HD void dft4(hcx& a0, hcx& a1, hcx& a2, hcx& a3) {
    const hcx t0 = a0 + a2, t1 = a0 - a2, t2 = a1 + a3, d = a1 - a3;
    hcx t3; if (INV) { t3.x = (_Float16)(-d.y); t3.y = d.x; } else { t3.x = d.y; t3.y = (_Float16)(-d.x); }
    a0 = t0 + t2; a1 = t1 + t3; a2 = t0 - t2; a3 = t1 - t3;
}
template <bool INV> FFT_HD void dft16(hcx (&x)[16]) {
#pragma unroll
    for (int n1 = 0; n1 < 4; ++n1) dft4<INV>(x[n1], x[n1 + 4], x[n1 + 8], x[n1 + 12]);
    const float C1 = 0.92387953251128674f, S1 = 0.38268343236508977f, C2 = 0.70710678118654752f;
#define FFT_TW(idx, cr, ci) do { const hcx w = hmk((cr), INV ? -(ci) : (ci)); x[idx] = hmul(x[idx], w); } while (0)
    FFT_TW(1 + 4 * 1, C1, -S1);  FFT_TW(2 + 4 * 1, C2, -C2);  FFT_TW(3 + 4 * 1, S1, -C1);
    FFT_TW(1 + 4 * 2, C2, -C2);  FFT_TW(2 + 4 * 2, 0.f, -1.f); FFT_TW(3 + 4 * 2, -C2, -C2);
    FFT_TW(1 + 4 * 3, S1, -C1);  FFT_TW(2 + 4 * 3, -C2, -C2); FFT_TW(3 + 4 * 3, -C1, S1);
#undef FFT_TW
#pragma unroll
    for (int k2 = 0; k2 < 4; ++k2) dft4<INV>(x[4 * k2], x[4 * k2 + 1], x[4 * k2 + 2], x[4 * k2 + 3]);
#define FFT_SW(a, b) do { const hcx t = x[a]; x[a] = x[b]; x[b] = t; } while (0)
    FFT_SW(1, 4); FFT_SW(2, 8); FFT_SW(3, 12); FFT_SW(6, 9); FFT_SW(7, 13); FFT_SW(11, 14);
#undef FFT_SW
}
FFT_HD void fft_fill_tables(FFT_BUF tw, int tid) {
    for (int i = tid; i < FFT_TW_ELEMS; i += NT) {
        int idx = i, M, L;
        if (idx < FFT_TA) { M = 1024; L = 16384; } else if (idx < FFT_TA + FFT_TB) { idx -= FFT_TA; M = 64; L = 1024; } else { idx -= FFT_TA + FFT_TB; M = 4; L = 64; }
        const int p = idx / M + 1, j = idx - (p - 1) * M; const cpx w = twid<false>((float)(j * p) / (float)L);
        tw[i] = hmk(w.x, w.y);
    }
}
template <bool INV> FFT_HD void fft_pass16(FFT_BUF buf, FFT_CBUF tbl, int M, int tid) {
#pragma unroll 1
    for (int i = 0; i < 2; ++i) {
        const int bf = tid + NT * i, blk = bf / M, j = bf - blk * M, base = blk * 16 * M + j;
        hcx x[16];
#pragma unroll
        for (int q = 0; q < 16; ++q) x[q] = buf[fpad(base + M * q)];
        if (INV) {
#pragma unroll
            for (int p = 1; p < 16; ++p) x[p] = hmul(x[p], hconj(tbl[(p - 1) * M + j]));
        }
        dft16<INV>(x);
        if (!INV) {
#pragma unroll
            for (int p = 1; p < 16; ++p) x[p] = hmul(x[p], tbl[(p - 1) * M + j]);
        }
#pragma unroll
        for (int q = 0; q < 16; ++q) buf[fpad(base + M * q)] = x[q];
    }
}
#ifndef FFT_HOST
#define FFT_SYNC() __syncthreads()
FFT_HD void fft_fwd3(FFT_BUF buf, FFT_CBUF tw, int tid) { fft_pass16<false>(buf, tw, 1024, tid); FFT_SYNC(); fft_pass16<false>(buf, tw + FFT_TA, 64, tid); FFT_SYNC(); fft_pass16<false>(buf, tw + FFT_TA + FFT_TB, 4, tid); FFT_SYNC(); }
FFT_HD void fft_inv3(FFT_BUF buf, FFT_CBUF tw, int tid) { fft_pass16<true>(buf, tw + FFT_TA + FFT_TB, 4, tid); FFT_SYNC(); fft_pass16<true>(buf, tw + FFT_TA, 64, tid); FFT_SYNC(); fft_pass16<true>(buf, tw, 1024, tid); FFT_SYNC(); }
#endif
FFT_HD void fft_mid_load(FFT_BUF buf, int tid, int i, hcx (&e)[4]) {
    const int b0 = 4 * (tid + NT * i);
#pragma unroll
    for (int q = 0; q < 4; ++q) e[q] = buf[fpad(b0 + q)];
    dft4<false>(e[0], e[1], e[2], e[3]);
}
FFT_HD void fft_mid_mulstore(FFT_BUF buf, int tid, int i, hcx (&e)[4], const hcx (&k)[4]) {
    const int b0 = 4 * (tid + NT * i);
#pragma unroll
    for (int q = 0; q < 4; ++q) e[q] = hmul(e[q], k[q]);
    dft4<true>(e[0], e[1], e[2], e[3]);
#pragma unroll
    for (int q = 0; q < 4; ++q) buf[fpad(b0 + q)] = e[q];
}

#define WSP(T, off) ((T*)(A.ws + (off)))
__device__ __forceinline__ int gwave() { return blockIdx.x * 8 + (ltid() >> 6); }
__device__ __forceinline__ int ngwaves() { return gridDim.x * 8; }

template <class F>
__device__ __forceinline__ void tr_item(const float* W, int ldw, F colmap, const float* kscale, bf16_t* WT, int ldd, int ksrc0, int kdst0, int n0, float* scr, int lane, float nscale = 1.0f, int nscale_lim = 0) {
    const int n = n0 + (lane & 31); const int col = colmap(n); const float ns = n < nscale_lim ? nscale : 1.0f;
    float vv[32];
#pragma unroll
    for (int i = 0; i < 32; ++i) { const int kk = 2 * i + (lane >> 5); vv[i] = col >= 0 ? W[(size_t)(ksrc0 + kk) * ldw + col] : 0.f; }
#pragma unroll
    for (int i = 0; i < 32; ++i) { const int kk = 2 * i + (lane >> 5); float v = vv[i]; if (kscale) v *= kscale[ksrc0 + kk]; scr[kk * 33 + (lane & 31)] = v * ns; }
    asm volatile("s_waitcnt lgkmcnt(0)" ::: "memory");
    const int c = lane & 7;
#pragma unroll
    for (int j = 0; j < 4; ++j) { const int nn = (lane >> 3) + 8 * j; const float* s = scr + (8 * c) * 33 + nn;
        u32x4 o; o.x = cvt_pk_bf16(s[0 * 33], s[1 * 33]); o.y = cvt_pk_bf16(s[2 * 33], s[3 * 33]); o.z = cvt_pk_bf16(s[4 * 33], s[5 * 33]); o.w = cvt_pk_bf16(s[6 * 33], s[7 * 33]);
        *(u32x4*)(WT + (size_t)(n0 + nn) * ldd + kdst0 + 8 * c) = o; }
    asm volatile("s_waitcnt lgkmcnt(0)" ::: "memory");
}
__device__ __forceinline__ void conv_small_weights(const Args& A, int l, char* lds, int skip = 0) {
    float* scr = (float*)lds + (ltid() >> 6) * (64 * 33); const int lane = ltid() & 63;
    constexpr int C_WIN = 16 * (NPREP / 32), C_WG = 16 * 128, C_WB = (8 + 4 + 4 + 4) * 32, C_WO = 16 * 32, C_WM = 6 * 32, C_ALL = C_WIN + C_WG + C_WB + C_WO + C_WM;
    if ((int)blockIdx.x < skip) return;
    for (int it = gwave() - skip * 8; it < C_ALL; it += ngwaves() - skip * 8) {
        int r = it;
        if (r < C_WIN) { const int kb = r / (NPREP / 32), nb = r % (NPREP / 32);
            tr_item(A.in[I_WIN] + (size_t)l * D * NIN, NIN, [](int n) { if (n >= NPRE) return -1;
                        if (n >= 2304 && n < 2816) { const int loc = n - 2304, uu = loc >> 8, cl = loc & 255; return 2304 + (cl >> 7) * 256 + uu * 128 + (cl & 127); }
                        if (n >= 1024) return n;
                        const int p = n & 63, g = p >> 3, t = p & 7; return (n & ~63) + (t < 4 ? 4 * g + t : 32 + 4 * g + t - 4); },
                    nullptr, WSP(bf16_t, WS_WIN) + (size_t)l * NPREP * D, D, kb * 64, kb * 64, nb * 32, scr, lane, 0.125f * 1.4426950408889634f, 512); continue; }
        r -= C_WIN;
        if (r < C_WG) { const int kb = r / 128, nb = r % 128;
            tr_item(A.in[I_WIN] + (size_t)l * D * NIN, NIN, [](int n) { const int pn = n >> 8, cl = n & 255, bj = cl >> 7, rr = cl & 127, wc = rr >> 5, r2 = rr & 31, nn = r2 >> 4, r3 = r2 & 15;
                                                                     return NPRE + (2 * bj + nn) * 1024 + pn * 64 + wc * 16 + r3; }, nullptr, WSP(bf16_t, WS_WG) + (size_t)l * 4096 * D, D, kb * 64, kb * 64, nb * 32, scr, lane); continue; }
        r -= C_WG;
        if (r < C_WB) { int br, kb; const int q = r / 32, nb = r % 32;
            if (q < 8) { br = 0; kb = q; } else if (q < 12) { br = 1; kb = q - 8; } else if (q < 16) { br = 2; kb = q - 12; } else { br = 3; kb = q - 16; }
            const int start = br == 0 ? 0 : 512 + 256 * (br - 1), Ki = br == 0 ? 512 : 256;
            tr_item(A.in[I_WBR] + (size_t)l * 1280 * D + (size_t)start * D, D, [](int n) { return n; }, nullptr, WSP(bf16_t, WS_WB) + ((size_t)l * 4 + br) * 1024 * 512, 512, kb * 64, kb * 64, nb * 32, scr, lane); continue; }
        r -= C_WB;
        if (r < C_WO) { const int kb = r / 32, nb = r % 32;
            tr_item(A.in[I_WOUT] + (size_t)l * D * D, D, [](int n) { return n; }, nullptr, WSP(bf16_t, WS_WO) + (size_t)l * D * D, D, kb * 64, kb * 64, nb * 32, scr, lane); continue; }
        r -= C_WO;
        { const int kb = r / 32, nb = r % 32; bf16_t* dst = WSP(bf16_t, WS_WMLA) + (size_t)l * 1024 * 384;
            if (kb < 4) tr_item(A.in[I_WUQ] + (size_t)l * 256 * 384, 384, [](int n) { return n < 384 ? n : -1; }, A.in[I_MQG] + l * 256, dst, 384, kb * 64, kb * 64, nb * 32, scr, lane, 0.10206207261596575f * 1.4426950408889634f, 384);
            else tr_item(A.in[I_WUKV] + (size_t)l * 128 * 512, 512, [](int n) { return (n >= 384 && n < 896) ? n - 384 : -1; }, A.in[I_MKVG] + l * 128, dst, 384, (kb - 4) * 64, kb * 64, nb * 32, scr, lane); }
    }
}
__device__ __forceinline__ void conv_expert_weights(const Args& A, int l, char* lds, int first_block = 0) {
    float* scr = (float*)lds + (ltid() >> 6) * (64 * 33); const int lane = ltid() & 63;
    constexpr int C_IN = NE * 16 * 64, C_OUT = NE * 16 * 32;
    if ((int)blockIdx.x < first_block) return;
    for (int it = ((int)blockIdx.x - first_block) * 8 + (ltid() >> 6); it < C_IN + C_OUT; it += ((int)gridDim.x - first_block) * 8) {
        if (it < C_IN) { const int e = it / (16 * 64), r = it % (16 * 64), kb = r / 64, nb = r % 64;
            tr_item(A.in[I_WEIN] + ((size_t)l * NE + e) * D * 2048, 2048, [](int n) { const int f = (n >> 8) * 128 + (n & 127); return ((n >> 7) & 1) ? 1024 + f : f; }, nullptr,
                    WSP(bf16_t, WS_WEIN) + (size_t)e * 2048 * D, D, kb * 64, kb * 64, nb * 32, scr, lane); }
        else { const int r0 = it - C_IN, e = r0 / (16 * 32), r = r0 % (16 * 32), kb = r / 32, nb = r % 32;
            tr_item(A.in[I_WEOUT] + ((size_t)l * NE + e) * EH * D, D, [](int n) { return n; }, nullptr, WSP(bf16_t, WS_WEOUT) + (size_t)e * D * EH, EH, kb * 64, kb * 64, nb * 32, scr, lane); }
    }
}
__device__ __forceinline__ void compute_mod(const Args& A, char* lds, int l, int rank, int nranks) {
    float* red = (float*)lds; float* sc = red + 8 * 3 * 64;
    const int tid = ltid(), w = tid >> 6, lane = tid & 63;
    if (rank < 96) { for (int i = tid; i < 3 * 1024; i += NT) sc[i] = siluf_(i < 2048 ? A.in[I_C][i] : A.in[I_CCTX][i - 2048]); __syncthreads(); }
    for (int it = rank; it < 96; it += nranks) {
        const int col = it * 64 + lane;
        const float* W = A.in[I_ADAW] + (size_t)l * D * 6144;
        float a0 = 0.f, a1 = 0.f, a2 = 0.f;
#pragma unroll 1
        for (int k0 = w * 128; k0 < w * 128 + 128; k0 += 32) { float wv[32];
#pragma unroll
            for (int q = 0; q < 32; ++q) wv[q] = W[(size_t)(k0 + q) * 6144 + col];
#pragma unroll
            for (int q = 0; q < 32; ++q) { a0 += sc[k0 + q] * wv[q]; a1 += sc[1024 + k0 + q] * wv[q]; a2 += sc[2048 + k0 + q] * wv[q]; } }
        red[(w * 3 + 0) * 64 + lane] = a0; red[(w * 3 + 1) * 64 + lane] = a1; red[(w * 3 + 2) * 64 + lane] = a2;
        __syncthreads();
        if (tid < 192) { const int v = tid >> 6; float s = 0.f;
#pragma unroll
            for (int q = 0; q < 8; ++q) s += red[(q * 3 + v) * 64 + lane];
            WSP(float, WS_MOD)[((size_t)l * 3 + v) * 6144 + col] = s + A.in[I_ADAB][l * 6144 + col]; }
        __syncthreads();
    }
    if (l == 0 && blockIdx.x == gridDim.x - 1 && tid < 128) {
        const int ll = tid >> 6; const float* dl = A.in[I_DLAM] + ll * 256;
        const float s1 = wave_sum(dl[lane] * dl[64 + lane]), s2 = wave_sum(dl[128 + lane] * dl[192 + lane]);
        const float lam_init = ll == 0 ? 0.2f : 0.35550907f;
        if (lane == 0) WSP(float, WS_LAM)[ll] = __expf(s1) - __expf(s2) + lam_init;
    }
}
__device__ __forceinline__ void compute_hid2(const Args& A, char* lds, int l, int rank, int nranks) {
    float* zs = (float*)lds; float* hs = zs + 128 * 34; float* w1s = hs + 128 * 65; float* w2s = w1s + 33 * 64;
    const int tid = ltid(), tl = tid & 127, og = tid >> 7;
    constexpr int IT_L = SEQ / 128, IT_C = NCTX / 128, IT = IT_L + IT_C;
    for (int it = rank; it < IT; it += nranks) {
        const int r = it; const bool isc = r >= IT_L; const int n = isc ? NCTX : SEQ, t = (isc ? r - IT_L : r) * 128 + tl;
        for (int i = tid; i < 33 * 64 / 4; i += NT) *(f32x4*)(w1s + 4 * i) = *(const f32x4*)(A.in[I_FW1] + l * 33 * 64 + 4 * i);
        for (int i = tid; i < 64 * 64 / 4; i += NT) *(f32x4*)(w2s + 4 * i) = *(const f32x4*)(A.in[I_FW2] + l * 64 * 64 + 4 * i);
        if (og == 0) {
            const float tn = (float)t / (float)(n - 1), tr = (float)t / (float)n;
            zs[tl * 34] = tn;
            for (int k = 0; k < 16; ++k) { const float f = 1e-4f + (float)k * ((15.0f - 1e-4f) / 15.0f); const float rv = f * tr;
                zs[tl * 34 + 1 + k] = __builtin_amdgcn_cosf(rv); zs[tl * 34 + 17 + k] = -__builtin_amdgcn_sinf(rv); }
        }
        __syncthreads();
        float acc[16];
        { const float* w1 = w1s; const float* b1 = A.in[I_FB1] + l * 64;
#pragma unroll
          for (int j = 0; j < 16; ++j) acc[j] = b1[og * 16 + j];
          for (int k = 0; k < 33; ++k) { const float z = zs[tl * 34 + k];
#pragma unroll
              for (int j = 0; j < 16; ++j) acc[j] += z * w1[k * 64 + og * 16 + j]; }
          const float* fq = A.in[I_FFREQ] + l * 128;
#pragma unroll
          for (int j = 0; j < 16; ++j) hs[tl * 65 + og * 16 + j] = __builtin_amdgcn_sinf(fq[og * 16 + j] * acc[j] * 0.15915494309189535f); }
        __syncthreads();
        { const float* w2 = w2s; const float* b2 = A.in[I_FB2] + l * 64;
#pragma unroll
          for (int j = 0; j < 16; ++j) acc[j] = b2[og * 16 + j];
          for (int k = 0; k < 64; ++k) { const float z = hs[tl * 65 + k];
#pragma unroll
              for (int j = 0; j < 16; ++j) acc[j] += z * w2[k * 64 + og * 16 + j]; }
          const float* fq = A.in[I_FFREQ] + l * 128 + 64;
          float* dst = isc ? WSP(float, WS_HID2C) + ((size_t)l * NCTX + t) * 64 : WSP(float, WS_HID2) + ((size_t)l * SEQ + t) * 64;
#pragma unroll
          for (int j = 0; j < 16; ++j) dst[og * 16 + j] = __builtin_amdgcn_sinf(fq[og * 16 + j] * acc[j] * 0.15915494309189535f); }
        __syncthreads();
    }
}
__device__ __forceinline__ void norm_mod_store(const f32x4 (&v)[4], const float* g, const float* shift, const float* scale, bf16_t* urow, int lane) {
    float ss = 0.f;
#pragma unroll
    for (int j = 0; j < 4; ++j) ss += (v[j].x * v[j].x + v[j].y * v[j].y) + (v[j].z * v[j].z + v[j].w * v[j].w);
    const float rs = 1.0f / sqrtf(wave_sum(ss) * (1.0f / D) + EPS);
#pragma unroll
    for (int j = 0; j < 4; ++j) { const int c = 4 * lane + 256 * j; const f32x4 gg = *(const f32x4*)(g + c), sh = *(const f32x4*)(shift + c), sc = *(const f32x4*)(scale + c);
        const f32x4 u = v[j] * rs * gg * (sc + 1.0f) + sh;
        u32x2 w; w.x = cvt_pk_bf16(u.x, u.y); w.y = cvt_pk_bf16(u.z, u.w); *(u32x2*)(urow + c) = w; }
}
#define COL8(j) (8 * lane + 512 * ((j) >> 1) + 4 * ((j) & 1))
__device__ __forceinline__ void norm_mod_store8(const f32x4 (&v)[4], const float* g, const float* shift, const float* scale, bf16_t* urow, int lane) {
    float ss = 0.f;
#pragma unroll
    for (int j = 0; j < 4; ++j) ss += (v[j].x * v[j].x + v[j].y * v[j].y) + (v[j].z * v[j].z + v[j].w * v[j].w);
    const float rs = 1.0f / sqrtf(wave_sum(ss) * (1.0f / D) + EPS);
    f32x4 u[4];
#pragma unroll
    for (int j = 0; j < 4; ++j) { const int c = COL8(j); const f32x4 gg = *(const f32x4*)(g + c), sh = *(const f32x4*)(shift + c), sc = *(const f32x4*)(scale + c); u[j] = v[j] * rs * gg * (sc + 1.0f) + sh; }
#pragma unroll
    for (int k = 0; k < 2; ++k) { u32x4 w; w.x = cvt_pk_bf16(u[2 * k].x, u[2 * k].y); w.y = cvt_pk_bf16(u[2 * k].z, u[2 * k].w); w.z = cvt_pk_bf16(u[2 * k + 1].x, u[2 * k + 1].y); w.w = cvt_pk_bf16(u[2 * k + 1].z, u[2 * k + 1].w);
        *(u32x4*)(urow + 8 * lane + 512 * k) = w; }
}
__device__ __forceinline__ void rows_to_u_layer0(const Args& A) {
    const int lane = ltid() & 63;
    for (int row = gwave(); row < ROWS; row += ngwaves()) {
        const float* src = row < RL ? A.in[I_X] + (size_t)row * D : A.in[I_CTX] + (size_t)(row - RL) * D;
        f32x4 v[4];
#pragma unroll
        for (int j = 0; j < 4; ++j) v[j] = *(const f32x4*)(src + COL8(j));
        const float* mod = WSP(float, WS_MOD) + (size_t)(0 * 3 + row_vec(row)) * 6144;
        norm_mod_store8(v, A.in[I_GMIX], mod, mod + 1024, WSP(bf16_t, WS_U) + (size_t)row * D, lane);
    }
}
__device__ __forceinline__ void post_rows(const Args& A) {
    const int lane = ltid() & 63;
    bf16_t* ZD = WSP(bf16_t, WS_ZD); bf16_t* ZM = WSP(bf16_t, WS_ZM); bf16_t* KR = WSP(bf16_t, WS_KR);
    for (int row = gwave(); row < ROWS; row += ngwaves()) {
        const bool lat = row < RL; const int tok = row & (SEQ - 1); const float prow = (float)(tok >> 6), pcol = (float)(tok & 63);
        bf16_t* zm = ZM + (size_t)row * 512;
        { const u32x2 q = *(const u32x2*)(zm + 4 * lane); const float a0 = bflo(q.x), a1 = bfhi(q.x), a2 = bflo(q.y), a3 = bfhi(q.y);
          const float rs = 1.0f / sqrtf(wave_sum((a0 * a0 + a1 * a1) + (a2 * a2 + a3 * a3)) * (1.0f / 256.0f) + EPS);
          u32x2 o; o.x = cvt_pk_bf16(a0 * rs, a1 * rs); o.y = cvt_pk_bf16(a2 * rs, a3 * rs); *(u32x2*)(zm + 4 * lane) = o; }
        { float a0 = 0.f, a1 = 0.f, a2 = 0.f, a3 = 0.f; if (lane < 32) { const u32x2 q = *(const u32x2*)(zm + 256 + 4 * lane); a0 = bflo(q.x); a1 = bfhi(q.x); a2 = bflo(q.y); a3 = bfhi(q.y); }
          const float rs = 1.0f / sqrtf(wave_sum((a0 * a0 + a1 * a1) + (a2 * a2 + a3 * a3)) * (1.0f / 128.0f) + EPS);
          if (lane < 32) { u32x2 o; o.x = cvt_pk_bf16(a0 * rs, a1 * rs); o.y = cvt_pk_bf16(a2 * rs, a3 * rs); *(u32x2*)(zm + 256 + 4 * lane) = o; } }
        if (lane < 16) { const float x1 = bf2f(zm[384 + lane]), x2 = bf2f(zm[384 + 16 + lane]); float y1 = x1, y2 = x2;
            if (lat) { const float pos = lane < 8 ? prow : pcol; const float inv = exp2f(-(float)(lane & 7) * (13.287712379549449f / 8.0f)); const float rev = pos * inv * 0.15915494309189535f;
                const float c = __builtin_amdgcn_cosf(rev), s = __builtin_amdgcn_sinf(rev); y1 = x1 * c - x2 * s; y2 = x1 * s + x2 * c; }
            KR[(size_t)row * 32 + lane] = f2bf(y1); KR[(size_t)row * 32 + 16 + lane] = f2bf(y2); }
    }
}
__device__ __forceinline__ void mla_q_rope(const Args& A) {
    const int lane = ltid() & 63; bf16_t* QM = WSP(bf16_t, WS_QM);
    for (int row = gwave(); row < RL; row += ngwaves()) {
        const int tok = row & (SEQ - 1); const int h = lane >> 4, j = lane & 15; bf16_t* p = QM + (size_t)row * 1024 + h * 96 + 64 + j;
        const float x1 = bf2f(p[0]), x2 = bf2f(p[16]); const float pos = j < 8 ? (float)(tok >> 6) : (float)(tok & 63);
        const float inv = exp2f(-(float)(j & 7) * (13.287712379549449f / 8.0f)); const float rev = pos * inv * 0.15915494309189535f;
        const float c = __builtin_amdgcn_cosf(rev), s = __builtin_amdgcn_sinf(rev);
        p[0] = f2bf(x1 * c - x2 * s); p[16] = f2bf(x1 * s + x2 * c);
    }
}

__device__ __forceinline__ void seq_bounds(int row, int& lo, int& hi) { if (row < RL) { lo = row & ~(SEQ - 1); hi = lo + SEQ; } else { lo = RL + ((row - RL) & ~(NCTX - 1)); hi = lo + NCTX; } }

__device__ __forceinline__ void conformer_tiles(const Args& A, int l, char* lds, int nrows) {
    float* glu = (float*)lds; float* ub = glu + 62 * 256;
    const int tid = ltid(), lane = tid & 63, w = tid >> 6, c = tid & 255, half = tid >> 8;
    const bf16_t* ZC = WSP(bf16_t, WS_ZC); bf16_t* Y = WSP(bf16_t, WS_Y);
    float wk[31];
#pragma unroll
    for (int k = 0; k < 31; ++k) wk[k] = A.in[I_CDW][(size_t)l * 31 * 256 + k * 256 + c];
    const f32x4 lg = *(const f32x4*)(A.in[I_CLNG] + l * 256 + 4 * lane), lb = *(const f32x4*)(A.in[I_CLNB] + l * 256 + 4 * lane);
    for (int it = blockIdx.x; it < nrows / 32; it += gridDim.x) {
        const int row0 = it * 32; int lo, hi; seq_bounds(row0, lo, hi);
        for (int idx = tid; idx < 62 * 64; idx += NT) { const int r = idx >> 6, c4 = (idx & 63) * 4, grow = row0 - 15 + r; f32x4 g = {0.f, 0.f, 0.f, 0.f};
            if (grow >= lo && grow < hi) { const u32x2 a = *(const u32x2*)(ZC + (size_t)grow * 256 + c4);
                g.x = bflo(a.x); g.y = bfhi(a.x); g.z = bflo(a.y); g.w = bfhi(a.y); }
            *(f32x4*)(glu + r * 256 + c4) = g; }
        __syncthreads();
        { float win[46];
#pragma unroll
            for (int k = 0; k < 46; ++k) win[k] = glu[(half * 16 + k) * 256 + c];
#pragma unroll
            for (int q = 0; q < 16; ++q) { float s = 0.f;
#pragma unroll
                for (int k = 0; k < 31; ++k) s += wk[k] * win[q + k];
                ub[(half * 16 + q) * 256 + c] = s; } }
        __syncthreads();
#pragma unroll
        for (int q = 0; q < 4; ++q) { const int tt = w * 4 + q; const f32x4 x = *(const f32x4*)(ub + tt * 256 + 4 * lane);
            const float mu = wave_sum((x.x + x.y) + (x.z + x.w)) * (1.0f / 256.0f); const f32x4 d = x - mu;
            const float var = wave_sum((d.x * d.x + d.y * d.y) + (d.z * d.z + d.w * d.w)) * (1.0f / 256.0f); const float rstd = 1.0f / sqrtf(var + EPS);
            const f32x4 y = d * rstd * lg + lb;
            u32x2 o; o.x = cvt_pk_bf16(siluf_(y.x), siluf_(y.y)); o.y = cvt_pk_bf16(siluf_(y.z), siluf_(y.w));
            *(u32x2*)(Y + (size_t)(row0 + tt) * 1280 + 768 + 4 * lane) = o; }
        __syncthreads();
    }
}
__device__ __forceinline__ void hyena_pre_tiles(const Args& A, int l, char* lds, int nrows) {
    bf16_t* zt = (bf16_t*)lds;
    const int tid = ltid(), lane = tid & 63, w = tid >> 6;
    const bf16_t* ZH = WSP(bf16_t, WS_ZH); bf16_t* HYT = WSP(bf16_t, WS_HYT);
    for (int it = (blockIdx.x + gridDim.x - 16u % gridDim.x) % gridDim.x; it < (nrows / 128) * 3; it += gridDim.x) {
        const int tile = it / 3, cg = it % 3, row0 = tile * 128; int lo, hi; seq_bounds(row0, lo, hi);
        for (int idx = tid; idx < 130 * 32; idx += NT) { const int r = idx >> 5, c8 = (idx & 31) * 8, grow = row0 - 1 + r; u32x4 v = {0u, 0u, 0u, 0u};
            if (grow >= lo && grow < hi) v = *(const u32x4*)(ZH + (size_t)grow * 768 + cg * 256 + c8);
            unsigned* d = (unsigned*)(zt + r * 258 + c8); d[0] = v.x; d[1] = v.y; d[2] = v.z; d[3] = v.w; }
        __syncthreads();
        const bool lat = row0 < RL; const int b = lat ? row0 / SEQ : (row0 - RL) / NCTX, t0 = lat ? row0 % SEQ : (row0 - RL) % NCTX;
        const int gchl = cg * 256 + w * 32 + (lane & 31);
        const float w0l = A.in[I_HSW][(size_t)l * 3 * 768 + gchl], w1l = A.in[I_HSW][(size_t)l * 3 * 768 + 768 + gchl], w2l = A.in[I_HSW][(size_t)l * 3 * 768 + 1536 + gchl], bbl = A.in[I_HSB][l * 768 + gchl];
        for (int q = 0; q < 32; ++q) { const int ch = w * 32 + q, gch = cg * 256 + ch;
            const float w0 = __uint_as_float(__builtin_amdgcn_readlane(__float_as_uint(w0l), q)), w1 = __uint_as_float(__builtin_amdgcn_readlane(__float_as_uint(w1l), q)),
                        w2 = __uint_as_float(__builtin_amdgcn_readlane(__float_as_uint(w2l), q)), bb = __uint_as_float(__builtin_amdgcn_readlane(__float_as_uint(bbl), q));
            const float z0 = bf2f(zt[(2 * lane) * 258 + ch]), z1 = bf2f(zt[(2 * lane + 1) * 258 + ch]), z2 = bf2f(zt[(2 * lane + 2) * 258 + ch]), z3 = bf2f(zt[(2 * lane + 3) * 258 + ch]);
            const float o0 = w0 * z0 + w1 * z1 + w2 * z2 + bb, o1 = w0 * z1 + w1 * z2 + w2 * z3 + bb;
            bf16_t* dst = lat ? HYT + ((size_t)(b * 768 + gch)) * SEQ + t0 : HYT + (size_t)2 * 768 * SEQ + ((size_t)(b * 768 + gch)) * NCTX + t0;
            *(unsigned*)(dst + 2 * lane) = cvt_pk_bf16(o0, o1); }
        __syncthreads();
    }
}
typedef _Float16 f16x8 __attribute__((ext_vector_type(8)));
__device__ __forceinline__ void hyena_filters(const Args& A, int l, char* lds, bool with_ctx) {
    float* h2 = (float*)lds; float* w3s = h2 + 256 * 68;
    const int tid = ltid(), lane = tid & 63, w = tid >> 6, l16 = lane & 15, lg = lane >> 4;
    const int nit = 64 * 8 + (with_ctx ? 8 : 0);
    for (int it = (blockIdx.x + gridDim.x - 32u % gridDim.x) % gridDim.x; it < nit; it += gridDim.x) {
        const bool isc = it >= 512; const int r = isc ? it - 512 : it, tt = r >> 3, ct = r & 7, n = isc ? NCTX : SEQ, t0 = tt * 256, col0 = ct * 128;
        const float* hsrc = isc ? WSP(float, WS_HID2C) + (size_t)l * NCTX * 64 : WSP(float, WS_HID2) + (size_t)l * SEQ * 64;
        for (int idx = tid; idx < 256 * 16; idx += NT) { const int rr = idx >> 4, c4 = (idx & 15) * 4; *(f32x4*)(h2 + rr * 68 + c4) = *(const f32x4*)(hsrc + (size_t)(t0 + rr) * 64 + c4); }
        for (int idx = tid; idx < 64 * 32; idx += NT) { const int j = idx >> 5, c4 = (idx & 31) * 4; *(f32x4*)(w3s + j * 132 + c4) = *(const f32x4*)(A.in[I_FW3] + (size_t)l * 64 * 1024 + j * 1024 + col0 + c4); }
        __syncthreads();
        f16x8 bt[2][2];
#pragma unroll
        for (int tb = 0; tb < 2; ++tb)
#pragma unroll
            for (int ks = 0; ks < 2; ++ks) { const float* hp = h2 + (w * 32 + tb * 16 + l16) * 68 + ks * 32 + lg * 8; const f32x4 x0 = *(const f32x4*)hp, x1 = *(const f32x4*)(hp + 4);
                bt[tb][ks] = (f16x8){(_Float16)x0.x, (_Float16)x0.y, (_Float16)x0.z, (_Float16)x0.w, (_Float16)x1.x, (_Float16)x1.y, (_Float16)x1.z, (_Float16)x1.w}; }
        const int t_l = t0 + w * 32 + l16;
#pragma unroll
        for (int cb = 0; cb < 8; ++cb) {
            f16x8 at[2];
#pragma unroll
            for (int ks = 0; ks < 2; ++ks) { const float* wp = w3s + (ks * 32 + lg * 8) * 132 + cb * 16 + l16;
                at[ks] = (f16x8){(_Float16)wp[0], (_Float16)wp[132], (_Float16)wp[2 * 132], (_Float16)wp[3 * 132], (_Float16)wp[4 * 132], (_Float16)wp[5 * 132], (_Float16)wp[6 * 132], (_Float16)wp[7 * 132]}; }
#pragma unroll
            for (int tb = 0; tb < 2; ++tb) { f32x4 d = {0.f, 0.f, 0.f, 0.f};
                d = __builtin_amdgcn_mfma_f32_16x16x32_f16(bt[tb][0], at[0], d, 0, 0, 0); d = __builtin_amdgcn_mfma_f32_16x16x32_f16(bt[tb][1], at[1], d, 0, 0, 0);
                const int col = col0 + cb * 16 + l16, ch = col & 255, tq = t0 + w * 32 + tb * 16 + 4 * lg; const float delta = 3.0701134573253945f + (float)ch * (12.280453829301578f / 255.0f);
                f32x4 v;
#pragma unroll
                for (int i = 0; i < 4; ++i) { const float tn = (float)(tq + i) / (float)(n - 1); v[i] = d[i] * __expf(-tn * delta); }
                if (isc) *(f32x4*)(WSP(float, WS_HC) + (size_t)col * NCTX + tq) = v;
                else { u32x2 o; o.x = cvt_pk_bf16(v[0], v[1]); o.y = cvt_pk_bf16(v[2], v[3]); *(u32x2*)(WSP(bf16_t, WS_HF) + (size_t)col * SEQ + tq) = o; } }
        }
        __syncthreads();
    }
}

__device__ __forceinline__ unsigned hcx_bits(hcx h) { return __builtin_bit_cast(unsigned, h); }
__device__ __forceinline__ hcx bits_hcx(unsigned u) { return __builtin_bit_cast(hcx, u); }
__device__ __forceinline__ float block_sum(float v, float* red) {
    v = wave_sum(v); if ((ltid() & 63) == 0) red[ltid() >> 6] = v; __syncthreads();
    float s = 0.f;
#pragma unroll
    for (int q = 0; q < 8; ++q) s += red[q];
    __syncthreads(); return s;
}
__device__ __forceinline__ void ld8bf(const bf16_t* p, float (&v)[8]) { const u32x4 q = *(const u32x4*)p; v[0] = bflo(q.x); v[1] = bfhi(q.x); v[2] = bflo(q.y); v[3] = bfhi(q.y); v[4] = bflo(q.z); v[5] = bfhi(q.z); v[6] = bflo(q.w); v[7] = bfhi(q.w); }
__device__ __forceinline__ void hyena_item(const Args& A, int l, int c, char* lds, unsigned char* scr) {
    LAS hcx* buf = (LAS hcx*)(LAS char*)lds; LAS hcx* tw = buf + FFT_BUF_ELEMS; float* red = (float*)(lds + FFT_LDS_BYTES);
    const int tid = ltid(); constexpr int n = SEQ; constexpr float inv2n = 1.0f / (2.0f * n);
    constexpr float FS = 16384.0f, DS = 1.0f / 128.0f, OS = 128.0f / (2.0f * n); const _Float16 KS = (_Float16)(1.0f / 16384.0f);
    const bf16_t* HYT = WSP(bf16_t, WS_HYT); const bf16_t* HF = WSP(bf16_t, WS_HF); bf16_t* HYO = WSP(bf16_t, WS_HYO);
    cpx* yev = (cpx*)scr; unsigned* v1s = (unsigned*)(scr + 131072);
    int tl;
#define LAUNDER() do { tl = tid; asm volatile("" : "+v"(tl)); } while (0)
    fft_fill_tables(tw, tid);
    __syncthreads();
    u32x4 zr[4][2];
#pragma unroll 1
    for (int o = 0; o < 2; ++o) {
        const bf16_t* hf = HF + (size_t)(o * 512 + c) * SEQ; const bf16_t* hb = HF + (size_t)(o * 512 + 256 + c) * SEQ;
        float sf = 0.f, sb = 0.f;
        LAUNDER();
        u32x4 hfr[4], hbr[4];
#pragma unroll
        for (int cc = 0; cc < 4; ++cc) { const int t0 = 8 * (tl + NT * cc); hfr[cc] = *(const u32x4*)(hf + t0); hbr[cc] = *(const u32x4*)(hb + (n - 8 - t0)); }
#define UNPACK8(q, v) do { v[0] = bflo(q.x); v[1] = bfhi(q.x); v[2] = bflo(q.y); v[3] = bfhi(q.y); v[4] = bflo(q.z); v[5] = bfhi(q.z); v[6] = bflo(q.w); v[7] = bfhi(q.w); } while (0)
#pragma unroll
        for (int cc = 0; cc < 4; ++cc) { float a[8], b[8]; UNPACK8(hfr[cc], a); UNPACK8(hbr[cc], b);
#pragma unroll
            for (int e = 0; e < 8; ++e) { sf += fabsf(a[e]); sb += fabsf(b[e]); } }
        sf = block_sum(sf, red); sb = block_sum(sb, red);
        const float inf = FS / sf, inb = FS / sb;
        if (o == 0) { const bf16_t* vin0 = HYT + (size_t)(0 * 768 + 512 + c) * SEQ; const bf16_t* vin1 = HYT + (size_t)(1 * 768 + 512 + c) * SEQ; LAUNDER();
#pragma unroll
          for (int cc = 0; cc < 4; ++cc) { const int t0 = 8 * (tl + NT * cc); zr[cc][0] = *(const u32x4*)(vin0 + t0); zr[cc][1] = *(const u32x4*)(vin1 + t0); } }
        unsigned Ke[8][4], Ko[8][4];
        LAUNDER();
#pragma unroll
        for (int cc = 0; cc < 4; ++cc) { const int t0 = 8 * (tl + NT * cc); float a[8], b[8]; UNPACK8(hfr[cc], a); UNPACK8(hbr[cc], b);
#pragma unroll
            for (int e = 0; e < 8; ++e) { const float hbp = (t0 + e) >= 1 ? b[7 - e] * inb : 0.f; buf[fpad(t0 + e)] = hmk(a[e] * inf + hbp, 0.f); } }
        __syncthreads(); fft_fwd3(buf, tw, tid);
LAUNDER();
#pragma unroll
        for (int i = 0; i < 8; ++i) { hcx e[4]; fft_mid_load(buf, tl, i, e);
#pragma unroll
            for (int q = 0; q < 4; ++q) Ke[i][q] = hcx_bits(e[q] * KS);
            asm volatile("" : "+v"(Ke[i][0]), "+v"(Ke[i][1]), "+v"(Ke[i][2]), "+v"(Ke[i][3]) :: "memory"); }
        __syncthreads();
        LAUNDER();
#pragma unroll
        for (int cc = 0; cc < 4; ++cc) { const int t0 = 8 * (tl + NT * cc); float a[8], b[8]; UNPACK8(hfr[cc], a); UNPACK8(hbr[cc], b);
#pragma unroll
            for (int e = 0; e < 8; ++e) { const float hbp = (t0 + e) >= 1 ? b[7 - e] * inb : 0.f; const float r = a[e] * inf - hbp; const cpx w = twid<false>((float)(t0 + e) * inv2n);
                buf[fpad(t0 + e)] = hmk(r * w.x, r * w.y); } }
        __syncthreads(); fft_fwd3(buf, tw, tid);
LAUNDER();
#pragma unroll
        for (int i = 0; i < 8; ++i) { hcx e[4]; fft_mid_load(buf, tl, i, e);
#pragma unroll
            for (int q = 0; q < 4; ++q) Ko[i][q] = hcx_bits(e[q] * KS);
            asm volatile("" : "+v"(Ko[i][0]), "+v"(Ko[i][1]), "+v"(Ko[i][2]), "+v"(Ko[i][3]) :: "memory"); }
        __syncthreads();
#define UNPACK_Z(cc, z0, z1) do { const u32x4 qa = zr[cc][0], qb = zr[cc][1]; if (o == 0) { \
            z0[0] = bflo(qa.x); z0[1] = bfhi(qa.x); z0[2] = bflo(qa.y); z0[3] = bfhi(qa.y); z0[4] = bflo(qa.z); z0[5] = bfhi(qa.z); z0[6] = bflo(qa.w); z0[7] = bfhi(qa.w); \
            z1[0] = bflo(qb.x); z1[1] = bfhi(qb.x); z1[2] = bflo(qb.y); z1[3] = bfhi(qb.y); z1[4] = bflo(qb.z); z1[5] = bfhi(qb.z); z1[6] = bflo(qb.w); z1[7] = bfhi(qb.w); } else { \
            z0[0] = bflo(qa.x); z1[0] = bfhi(qa.x); z0[1] = bflo(qa.y); z1[1] = bfhi(qa.y); z0[2] = bflo(qa.z); z1[2] = bfhi(qa.z); z0[3] = bflo(qa.w); z1[3] = bfhi(qa.w); \
            z0[4] = bflo(qb.x); z1[4] = bfhi(qb.x); z0[5] = bflo(qb.y); z1[5] = bfhi(qb.y); z0[6] = bflo(qb.z); z1[6] = bfhi(qb.z); z0[7] = bflo(qb.w); z1[7] = bfhi(qb.w); } } while (0)
        LAUNDER();
#pragma unroll
        for (int cc = 0; cc < 4; ++cc) { const int t0 = 8 * (tl + NT * cc); float z0[8], z1[8]; UNPACK_Z(cc, z0, z1);
#pragma unroll
            for (int e = 0; e < 8; ++e) buf[fpad(t0 + e)] = hmk(z0[e] * DS, z1[e] * DS); }
        __syncthreads(); fft_fwd3(buf, tw, tid);
LAUNDER();
#pragma unroll
        for (int i = 0; i < 8; ++i) { hcx e[4], k[4]; fft_mid_load(buf, tl, i, e);
#pragma unroll
            for (int q = 0; q < 4; ++q) k[q] = bits_hcx(Ke[i][q]);
            fft_mid_mulstore(buf, tl, i, e, k); asm volatile("" ::: "memory"); }
        __syncthreads(); fft_inv3(buf, tw, tid);
        LAUNDER();
        unsigned yv[4][8];
#pragma unroll
        for (int cc = 0; cc < 4; ++cc) { const int t0 = 8 * (tl + NT * cc);
#pragma unroll
            for (int e = 0; e < 8; ++e) yv[cc][e] = hcx_bits(buf[fpad(t0 + e)]);
            asm volatile("" : "+v"(yv[cc][0]), "+v"(yv[cc][1]), "+v"(yv[cc][2]), "+v"(yv[cc][3]), "+v"(yv[cc][4]), "+v"(yv[cc][5]), "+v"(yv[cc][6]), "+v"(yv[cc][7]) :: "memory"); }
        __syncthreads();
        LAUNDER();
#pragma unroll
        for (int cc = 0; cc < 4; ++cc) { const int t0 = 8 * (tl + NT * cc); float z0[8], z1[8]; UNPACK_Z(cc, z0, z1);
#pragma unroll
            for (int e = 0; e < 8; ++e) { cpx z; z.x = z0[e] * DS; z.y = z1[e] * DS; z = cmul(z, twid<false>((float)(t0 + e) * inv2n)); buf[fpad(t0 + e)] = hmk(z.x, z.y); } }
        __syncthreads(); fft_fwd3(buf, tw, tid);
LAUNDER();
#pragma unroll
        for (int i = 0; i < 8; ++i) { hcx e[4], k[4]; fft_mid_load(buf, tl, i, e);
#pragma unroll
            for (int q = 0; q < 4; ++q) k[q] = bits_hcx(Ko[i][q]);
            fft_mid_mulstore(buf, tl, i, e, k); asm volatile("" ::: "memory"); }
        __syncthreads(); fft_inv3(buf, tw, tid);
        const float skip = A.in[I_HSKIP][l * 512 + o * 256 + c];
        const bf16_t* g0 = HYT + (size_t)(0 * 768 + o * 256 + c) * SEQ; const bf16_t* g1 = HYT + (size_t)(1 * 768 + o * 256 + c) * SEQ;
        LAUNDER();
#pragma unroll
        for (int cc = 0; cc < 4; ++cc) { const int t0 = 8 * (tl + NT * cc); float z0[8], z1[8], ga[8], gb[8]; UNPACK_Z(cc, z0, z1); ld8bf(g0 + t0, ga); ld8bf(g1 + t0, gb);
            float r0[8], r1[8];
#pragma unroll
            for (int e = 0; e < 8; e += 2) { const hcx y0 = bits_hcx(yv[cc][e]), y1 = bits_hcx(yv[cc][e + 1]); const hcx h0 = buf[fpad(t0 + e)], h1 = buf[fpad(t0 + e + 1)];
                cpx b0; b0.x = (float)h0.x; b0.y = (float)h0.y; cpx b1; b1.x = (float)h1.x; b1.y = (float)h1.y;
                const cpx yo0 = cmul(b0, twid<true>((float)(t0 + e) * inv2n)), yo1 = cmul(b1, twid<true>((float)(t0 + e + 1) * inv2n));
                r0[e] = ga[e] * (((float)y0.x + yo0.x) * OS + skip * z0[e]); r1[e] = gb[e] * (((float)y0.y + yo0.y) * OS + skip * z1[e]);
                r0[e + 1] = ga[e + 1] * (((float)y1.x + yo1.x) * OS + skip * z0[e + 1]); r1[e + 1] = gb[e + 1] * (((float)y1.y + yo1.y) * OS + skip * z1[e + 1]); }
            if (o == 0) { u32x4 qa, qb; qa.x = cvt_pk_bf16(r0[0], r1[0]); qa.y = cvt_pk_bf16(r0[1], r1[1]); qa.z = cvt_pk_bf16(r0[2], r1[2]); qa.w = cvt_pk_bf16(r0[3], r1[3]);
                qb.x = cvt_pk_bf16(r0[4], r1[4]); qb.y = cvt_pk_bf16(r0[5], r1[5]); qb.z = cvt_pk_bf16(r0[6], r1[6]); qb.w = cvt_pk_bf16(r0[7], r1[7]);
                zr[cc][0] = qa; zr[cc][1] = qb; }
            else { u32x4 qa, qb; qa.x = cvt_pk_bf16(r0[0], r0[1]); qa.y = cvt_pk_bf16(r0[2], r0[3]); qa.z = cvt_pk_bf16(r0[4], r0[5]); qa.w = cvt_pk_bf16(r0[6], r0[7]);
                qb.x = cvt_pk_bf16(r1[0], r1[1]); qb.y = cvt_pk_bf16(r1[2], r1[3]); qb.z = cvt_pk_bf16(r1[4], r1[5]); qb.w = cvt_pk_bf16(r1[6], r1[7]);
                *(u32x4*)(HYO + (size_t)(0 * 256 + c) * SEQ + t0) = qa; *(u32x4*)(HYO + (size_t)(1 * 256 + c) * SEQ + t0) = qb; } }
        __syncthreads();
    }
#undef UNPACK_Z
#undef UNPACK8
#undef LAUNDER
}
__device__ __forceinline__ void hyena_ctx_item(const Args& A, int l, int c, char* lds) {
    float* hfl = (float*)lds; float* hbl = hfl + 512; float* vv = hbl + 512; float* nrm = vv + 512;
    const int tid = ltid(), t = tid & 255, b = tid >> 8, lane = tid & 63, w = tid >> 6;
    const float* HC = WSP(float, WS_HC); const bf16_t* HYTC = WSP(bf16_t, WS_HYT) + (size_t)2 * 768 * SEQ; bf16_t* HYOC = WSP(bf16_t, WS_HYO) + (size_t)2 * 256 * SEQ;
    if (w < 4) { const int col = (w >> 1) * 512 + (w & 1) * 256 + c; float s = 0.f;
#pragma unroll
        for (int q = 0; q < 4; ++q) s += fabsf(HC[(size_t)col * NCTX + lane + 64 * q]);
        s = wave_sum(s); if (lane == 0) nrm[w] = s; }
    vv[b * 256 + t] = bf2f(HYTC[(size_t)(b * 768 + 512 + c) * NCTX + t]);
    __syncthreads();
    hfl[b * 256 + t] = HC[(size_t)(b * 512 + c) * NCTX + t] / nrm[b * 2];
    hbl[b * 256 + t] = HC[(size_t)(b * 512 + 256 + c) * NCTX + t] / nrm[b * 2 + 1];
    __syncthreads();
    for (int o = 0; o < 2; ++o) {
        float y = 0.f;
        for (int s = 0; s < NCTX; ++s) { const float k = s <= t ? hfl[o * 256 + t - s] : hbl[o * 256 + s - t - 1]; y += k * vv[b * 256 + s]; }
        const float gate = bf2f(HYTC[(size_t)(b * 768 + o * 256 + c) * NCTX + t]); const float r = gate * (y + A.in[I_HSKIP][l * 512 + o * 256 + c] * vv[b * 256 + t]);
        __syncthreads();
        vv[b * 256 + t] = r;
        __syncthreads();
    }
    HYOC[(size_t)(b * 256 + c) * NCTX + t] = f2bf(vv[b * 256 + t]);
    __syncthreads();
}
__device__ __forceinline__ void hyena_post_tiles(const Args& A, char* lds, int nrows) {
    bf16_t* tl = (bf16_t*)lds;
    const int tid = ltid(); const bf16_t* HYO = WSP(bf16_t, WS_HYO); bf16_t* Y = WSP(bf16_t, WS_Y);
    for (int it = blockIdx.x; it < nrows / 64; it += gridDim.x) {
        const int row0 = it * 64; const bool lat = row0 < RL; const int b = lat ? row0 / SEQ : (row0 - RL) / NCTX, t0 = lat ? row0 % SEQ : (row0 - RL) % NCTX;
        for (int idx = tid; idx < 256 * 8; idx += NT) { const int ch = idx >> 3, c8 = (idx & 7) * 8;
            const bf16_t* src = lat ? HYO + (size_t)(b * 256 + ch) * SEQ + t0 + c8 : HYO + (size_t)2 * 256 * SEQ + (size_t)(b * 256 + ch) * NCTX + t0 + c8;
            const u32x4 v = *(const u32x4*)src; unsigned* d = (unsigned*)(tl + ch * 66 + c8); d[0] = v.x; d[1] = v.y; d[2] = v.z; d[3] = v.w; }
        __syncthreads();
        for (int idx = tid; idx < 64 * 32; idx += NT) { const int tok = idx >> 5, c8 = (idx & 31) * 8; unsigned short e[8];
#pragma unroll
            for (int q = 0; q < 8; ++q) e[q] = tl[(c8 + q) * 66 + tok];
            u32x4 o; o.x = e[0] | ((unsigned)e[1] << 16); o.y = e[2] | ((unsigned)e[3] << 16); o.z = e[4] | ((unsigned)e[5] << 16); o.w = e[6] | ((unsigned)e[7] << 16);
            *(u32x4*)(Y + (size_t)(row0 + tok) * 1280 + 512 + c8) = o; }
        __syncthreads();
    }
}

namespace epi {
using pg8::Unit; using pg8::BM; using pg8::HALF;
__device__ __forceinline__ u32x4 pack8(const f32x4& a, const f32x4& b) { u32x4 w; w.x = cvt_pk_bf16(a[0], a[1]); w.y = cvt_pk_bf16(a[2], a[3]); w.z = cvt_pk_bf16(b[0], b[1]); w.w = cvt_pk_bf16(b[2], b[3]); return w; }
struct Win { static constexpr bool PERM = true; bf16_t *zd, *zh, *zc, *zm;
    __device__ __forceinline__ void operator()(const f32x4 (&acc)[2][2][4][2], const Unit& u, int wr, int wc, int fr, int fq) const {
        bf16_t* base; int ldc, colt; const int pn = u.pn;
        if (pn < 6) { base = zd; ldc = 1536; colt = pn * 256; } else if (pn < 9) { base = zh; ldc = 768; colt = (pn - 6) * 256; } else if (pn < 11) { base = zc; ldc = 512; colt = (pn - 9) * 256; } else { base = zm; ldc = 512; colt = (pn - 11) * 256; }
        const int row0 = u.pm * BM + wr * 64 + fr, col0 = colt + wc * 32 + 8 * fq;
        if (pn == 9 || pn == 10) {
            const int f0 = (pn - 9) * 128 + wc * 32 + 8 * fq;
#pragma unroll
            for (int ai = 0; ai < 2; ++ai)
#pragma unroll
                for (int m = 0; m < 4; ++m) { f32x4 ga, gb; const f32x4 a0 = acc[ai][0][m][0], a1 = acc[ai][0][m][1], b0 = acc[ai][1][m][0], b1 = acc[ai][1][m][1];
#pragma unroll
                    for (int j = 0; j < 4; ++j) { ga[j] = a0[j] * sigmoidf_(b0[j]); gb[j] = a1[j] * sigmoidf_(b1[j]); }
                    *(u32x4*)(zc + (size_t)(row0 + ai * HALF + m * 16) * 256 + f0) = pack8(ga, gb); }
            return;
        }
        if (pn < 4) {
            const int g = 4 * (wc & 1) + fq; float inv[4];
#pragma unroll
            for (int t = 0; t < 4; ++t) inv[t] = exp2f(-(float)((4 * g + t) & 15) * (13.287712379549449f / 16.0f)) * 0.15915494309189535f;
            const bool lat = u.pm < RL / BM;
#pragma unroll
            for (int ai = 0; ai < 2; ++ai)
#pragma unroll
                for (int m = 0; m < 4; ++m) { const int row = row0 + ai * HALF + m * 16; const int tok = row & (SEQ - 1); const float pos = g < 4 ? (float)(tok >> 6) : (float)(tok & 63);
                    float cs[4], sn[4];
#pragma unroll
                    for (int t = 0; t < 4; ++t) { const float rev = pos * inv[t]; cs[t] = lat ? __builtin_amdgcn_cosf(rev) : 1.f; sn[t] = lat ? __builtin_amdgcn_sinf(rev) : 0.f; }
#pragma unroll
                    for (int bj = 0; bj < 2; ++bj) { const f32x4 x1 = acc[ai][bj][m][0], x2 = acc[ai][bj][m][1]; f32x4 y1, y2;
#pragma unroll
                        for (int t = 0; t < 4; ++t) { y1[t] = x1[t] * cs[t] - x2[t] * sn[t]; y2[t] = x1[t] * sn[t] + x2[t] * cs[t]; }
                        bf16_t* bp = base + (size_t)row * ldc + colt + bj * HALF + (wc >> 1) * 64 + 4 * g;
                        u32x2 w1, w2; w1.x = cvt_pk_bf16(y1[0], y1[1]); w1.y = cvt_pk_bf16(y1[2], y1[3]); w2.x = cvt_pk_bf16(y2[0], y2[1]); w2.y = cvt_pk_bf16(y2[2], y2[3]);
                        *(u32x2*)bp = w1; *(u32x2*)(bp + 32) = w2; } }
            return;
        }
#pragma unroll
        for (int ai = 0; ai < 2; ++ai)
#pragma unroll
            for (int m = 0; m < 4; ++m) { bf16_t* rowp = base + (size_t)(row0 + ai * HALF + m * 16) * ldc + col0;
#pragma unroll
                for (int bj = 0; bj < 2; ++bj) *(u32x4*)(rowp + bj * HALF) = pack8(acc[ai][bj][m][0], acc[ai][bj][m][1]); }
    } };
struct Mla { static constexpr bool PERM = true; bf16_t* qkv;
    __device__ __forceinline__ void operator()(const f32x4 (&acc)[2][2][4][2], const Unit& u, int wr, int wc, int fr, int fq) const {
        const int row0 = u.pm * BM + wr * 64 + fr, col0 = u.pn * BM + wc * 32 + 8 * fq;
#pragma unroll
        for (int ai = 0; ai < 2; ++ai)
#pragma unroll
            for (int m = 0; m < 4; ++m) { bf16_t* rowp = qkv + (size_t)(row0 + ai * HALF + m * 16) * 1024 + col0;
#pragma unroll
                for (int bj = 0; bj < 2; ++bj) *(u32x4*)(rowp + bj * HALF) = pack8(acc[ai][bj][m][0], acc[ai][bj][m][1]); }
    } };
struct PBranch { static constexpr bool PERM = true; bf16_t* P;
    __device__ __forceinline__ void operator()(const f32x4 (&acc)[2][2][4][2], const Unit& u, int wr, int wc, int fr, int fq) const {
        const int row0 = u.pm * BM + wr * 64 + fr, col0 = u.tag * 1024 + u.pn * BM + wc * 32 + 8 * fq;
#pragma unroll
        for (int ai = 0; ai < 2; ++ai)
#pragma unroll
            for (int m = 0; m < 4; ++m) { bf16_t* rowp = P + (size_t)(row0 + ai * HALF + m * 16) * 4096 + col0;
#pragma unroll
                for (int bj = 0; bj < 2; ++bj) *(u32x4*)(rowp + bj * HALF) = pack8(acc[ai][bj][m][0], acc[ai][bj][m][1]); }
    } };
struct Gate { static constexpr bool PERM = false; const bf16_t* P; bf16_t* ACC;
    __device__ __forceinline__ void operator()(const f32x4 (&acc)[2][2][4][2], const Unit& u, int wr, int wc, int fr, int fq) const {
        const int row0 = u.pm * BM + wr * 64 + fr, chan = u.pn * 64 + wc * 16 + 4 * fq;
#pragma unroll
        for (int ai = 0; ai < 2; ++ai) {
            u32x2 pw[4][4];
#pragma unroll
            for (int m = 0; m < 4; ++m) { const bf16_t* pp = P + (size_t)(row0 + ai * HALF + m * 16) * 4096 + chan;
#pragma unroll
                for (int i = 0; i < 4; ++i) pw[m][i] = *(const u32x2*)(pp + i * 1024); }
            asm volatile("" ::: "memory");
#pragma unroll
            for (int m = 0; m < 4; ++m) { const int row = row0 + ai * HALF + m * 16; f32x4 s = {0.f, 0.f, 0.f, 0.f};
#pragma unroll
                for (int i = 0; i < 4; ++i) { const f32x4 g = acc[ai][i >> 1][m][i & 1];
                    s[0] += sigmoidf_(g[0]) * bflo(pw[m][i].x); s[1] += sigmoidf_(g[1]) * bfhi(pw[m][i].x); s[2] += sigmoidf_(g[2]) * bflo(pw[m][i].y); s[3] += sigmoidf_(g[3]) * bfhi(pw[m][i].y); }
                u32x2 w; w.x = cvt_pk_bf16(s[0], s[1]); w.y = cvt_pk_bf16(s[2], s[3]); *(u32x2*)(ACC + (size_t)row * 1024 + chan) = w; }
        }
    } };
struct Out { static constexpr bool PERM = true; const float* xlat; const float* xctx; bf16_t* hb; bool first; const float* mod2;
    __device__ __forceinline__ void operator()(const f32x4 (&acc)[2][2][4][2], const Unit& u, int wr, int wc, int fr, int fq) const {
        const int v = u.pm < 64 ? 0 : (u.pm < 128 ? 1 : 2); const bool lat = u.pm < 128;
        const int row0 = u.pm * BM + wr * 64 + fr, col0 = u.pn * BM + wc * 32 + 8 * fq; const float* mg = mod2 + (size_t)v * 6144 + col0;
        f32x4 gv[2][2];
#pragma unroll
        for (int bj = 0; bj < 2; ++bj)
#pragma unroll
            for (int n = 0; n < 2; ++n) gv[bj][n] = *(const f32x4*)(mg + bj * HALF + n * 4);
        if (first) {
            const float* src = lat ? xlat : xctx - (size_t)RL * D;
#pragma unroll
            for (int ai = 0; ai < 2; ++ai)
#pragma unroll
                for (int m = 0; m < 4; ++m) { const size_t off = (size_t)(row0 + ai * HALF + m * 16) * D + col0;
#pragma unroll
                    for (int bj = 0; bj < 2; ++bj) { const f32x4 r0 = *(const f32x4*)(src + off + bj * HALF) + gv[bj][0] * acc[ai][bj][m][0], r1 = *(const f32x4*)(src + off + bj * HALF + 4) + gv[bj][1] * acc[ai][bj][m][1];
                        *(u32x4*)(hb + off + bj * HALF) = pack8(r0, r1); } }
        } else {
#pragma unroll
            for (int ai = 0; ai < 2; ++ai)
#pragma unroll
                for (int m = 0; m < 4; ++m) { const size_t off = (size_t)(row0 + ai * HALF + m * 16) * D + col0;
#pragma unroll
                    for (int bj = 0; bj < 2; ++bj) { bf16_t* hp = hb + off + bj * HALF; const u32x4 q = *(const u32x4*)hp;
                        const f32x4 h0 = {bflo(q.x), bfhi(q.x), bflo(q.y), bfhi(q.y)}, h1 = {bflo(q.z), bfhi(q.z), bflo(q.w), bfhi(q.w)};
                        *(u32x4*)hp = pack8(h0 + gv[bj][0] * acc[ai][bj][m][0], h1 + gv[bj][1] * acc[ai][bj][m][1]); } }
        }
    } };
struct Ex1 { static constexpr bool PERM = true; bf16_t* HID;
    __device__ __forceinline__ void operator()(const f32x4 (&acc)[2][2][4][2], const Unit& u, int wr, int wc, int fr, int fq) const {
        const int row0 = u.pm * BM + wr * 64 + fr, f0 = u.pn * 128 + wc * 32 + 8 * fq;
#pragma unroll
        for (int ai = 0; ai < 2; ++ai)
#pragma unroll
            for (int m = 0; m < 4; ++m) { f32x4 a, b; const f32x4 g0 = acc[ai][0][m][0], g1 = acc[ai][0][m][1], u0 = acc[ai][1][m][0], u1 = acc[ai][1][m][1];
#pragma unroll
                for (int j = 0; j < 4; ++j) { a[j] = siluf_(g0[j]) * u0[j]; b[j] = siluf_(g1[j]) * u1[j]; }
                *(u32x4*)(HID + (size_t)(row0 + ai * HALF + m * 16) * EH + f0) = pack8(a, b); }
    } };
struct Ex2 { static constexpr bool PERM = true; bf16_t* YE; const float* grow;
    __device__ __forceinline__ void operator()(const f32x4 (&acc)[2][2][4][2], const Unit& u, int wr, int wc, int fr, int fq) const {
        const int row0 = u.pm * BM + wr * 64 + fr, col0 = u.pn * BM + wc * 32 + 8 * fq;
#pragma unroll
        for (int ai = 0; ai < 2; ++ai)
#pragma unroll
            for (int m = 0; m < 4; ++m) { const int row = row0 + ai * HALF + m * 16; const float g = grow[row];
#pragma unroll
                for (int bj = 0; bj < 2; ++bj) *(u32x4*)(YE + (size_t)row * D + col0 + bj * HALF) = pack8(acc[ai][bj][m][0] * g, acc[ai][bj][m][1] * g); }
    } };
}

__device__ __forceinline__ void router_rows(const Args& A, int l, char* lds, int nrows) {
    float* wrT = (float*)lds; const int tid = ltid(), lane = tid & 63;
    constexpr int WRS = 1028;
    { f32x4 lw[8];
#pragma unroll
      for (int q = 0; q < 8; ++q) lw[q] = *(const f32x4*)(A.in[I_WROUTER] + (size_t)l * D * NE + 4 * (tid + NT * q));
#pragma unroll
      for (int q = 0; q < 8; ++q) { const int i4 = 4 * (tid + NT * q), kk = i4 >> 4, e0 = i4 & 15, k = 4 * ((kk & 511) >> 3) + 256 * (2 * (kk >> 9) + ((kk >> 2) & 1)) + (kk & 3);
          wrT[(e0 + 0) * WRS + k] = lw[q].x; wrT[(e0 + 1) * WRS + k] = lw[q].y; wrT[(e0 + 2) * WRS + k] = lw[q].z; wrT[(e0 + 3) * WRS + k] = lw[q].w; } }
    __syncthreads();
    float* AFFT = WSP(float, WS_AFFT); int* INV = WSP(int, WS_INV);
    const int stride = ngwaves(); int row = gwave(); u32x4 vn[2];
#define RROW_PTR(r) (WSP(bf16_t, WS_HB) + (size_t)(r) * D)
#define UNPK8(q, va, vb) do { va = (f32x4){bflo(q.x), bfhi(q.x), bflo(q.y), bfhi(q.y)}; vb = (f32x4){bflo(q.z), bfhi(q.z), bflo(q.w), bfhi(q.w)}; } while (0)
    if (row < nrows) { const bf16_t* src = RROW_PTR(row);
#pragma unroll
        for (int k = 0; k < 2; ++k) vn[k] = *(const u32x4*)(src + 8 * lane + 512 * k); }
    for (; row < nrows; row += stride) {
        f32x4 v[4]; float ss = 0.f;
#pragma unroll
        for (int k = 0; k < 2; ++k) UNPK8(vn[k], v[2 * k], v[2 * k + 1]);
#pragma unroll
        for (int j = 0; j < 4; ++j) ss += (v[j].x * v[j].x + v[j].y * v[j].y) + (v[j].z * v[j].z + v[j].w * v[j].w);
        if (row + stride < nrows) { const bf16_t* src = RROW_PTR(row + stride);
#pragma unroll
            for (int k = 0; k < 2; ++k) vn[k] = *(const u32x4*)(src + 8 * lane + 512 * k); }
        const float rs = 1.0f / sqrtf(wave_sum(ss) * (1.0f / D) + EPS);
        const float* mod = WSP(float, WS_MOD) + (size_t)(l * 3 + row_vec(row)) * 6144; const float* g = A.in[I_GFFN] + l * D;
        bf16_t* urow = WSP(bf16_t, WS_U) + (size_t)row * D;
#pragma unroll
        for (int j = 0; j < 4; ++j) { const int c = COL8(j); const f32x4 gg = *(const f32x4*)(g + c), sh = *(const f32x4*)(mod + 3 * 1024 + c), sc = *(const f32x4*)(mod + 4 * 1024 + c);
            v[j] = v[j] * rs * gg * (sc + 1.0f) + sh; }
#pragma unroll
        for (int k = 0; k < 2; ++k) { u32x4 w; w.x = cvt_pk_bf16(v[2 * k].x, v[2 * k].y); w.y = cvt_pk_bf16(v[2 * k].z, v[2 * k].w); w.z = cvt_pk_bf16(v[2 * k + 1].x, v[2 * k + 1].y); w.w = cvt_pk_bf16(v[2 * k + 1].z, v[2 * k + 1].w);
            *(u32x4*)(urow + 8 * lane + 512 * k) = w; }
        float lg[16];
#pragma unroll
        for (int e = 0; e < 16; ++e) { float s = 0.f;
#pragma unroll
            for (int j = 0; j < 4; ++j) { const f32x4 w = *(const f32x4*)(wrT + e * WRS + 4 * lane + 256 * j); s += (v[j].x * w.x + v[j].y * w.y) + (v[j].z * w.z + v[j].w * w.w); }
            lg[e] = s; }
#pragma unroll
        for (int i = 0; i < 8; ++i) { const bool up = (lane & 32) != 0; const float send = up ? lg[i] : lg[i + 8], keep = up ? lg[i + 8] : lg[i]; lg[i] = keep + __shfl_xor(send, 32); }
#pragma unroll
        for (int i = 0; i < 4; ++i) { const bool up = (lane & 16) != 0; const float send = up ? lg[i] : lg[i + 4], keep = up ? lg[i + 4] : lg[i]; lg[i] = keep + __shfl_xor(send, 16); }
#pragma unroll
        for (int i = 0; i < 2; ++i) { const bool up = (lane & 8) != 0; const float send = up ? lg[i] : lg[i + 2], keep = up ? lg[i + 2] : lg[i]; lg[i] = keep + __shfl_xor(send, 8); }
        { const bool up = (lane & 4) != 0; const float send = up ? lg[0] : lg[1], keep = up ? lg[1] : lg[0]; lg[0] = keep + __shfl_xor(send, 4); }
        float logit = lg[0]; logit += __shfl_xor(logit, 2); logit += __shfl_xor(logit, 1);
        const int e = ((lane >> 5) & 1) * 8 + ((lane >> 4) & 1) * 4 + ((lane >> 3) & 1) * 2 + ((lane >> 2) & 1);
        float mx = logit;
#pragma unroll
        for (int o = 4; o < 64; o <<= 1) mx = fmaxf(mx, __shfl_xor(mx, o));
        const float ex = __expf(logit - mx); float den = ex;
#pragma unroll
        for (int o = 4; o < 64; o <<= 1) den += __shfl_xor(den, o);
        const float mine = ex / den;
        if ((lane & 3) == 0) { const bool lat = row < RL;
            if (lat) AFFT[((size_t)(row / SEQ) * 16 + e) * SEQ + (row % SEQ)] = mine;
            else AFFT[(size_t)2 * 16 * SEQ + ((size_t)((row - RL) / NCTX) * 16 + e) * NCTX + ((row - RL) % NCTX)] = mine;
            INV[(size_t)row * 16 + e] = -1; }
    }
#undef RROW_PTR
}
__device__ __forceinline__ int block_sum_i(int v, int* red) {
#pragma unroll
    for (int o = 1; o < 64; o <<= 1) v += __shfl_xor(v, o);
    if ((ltid() & 63) == 0) red[ltid() >> 6] = v; __syncthreads();
    int s = 0;
#pragma unroll
    for (int q = 0; q < 8; ++q) s += red[q];
    __syncthreads(); return s;
}
__device__ __forceinline__ int block_excl_scan(int v, int* red) {
    const int lane = ltid() & 63, w = ltid() >> 6; int inc = v;
#pragma unroll
    for (int o = 1; o < 64; o <<= 1) { const int t = __shfl_up(inc, o); if (lane >= o) inc += t; }
    if (lane == 63) red[w] = inc; __syncthreads();
    int base = 0;
#pragma unroll
    for (int q = 0; q < 8; ++q) base += (q < w) ? red[q] : 0;
    __syncthreads(); return base + inc - v;
}
__device__ __forceinline__ void topk_select(const Args& A, char* lds, bool with_ctx) {
    int* red = (int*)lds; const int tid = ltid();
    const float* AFFT = WSP(float, WS_AFFT); int* SROW = WSP(int, WS_IDX); float* GROW = WSP(float, WS_GROW); int* INV = WSP(int, WS_INV);
    for (int it = blockIdx.x; it < (with_ctx ? 64 : 32); it += gridDim.x) {
        const bool isc = it >= 32; const int r = it & 31, b = r >> 4, e = r & 15; const int n = isc ? NCTX : SEQ, cap = isc ? CAPC : CAPL;
        const float* src = isc ? AFFT + (size_t)2 * 16 * SEQ + (size_t)(b * 16 + e) * NCTX : AFFT + (size_t)(b * 16 + e) * SEQ;
        unsigned key[32];
#pragma unroll
        for (int i = 0; i < 32; ++i) { const int t = tid + NT * i; key[i] = t < n ? __float_as_uint(src[t]) : 0u; }
        unsigned prefix = 0u; int krem = cap;
        for (int bit = 30; bit >= 0; --bit) { const unsigned cand = prefix | (1u << bit); int cnt = 0;
#pragma unroll
            for (int i = 0; i < 32; ++i) cnt += ((key[i] >> bit) == (cand >> bit)) ? 1 : 0;
            cnt = block_sum_i(cnt, red);
            if (cnt >= krem) prefix = cand; else krem -= cnt; }
        int cg = 0, ce = 0;
#pragma unroll
        for (int i = 0; i < 32; ++i) { cg += key[i] > prefix ? 1 : 0; ce += key[i] == prefix ? 1 : 0; }
        int sg = block_excl_scan(cg, red), se = block_excl_scan(ce, red);
        const int ngreater = cap - krem;
        const int xbase = isc ? NE * 4096 + e * 256 + b * CAPC : e * 4096 + b * CAPL;
        const int rowbase = isc ? RL + b * NCTX : b * SEQ;
#pragma unroll
        for (int i = 0; i < 32; ++i) { const int t = tid + NT * i; int slot = -1;
            if (key[i] > prefix) slot = sg++; else if (key[i] == prefix && prefix != 0u) { if (se < krem) slot = ngreater + se; ++se; }
            if (slot >= 0) { SROW[xbase + slot] = rowbase + t; GROW[xbase + slot] = __uint_as_float(key[i]); INV[(size_t)(rowbase + t) * 16 + e] = slot; } }
        if (isc && b == 0 && tid < 256 - 2 * CAPC) { SROW[NE * 4096 + e * 256 + 2 * CAPC + tid] = 0; GROW[NE * 4096 + e * 256 + 2 * CAPC + tid] = 0.f; }
        __syncthreads();
    }
}
__device__ __forceinline__ void moe_gather(const Args& A, bool with_ctx, float* GROW) {
    const int lane = ltid() & 63; const int* IDX = WSP(int, WS_IDX); const float* GV = WSP(float, WS_GATEV); const bf16_t* U = WSP(bf16_t, WS_U); bf16_t* XE = WSP(bf16_t, WS_XE);
    const int nx = with_ctx ? XROWS : NE * 4096;
    for (int xr = gwave(); xr < nx; xr += ngwaves()) {
        int srow = 0; float g = 0.f;
        if (xr < NE * 4096) { const int e = xr >> 12, s = xr & 4095, b = s >> 11, i = s & 2047; srow = b * SEQ + IDX[(b * 16 + e) * CAPL + i]; g = GV[(b * 16 + e) * CAPL + i]; }
        else { const int q = xr - NE * 4096, e = q >> 8, s = q & 255; if (s < 2 * CAPC) { const int b = s >> 5, i = s & 31; srow = RL + b * NCTX + IDX[2 * 16 * CAPL + (b * 16 + e) * CAPC + i]; g = GV[2 * 16 * CAPL + (b * 16 + e) * CAPC + i]; } }
        const u32x4* s4 = (const u32x4*)(U + (size_t)srow * D); u32x4* d4 = (u32x4*)(XE + (size_t)xr * D);
        d4[lane] = s4[lane]; d4[64 + lane] = s4[64 + lane];
        if (lane == 0) GROW[xr] = g;
    }
}
__device__ __forceinline__ void moe_combine(const Args& A, int l) {
    const int lane = ltid() & 63; const int* INV = WSP(int, WS_INV); const bf16_t* YE = WSP(bf16_t, WS_XE);
    const int nrows = l == 0 ? ROWS : RL;
    const int stride = ngwaves(); int row = gwave(); u32x4 vn[2]; int invn = -1;
#define CROW_PTR(r) (WSP(bf16_t, WS_HB) + (size_t)(r) * D)
    if (row < nrows) { const bf16_t* src = CROW_PTR(row);
#pragma unroll
        for (int k = 0; k < 2; ++k) vn[k] = *(const u32x4*)(src + 8 * lane + 512 * k);
        invn = lane < 16 ? INV[(size_t)row * 16 + lane] : -1; }
    for (; row < nrows; row += stride) {
        const bool lat = row < RL; bf16_t* hp = CROW_PTR(row);
        f32x4 v[4], s[4];
#pragma unroll
        for (int j = 0; j < 4; ++j) s[j] = (f32x4){0.f, 0.f, 0.f, 0.f};
#pragma unroll
        for (int k = 0; k < 2; ++k) UNPK8(vn[k], v[2 * k], v[2 * k + 1]);
        const int myinv = invn;
        if (row + stride < nrows) { const bf16_t* src = CROW_PTR(row + stride);
#pragma unroll
            for (int k = 0; k < 2; ++k) vn[k] = *(const u32x4*)(src + 8 * lane + 512 * k);
            invn = lane < 16 ? INV[(size_t)(row + stride) * 16 + lane] : -1; }
        const int b = lat ? row / SEQ : (row - RL) / NCTX;
        unsigned m = (unsigned)(__ballot(myinv >= 0) & 0xFFFFull);
        while (m) {
            const bf16_t* yr[4]; float wq[4];
#pragma unroll
            for (int q = 0; q < 4; ++q) { const bool ok = m != 0u; const int e = ok ? __builtin_ctz(m) : 0; if (ok) m &= m - 1u;
                const int slot = ok ? __builtin_amdgcn_readlane(myinv, e) : 0;
                const size_t xr = lat ? (size_t)e * 4096 + b * 2048 + slot : (size_t)NE * 4096 + e * 256 + b * 32 + slot;
                yr[q] = (ok || q == 0) ? YE + xr * D : yr[0]; wq[q] = ok ? 1.f : 0.f; }
            u32x4 qv[4][2];
#pragma unroll
            for (int q = 0; q < 4; ++q)
#pragma unroll
                for (int k = 0; k < 2; ++k) qv[q][k] = *(const u32x4*)(yr[q] + 8 * lane + 512 * k);
#pragma unroll
            for (int q = 0; q < 4; ++q)
#pragma unroll
                for (int k = 0; k < 2; ++k) { f32x4 ya, yb; UNPK8(qv[q][k], ya, yb); s[2 * k] = s[2 * k] + wq[q] * ya; s[2 * k + 1] = s[2 * k + 1] + wq[q] * yb; }
        }
        const int vv = row_vec(row); const float* mod = WSP(float, WS_MOD) + (size_t)(l * 3 + vv) * 6144;
#pragma unroll
        for (int j = 0; j < 4; ++j) { const f32x4 g5 = *(const f32x4*)(mod + 5 * 1024 + COL8(j)); v[j] = v[j] + g5 * s[j]; }
        if (l == 0) {
#pragma unroll
            for (int k = 0; k < 2; ++k) { u32x4 w; w.x = cvt_pk_bf16(v[2 * k].x, v[2 * k].y); w.y = cvt_pk_bf16(v[2 * k].z, v[2 * k].w); w.z = cvt_pk_bf16(v[2 * k + 1].x, v[2 * k + 1].y); w.w = cvt_pk_bf16(v[2 * k + 1].z, v[2 * k + 1].w);
                *(u32x4*)(hp + 8 * lane + 512 * k) = w; }
            const float* mod1 = WSP(float, WS_MOD) + (size_t)(1 * 3 + vv) * 6144;
            norm_mod_store8(v, A.in[I_GMIX] + D, mod1, mod1 + 1024, WSP(bf16_t, WS_U) + (size_t)row * D, lane);
        } else {
            float ss = 0.f;
#pragma unroll
            for (int j = 0; j < 4; ++j) ss += (v[j].x * v[j].x + v[j].y * v[j].y) + (v[j].z * v[j].z + v[j].w * v[j].w);
            const float rs = 1.0f / sqrtf(wave_sum(ss) * (1.0f / D) + EPS);
#pragma unroll
            for (int j = 0; j < 4; ++j) { const f32x4 g = *(const f32x4*)(A.in[I_FNORM] + COL8(j)); *(f32x4*)(A.out + (size_t)row * D + COL8(j)) = v[j] * rs * g; }
        }
    }
#undef CROW_PTR
#undef UNPK8
}

#define XB_TMO      128
#define XB_XCNT(j)  (256  + 64 * (j))
#define XB_XSUB(j)  (1280 + 64 * (j))
#define XB_XGEN(j)  (2304 + 64 * (j))
#define XB_TOP      3328
#define XB_TOPGEN   3392
#define XCD_BAR_WORDS 3456
#define XB_SPIN_CAP (1u << 22)
__device__ __forceinline__ unsigned xb_ld(unsigned* p)              { return __hip_atomic_load(p, __ATOMIC_RELAXED, __HIP_MEMORY_SCOPE_AGENT); }
__device__ __forceinline__ unsigned xb_add(unsigned* p, unsigned v) { return __hip_atomic_fetch_add(p, v, __ATOMIC_RELAXED, __HIP_MEMORY_SCOPE_AGENT); }
__device__ __forceinline__ unsigned xb_xcc_id() { return (unsigned)__builtin_amdgcn_s_getreg((3 << 11) | 20) & 0xFu; }
#define XB_SPIN(cond, bar) do { unsigned _sp = 0; while (cond) { __builtin_amdgcn_s_sleep(1); \
    if ((++_sp & 255u) == 0u) { if (xb_ld(&(bar)[XB_TMO])) break; if (_sp > XB_SPIN_CAP) { atomicAdd(&(bar)[XB_TMO], 1u); break; } } } } while (0)
struct XcdBarrier { unsigned* bar; unsigned x; volatile LAS unsigned* st; };
__device__ __forceinline__ XcdBarrier xcd_barrier_post(unsigned* bar, volatile LAS unsigned* st) {
    XcdBarrier b; b.bar = bar; b.x = xb_xcc_id(); b.st = st;
    if (threadIdx.x == 0) (void)xb_add(&bar[XB_XCNT(b.x)], 1u);
    return b;
}
__device__ __forceinline__ void xcd_barrier_complete(unsigned* bar, unsigned x, unsigned& nloc, unsigned& nx) {
    const unsigned G = gridDim.x * gridDim.y * gridDim.z;
    unsigned sum, cnt, mine, sp = 0u;
    for (;;) {
        sum = 0u; cnt = 0u; mine = 0u;
#pragma unroll
        for (unsigned j = 0; j < 16; ++j) { const unsigned c = xb_ld(&bar[XB_XCNT(j)]); sum += c; cnt += (c > 0u) ? 1u : 0u; mine = (j == x) ? c : mine; }
        if (sum == G) break;
        __builtin_amdgcn_s_sleep(1);
        if ((++sp & 255u) == 0u) { if (xb_ld(&bar[XB_TMO])) break; if (sp > XB_SPIN_CAP) { atomicAdd(&bar[XB_TMO], 1u); break; } }
    }
    nloc = mine > 0u ? mine : 1u; nx = cnt > 0u ? cnt : 1u;
}
__device__ __forceinline__ void xcd_barrier(const XcdBarrier& b) {
    asm volatile("s_waitcnt vmcnt(0)" ::: "memory");
    __syncthreads();
    if (threadIdx.x == 0) {
        unsigned* bar = b.bar;
        __builtin_amdgcn_s_waitcnt(0);
        unsigned nloc = b.st[0], nx = b.st[1];
        if (nloc == 0u) { xcd_barrier_complete(bar, b.x, nloc, nx); b.st[0] = nloc; b.st[1] = nx; }
        const unsigned old = xb_add(&bar[XB_XSUB(b.x)], 1u);
        const unsigned gen = old / nloc;
        if (old + 1u == (gen + 1u) * nloc) {
            __builtin_amdgcn_fence(__ATOMIC_RELEASE, "agent");
            asm volatile("s_waitcnt vmcnt(0)" ::: "memory");
            const unsigned og = xb_add(&bar[XB_TOP], 1u);
            const unsigned tg = og / nx;
            if (og + 1u == (tg + 1u) * nx) xb_add(&bar[XB_TOPGEN], 1u);
            else XB_SPIN(xb_ld(&bar[XB_TOPGEN]) == tg, bar);
            __builtin_amdgcn_fence(__ATOMIC_ACQUIRE, "agent");
            xb_add(&bar[XB_XGEN(b.x)], 1u);
            asm volatile("s_waitcnt vmcnt(0)" ::: "memory");
        } else {
            XB_SPIN(xb_ld(&bar[XB_XGEN(b.x)]) == gen, bar);
            __builtin_amdgcn_fence(__ATOMIC_ACQUIRE, "agent");
            asm volatile("s_waitcnt vmcnt(0)" ::: "memory");
        }
    }
    __syncthreads();
}

constexpr int LDS_MAIN = 136 * 1024;
constexpr int LDS_BYTES = LDS_MAIN + 16;
constexpr int PH_PER_LAYER = 15, N_PHASES = 2 + 2 * PH_PER_LAYER;

__global__ void __launch_bounds__(NT, 2) hybrid_fwd(Args A0) {
    extern __shared__ __attribute__((aligned(16))) unsigned char lds_raw[];
    char* lds = (char*)lds_raw;
    const int tid = threadIdx.x;
    if (tid < 4) ((volatile LAS unsigned*)(LAS unsigned char*)(lds_raw + LDS_MAIN))[tid] = 0u;
    __syncthreads();
    const bool multi = (A0.ph_hi - A0.ph_lo) > 1;
    XcdBarrier bar; bar.bar = (unsigned*)(A0.ws + WS_CTL); bar.x = 0; bar.st = nullptr;
    if (multi) bar = xcd_barrier_post((unsigned*)(A0.ws + WS_CTL), (volatile LAS unsigned*)(LAS unsigned char*)(lds_raw + LDS_MAIN));
    const int lo = A0.ph_lo, hi = A0.ph_hi;
#ifndef PROBE_PHASE
#define PROBE_PHASE -1
#endif
#ifndef PROBE_B
#define PROBE_B -1
#endif
#ifndef PROBE_C
#define PROBE_C -1
#endif
#ifndef PROBE_D
#define PROBE_D -1
#endif
#define REPEAT(j) _Pragma("unroll 1") for (int _rep = 0; _rep < ((PROBE_PHASE == (j) || PROBE_B == (j) || PROBE_C == (j) || PROBE_D == (j)) ? 2 : 1); ++_rep)
#define LA Args A = A0; asm volatile("" : "+s"(A.ws))
#ifdef DIAG_PHASE
#define DIAGOK(k) ((k) < 2 ? (k) == DIAG_PHASE : (((k) - 2) % PH_PER_LAYER) + 2 == DIAG_PHASE)
#else
#define DIAGOK(k) true
#endif
#define IN(k) (DIAGOK(k) && lo <= (k) && (k) < hi)
#define INR(k) (lo <= (k) && (k) < hi)
#define SEAM(k) do { if (INR(k) && INR((k) + 1)) xcd_barrier(bar); } while (0)
    const int G = gridDim.x, bx = blockIdx.x;
    LAS unsigned char* ldsl = (LAS unsigned char*)lds_raw;

    if (IN(0)) { LA; REPEAT(200) { conv_small_weights(A, 0, lds); __syncthreads(); }     REPEAT(201) compute_mod(A, lds, 0, bx, G); REPEAT(202) compute_hid2(A, lds, 0, G >= 226 ? (bx + G - 96) % G : bx, G);     }
    SEAM(0);
    if (IN(1)) { LA; REPEAT(203) rows_to_u_layer0(A); }
    SEAM(1);

#pragma unroll 1
    for (int l = 0; l < DEPTH; ++l) {
        const int pb = 2 + l * PH_PER_LAYER; const bool first = (l == 0);
        const int Mtok = first ? ROWS : RL;
        if (IN(pb + 0)) { LA;
            pg8::Gemm g{WSP(bf16_t, WS_U), WSP(bf16_t, WS_WIN) + (size_t)l * NPREP * D, ROWS, NPREP, D, D, D, -1, 0, 0};
            pg8::StaticOrder S; S.init(g, G, bx);
            epi::Win E{WSP(bf16_t, WS_ZD), WSP(bf16_t, WS_ZH), WSP(bf16_t, WS_ZC), WSP(bf16_t, WS_ZM)};
            REPEAT(0) pg8::gemm_phase(ldsl, g, S, E);
        }
        SEAM(pb + 0);
        if (IN(pb + 1)) { LA;
            post_rows(A);
            REPEAT(10) conformer_tiles(A, l, lds, Mtok);
            REPEAT(11) hyena_pre_tiles(A, l, lds, Mtok);
            REPEAT(12) hyena_filters(A, l, lds, first);
        }
        SEAM(pb + 1);
        if (IN(pb + 2)) { LA;
            pg8::Gemm g{WSP(bf16_t, WS_ZM), WSP(bf16_t, WS_WMLA) + (size_t)l * 1024 * 384, ROWS, 1024, 384, 512, 384, -1, 0, 0};
            pg8::StaticOrder S; S.init(g, G, bx);
            epi::Mla E{WSP(bf16_t, WS_QM)};
            REPEAT(2) pg8::gemm_phase(ldsl, g, S, E);
        }
        SEAM(pb + 2);
        if (IN(pb + 4)) { LA;
            att::Tensors T{(const char*)A.ws, WSP(bf16_t, WS_ZD), WSP(bf16_t, WS_QM), WSP(bf16_t, WS_KR), WSP(bf16_t, WS_Y), A.in[I_SUBLN] + l * 128, WSP(float, WS_LAM)[l], first ? 0.8f : 0.64449093f};
            constexpr int N_DL = 1024, N_ML = 512, N_HL = 256, N_DC = 16, N_MC = 8, N_HC = 256;
#if !defined(DIAG_SUB) || DIAG_SUB == 0
            REPEAT(40) for (int r = bx; r < N_DL; r += G) att::attn_unit<true>(T, r >> 9, (r >> 7) & 3, (r & 127) * 128, false, lds);
#endif
#if !defined(DIAG_SUB) || DIAG_SUB == 1
            REPEAT(41) for (int r = bx; r < N_ML; r += G) att::attn_unit<false>(T, r >> 8, (r >> 6) & 3, (r & 63) * 256, false, lds);
#endif
#if defined(PROBE_HALF) && PROBE_HALF == 1
            for (int r = bx; r < N_ML; r += G) att::attn_unit<false, PROBE_SH>(T, r >> 8, (r >> 6) & 3, (r & 63) * 256, false, lds);
#endif
#if defined(PROBE_HALF) && PROBE_HALF == 2
            for (int r = bx; r < N_DL; r += G) att::attn_unit<true, PROBE_SH>(T, r >> 9, (r >> 7) & 3, (r & 127) * 128, false, lds);
#endif
#if !defined(DIAG_SUB) || DIAG_SUB == 2
            REPEAT(42) for (int r = bx; r < N_HL; r += G) hyena_item(A, l, r, lds, A.ws + WS_ZM + (size_t)bx * SCR_PER_BLOCK);
#endif
#if !defined(DIAG_SUB) || DIAG_SUB == 3
            if (first) {
                for (int r = bx; r < N_DC; r += G) att::attn_unit<true>(T, r >> 3, (r >> 1) & 3, (r & 1) * 128, true, lds);
                for (int r = G >= 32 ? bx - 16 : bx; r >= 0 && r < N_MC; r += G) att::attn_unit<false>(T, r >> 2, r & 3, 0, true, lds);
                for (int r = bx; r < N_HC; r += G) hyena_ctx_item(A, l, r, lds);
            }
#endif
        }
        SEAM(pb + 4);
        if (IN(pb + 5)) { LA; REPEAT(5) hyena_post_tiles(A, lds, Mtok); }
        SEAM(pb + 5);
#if defined(SENS) && SENS == 3
        if (multi) { for (int q = 0; q < 10; ++q) xcd_barrier(bar); }
#endif
        if (IN(pb + 6)) { LA;
            pg8::Gemm g{WSP(bf16_t, WS_Y), WSP(bf16_t, WS_WB) + (size_t)l * 4 * 1024 * 512, Mtok, 4096, 512, 1280, 512, -1, 0, 0};
            pg8::BranchOrder S; S.init(g, G, bx);
            epi::PBranch E{WSP(bf16_t, WS_P)};
            REPEAT(6) pg8::gemm_phase(ldsl, g, S, E);
        }
        SEAM(pb + 6);
        if (IN(pb + 7)) { LA;
            pg8::Gemm g{WSP(bf16_t, WS_U), WSP(bf16_t, WS_WG) + (size_t)l * 4096 * D, Mtok, 4096, D, D, D, -1, 0, 0};
            pg8::StaticOrder S; S.init(g, G, bx);
            epi::Gate E{WSP(bf16_t, WS_P), WSP(bf16_t, WS_ACC)};
            REPEAT(7) pg8::gemm_phase(ldsl, g, S, E);
            if (first && DEPTH > 1) { __syncthreads(); const int rem = S.nwg % G, sk = (rem > 0 && rem < G / 2) ? rem : 0;
                conv_small_weights(A, 1, lds, sk); __syncthreads();
                if (bx >= sk) { const int r = bx - sk, nr = G - sk; compute_mod(A, lds, 1, r, nr); compute_hid2(A, lds, 1, nr >= 226 ? (r + nr - 96) % nr : r, nr); } __syncthreads(); }
        }
        SEAM(pb + 7);
        if (IN(pb + 8)) { LA;
            pg8::Gemm g{WSP(bf16_t, WS_ACC), WSP(bf16_t, WS_WO) + (size_t)l * D * D, Mtok, D, D, D, D, -1, 0, 0};
            pg8::StaticOrder S; S.init(g, G, bx);
            epi::Out E{A.in[I_X], A.in[I_CTX], WSP(bf16_t, WS_HB), first, WSP(float, WS_MOD) + (size_t)l * 3 * 6144 + 2 * 1024};
            pg8::gemm_phase(ldsl, g, S, E);
        }
        SEAM(pb + 8);
        if (IN(pb + 9)) { LA; REPEAT(90) { router_rows(A, l, lds, Mtok); __syncthreads(); } }
        SEAM(pb + 9);
        if (IN(pb + 10)) { LA; REPEAT(100) topk_select(A, lds, first); __syncthreads(); conv_expert_weights(A, l, lds, G >= 128 ? (first ? 64 : 32) : 0); }
        SEAM(pb + 10);
        if (IN(pb + 12)) { LA;
            pg8::Gemm g{WSP(bf16_t, WS_U), WSP(bf16_t, WS_WEIN), first ? XROWS : NE * 4096, 2048, D, D, D, 4, 256, (size_t)2048 * D};
            pg8::StaticOrder S; S.init(g, G, bx);
            epi::Ex1 E{WSP(bf16_t, WS_HID)};
            REPEAT(120) pg8::gemm_phase<epi::Ex1, pg8::StaticOrder, true>(ldsl, g, S, E, WSP(int, WS_IDX));
        }
        SEAM(pb + 12);
        if (IN(pb + 13)) { LA;
            pg8::Gemm g{WSP(bf16_t, WS_HID), WSP(bf16_t, WS_WEOUT), first ? XROWS : NE * 4096, D, EH, EH, EH, 4, 256, (size_t)D * EH};
            pg8::StaticOrder S; S.init(g, G, bx);
            epi::Ex2 E{WSP(bf16_t, WS_XE), WSP(float, WS_GROW)};
            REPEAT(130) pg8::gemm_phase(ldsl, g, S, E);
        }
        SEAM(pb + 13);
        if (IN(pb + 14)) { LA; moe_combine(A, l); }
        if (l + 1 < DEPTH) SEAM(pb + 14);
    }
#undef LA
#undef REPEAT
#undef IN
#undef INR
#undef SEAM
}

#ifndef MK_ONE_LAUNCH
#define MK_ONE_LAUNCH 0
#endif
#ifndef MAX_PHASE
#define MAX_PHASE N_PHASES
#endif
extern "C" void kernel_launch(void* const* d_in, const int* in_sizes, int n_in, void* d_out, int out_size, void* d_ws, size_t ws_size, hipStream_t stream) {
    static int grid = 0;
    if (grid == 0) {
        if (n_in != N_INPUTS || out_size != RL * D || ws_size < WS_END) { fprintf(stderr, "kernel_launch: unexpected shapes (n_in %d out %d ws %zu need %zu)\n", n_in, out_size, ws_size, (size_t)WS_END); grid = -1; return; }
        int dev = 0, cus = 0, per_cu = 0;
        if (hipGetDevice(&dev) != hipSuccess || hipDeviceGetAttribute(&cus, hipDeviceAttributeMultiprocessorCount, dev) != hipSuccess) { grid = -1; return; }
        if (hipFuncSetAttribute((const void*)hybrid_fwd, hipFuncAttributeMaxDynamicSharedMemorySize, LDS_BYTES) != hipSuccess) { fprintf(stderr, "kernel_launch: hipFuncSetAttribute failed\n"); grid = -1; return; }
        if (hipOccupancyMaxActiveBlocksPerMultiprocessor(&per_cu, (const void*)hybrid_fwd, NT, LDS_BYTES) != hipSuccess || per_cu < 1) fprintf(stderr, "kernel_launch: occupancy query says %d\n", per_cu);
        (void)hipGetLastError();
        grid = cus > 256 ? 256 : cus;
    }
    if (grid < 0) return;
    (void)hipMemsetAsync((char*)d_ws + WS_CTL, 0, CTL_BYTES, stream);
    Args a{};
    for (int i = 0; i < N_INPUTS; ++i) a.in[i] = (const float*)d_in[i];
    a.out = (float*)d_out; a.ws = (unsigned char*)d_ws;
#if MK_ONE_LAUNCH
    a.ph_lo = 0; a.ph_hi = N_PHASES;
    hipLaunchKernelGGL(hybrid_fwd, dim3(grid), dim3(NT), LDS_BYTES, stream, a);
#else
    for (int k = 0; k < MAX_PHASE; ++k) { a.ph_lo = k; a.ph_hi = k + 1; hipLaunchKernelGGL(hybrid_fwd, dim3(grid), dim3(NT), LDS_BYTES, stream, a); }
#endif
}
```
